# Optimizing an MI355X kernel written in HIP

```python
import jax, jax.numpy as jnp
from jax import lax
import numpy as np

D_MODEL = 1024
BATCH = 32
SEQ = 2048
DEPTH = 1

GRID_W = 64
CTX_LEN = 256

N_HEADS = 8
QK_NOPE_DIM = 128
ROPE_DIM = 64
V_HEAD_DIM = 128
QK_HEAD_DIM = QK_NOPE_DIM + ROPE_DIM
Q_LORA_RANK = 256
KV_LORA_RANK = 128
ROPE_BASE = 10000.0
ATTN_SCALE = QK_HEAD_DIM ** -0.5
Q_BLOCK = 128

POOL_WINDOWS = (2, 4, 8, 16)
POOL_GROUPS = 4
POOL_WIDTH = D_MODEL
POOL_GROUP_DIM = POOL_WIDTH // POOL_GROUPS

N_BRANCHES = 2
KV_IN = KV_LORA_RANK + ROPE_DIM
Q_OFF = KV_IN
POOL_OFF = Q_OFF + Q_LORA_RANK
GATE_OFF = POOL_OFF + POOL_WIDTH
IN_WIDTH = GATE_OFF + N_BRANCHES * D_MODEL

PEER_HEADS = 8
N_KEYS = 128
N_EXPERTS = N_KEYS * N_KEYS
PEER_QDIM = 256
PEER_HALF = PEER_QDIM // 2
PEER_TOPK = 16
TOKEN_CHUNK = 128

EPS = 1e-6

kernel_name = "hybrid_mla_pool_peer_dit_block"


def rmsnorm(x, g):
    xf = x.astype(jnp.float32)
    var = jnp.mean(jnp.square(xf), axis=-1, keepdims=True)
    return (xf * lax.rsqrt(var + EPS)).astype(x.dtype) * g


def modulate(h, shift, scale):
    return h * (1 + scale) + shift


def axial_rope_tables(rows, dtype):
    row = jnp.broadcast_to(jnp.arange(rows, dtype=jnp.float32)[:, None], (rows, GRID_W)).reshape(-1)
    col = jnp.broadcast_to(jnp.arange(GRID_W, dtype=jnp.float32)[None, :], (rows, GRID_W)).reshape(-1)
    n_freq = ROPE_DIM // 4
    inv_freq = ROPE_BASE ** (-jnp.arange(n_freq, dtype=jnp.float32) / n_freq)
    ang = jnp.stack([row[:, None] * inv_freq, col[:, None] * inv_freq], axis=1)
    return jnp.cos(ang).astype(dtype), jnp.sin(ang).astype(dtype)


def apply_axial_rope(x, cos, sin):
    xs = x.reshape(x.shape[:-1] + (2, 2, ROPE_DIM // 4))
    x1, x2 = xs[..., 0, :], xs[..., 1, :]
    out = jnp.stack([x1 * cos - x2 * sin, x1 * sin + x2 * cos], axis=-2)
    return out.reshape(x.shape)


def mla_kv(kv_in, g_kv_lora, w_ukv):
    ckv, k_rope = kv_in[..., :KV_LORA_RANK], kv_in[..., KV_LORA_RANK:]
    kv = rmsnorm(ckv, g_kv_lora) @ w_ukv
    kv = kv.reshape(kv.shape[:-1] + (N_HEADS, QK_NOPE_DIM + V_HEAD_DIM))
    return kv[..., :QK_NOPE_DIM], kv[..., QK_NOPE_DIM:], k_rope


def mla_q(cq, g_q_lora, w_uq):
    q = (rmsnorm(cq, g_q_lora) @ w_uq).reshape(cq.shape[:-1] + (N_HEADS, QK_HEAD_DIM))
    return q[..., :QK_NOPE_DIM], q[..., QK_NOPE_DIM:]


def mla_attend(q_nope, q_rope, k_nope, k_rope, v):
    s = (jnp.einsum('bqhd,bkhd->bhqk', q_nope, k_nope)
         + jnp.einsum('bqhr,bkr->bhqk', q_rope, k_rope))
    p = jax.nn.softmax(s.astype(jnp.float32) * ATTN_SCALE, axis=-1).astype(v.dtype)
    return jnp.einsum('bhqk,bkhd->bqhd', p, v)


def latent_attention(q_nope, q_rope, k_nope, k_rope, v):
    b, s = q_nope.shape[:2]
    nb = s // Q_BLOCK
    qn = q_nope.reshape(b, nb, Q_BLOCK, N_HEADS, QK_NOPE_DIM).transpose(1, 0, 2, 3, 4)
    qr = q_rope.reshape(b, nb, Q_BLOCK, N_HEADS, ROPE_DIM).transpose(1, 0, 2, 3, 4)
    out = lax.map(lambda blk: mla_attend(blk[0], blk[1], k_nope, k_rope, v), (qn, qr))
    return out.transpose(1, 0, 2, 3, 4).reshape(b, s, N_HEADS * V_HEAD_DIM)


def multiscale_pool(xp, w_pool, pool_scale):
    b, L, _ = xp.shape
    xg = xp.reshape(b, L, POOL_GROUPS, POOL_GROUP_DIM)
    cs = jnp.cumsum(xg.astype(jnp.float32), axis=1)
    cs = jnp.concatenate([jnp.zeros_like(cs[:, :1]), cs], axis=1)
    t = jnp.arange(L, dtype=jnp.int32)[:, None]
    half = (jnp.array(POOL_WINDOWS, dtype=jnp.int32) // 2)[None, :]
    lo = jnp.clip(t - half, 0, L)
    hi = jnp.clip(t + half, 0, L)
    gidx = jnp.arange(POOL_GROUPS, dtype=jnp.int32)[None, :]
    win_sum = cs[:, hi, gidx] - cs[:, lo, gidx]
    count = (hi - lo).astype(jnp.float32)[None, :, :, None]
    pooled = (win_sum / count - xg.astype(jnp.float32)).astype(xp.dtype)
    y = jnp.einsum('blgc,gcd->blgd', pooled, w_pool)
    return y.reshape(b, L, POOL_WIDTH) * pool_scale


def merge_branches(proj, attn_out, w_pool, pool_scale, w_out):
    y_pool = multiscale_pool(proj[..., POOL_OFF:GATE_OFF], w_pool, pool_scale)
    gates = jax.nn.sigmoid(proj[..., GATE_OFF:].astype(jnp.float32)).astype(proj.dtype)
    merged = gates[..., :D_MODEL] * attn_out + gates[..., D_MODEL:] * y_pool
    return merged @ w_out


def peer_ffn(h, peer_wq, peer_keys, peer_u, peer_v):
    shape = h.shape
    tokens = h.reshape(-1, TOKEN_CHUNK, D_MODEL)

    def chunk(xc):
        n_tok = xc.shape[0]
        q = (xc @ peer_wq).reshape(n_tok, PEER_HEADS, 2, PEER_HALF)
        s = jnp.einsum('thpc,pnc->thpn', q, peer_keys).astype(jnp.float32)
        s_top, i_top = lax.top_k(s, PEER_TOPK)
        cand = s_top[..., 0, :, None] + s_top[..., 1, None, :]
        cand_idx = i_top[..., 0, :, None] * N_KEYS + i_top[..., 1, None, :]
        best, pos = lax.top_k(cand.reshape(n_tok, PEER_HEADS, PEER_TOPK * PEER_TOPK), PEER_TOPK)
        experts = jnp.take_along_axis(
            cand_idx.reshape(n_tok, PEER_HEADS, PEER_TOPK * PEER_TOPK), pos, axis=-1)
        g = jax.nn.softmax(best, axis=-1).astype(xc.dtype)
        u = peer_u[experts]
        v = peer_v[experts]
        a = jax.nn.gelu(jnp.einsum('thkd,td->thk', u, xc), approximate=False) * g
        return jnp.einsum('thk,thkd->td', a, v)

    return lax.map(chunk, tokens).reshape(shape)


def setup_inputs(seed: int = 0) -> dict:
    key = jax.random.key(seed)
    ks = jax.random.split(key, 22)
    f32 = jnp.float32

    def nrm(k, shape, scale):
        return jax.random.normal(k, shape, f32) * scale

    def gain(k, shape):
        return 1.0 + 0.1 * jax.random.normal(k, shape, f32)

    return {
        "x": nrm(ks[0], (BATCH, SEQ, D_MODEL), 1.0),
        "c": nrm(ks[1], (BATCH, D_MODEL), 1.0),
        "ctx": nrm(ks[2], (BATCH, CTX_LEN, D_MODEL), 1.0),
        "c_ctx": nrm(ks[3], (D_MODEL,), 1.0),
        "w_ada": nrm(ks[4], (DEPTH, D_MODEL, 6 * D_MODEL), 0.5 * D_MODEL ** -0.5),
        "b_ada": nrm(ks[5], (DEPTH, 6 * D_MODEL), 0.01),
        "g_mix_pre": gain(ks[6], (DEPTH, D_MODEL)),
        "g_mix_post": gain(ks[7], (DEPTH, D_MODEL)),
        "g_ffn_pre": gain(ks[8], (DEPTH, D_MODEL)),
        "g_ffn_post": gain(ks[9], (DEPTH, D_MODEL)),
        "w_in": nrm(ks[10], (DEPTH, D_MODEL, IN_WIDTH), D_MODEL ** -0.5),
        "g_q_lora": gain(ks[11], (DEPTH, Q_LORA_RANK)),
        "w_uq": nrm(ks[12], (DEPTH, Q_LORA_RANK, N_HEADS * QK_HEAD_DIM), Q_LORA_RANK ** -0.5),
        "g_kv_lora": gain(ks[13], (DEPTH, KV_LORA_RANK)),
        "w_ukv": nrm(ks[14], (DEPTH, KV_LORA_RANK, N_HEADS * (QK_NOPE_DIM + V_HEAD_DIM)), KV_LORA_RANK ** -0.5),
        "w_pool": nrm(ks[15], (DEPTH, POOL_GROUPS, POOL_GROUP_DIM, POOL_GROUP_DIM), POOL_GROUP_DIM ** -0.5),
        "pool_scale": gain(ks[16], (DEPTH, POOL_WIDTH)),
        "w_out": nrm(ks[17], (DEPTH, D_MODEL, D_MODEL), D_MODEL ** -0.5),
        "peer_wq": nrm(ks[18], (DEPTH, D_MODEL, PEER_HEADS * PEER_QDIM), D_MODEL ** -0.5),
        "peer_keys": nrm(ks[19], (DEPTH, 2, N_KEYS, PEER_HALF), PEER_HALF ** -0.5),
        "peer_u": nrm(ks[20], (DEPTH, N_EXPERTS, D_MODEL), D_MODEL ** -0.5),
        "peer_v": nrm(ks[21], (DEPTH, N_EXPERTS, D_MODEL), D_MODEL ** -0.5),
    }


def reference(x, c, ctx, c_ctx, w_ada, b_ada, g_mix_pre, g_mix_post, g_ffn_pre, g_ffn_post,
              w_in, g_q_lora, w_uq, g_kv_lora, w_ukv, w_pool, pool_scale, w_out,
              peer_wq, peer_keys, peer_u, peer_v):
    ROWS = x.shape[1] // GRID_W
    cos, sin = axial_rope_tables(ROWS, x.dtype)
    for layer in range(DEPTH):
        last = layer == DEPTH - 1
        mod = jax.nn.silu(c) @ w_ada[layer] + b_ada[layer]
        sh_m, sc_m, gt_m, sh_f, sc_f, gt_f = jnp.split(mod[:, None, :], 6, axis=-1)
        mod_c = jax.nn.silu(c_ctx) @ w_ada[layer] + b_ada[layer]
        csh_m, csc_m, cgt_m, csh_f, csc_f, cgt_f = jnp.split(mod_c, 6, axis=-1)

        hc = modulate(rmsnorm(ctx, g_mix_pre[layer]), csh_m, csc_m)
        if last:
            kv_in_c = hc @ w_in[layer, :, :KV_IN]
        else:
            proj_c = hc @ w_in[layer]
            kv_in_c = proj_c[..., :KV_IN]
        kc_nope, vc, kc_rope = mla_kv(kv_in_c, g_kv_lora[layer], w_ukv[layer])

        h = modulate(rmsnorm(x, g_mix_pre[layer]), sh_m, sc_m)
        proj = h @ w_in[layer]
        k_nope, v, k_rope = mla_kv(proj[..., :KV_IN], g_kv_lora[layer], w_ukv[layer])
        k_rope = apply_axial_rope(k_rope, cos, sin)
        q_nope, q_rope = mla_q(proj[..., Q_OFF:POOL_OFF], g_q_lora[layer], w_uq[layer])
        q_rope = apply_axial_rope(q_rope, cos[:, None], sin[:, None])
        attn = latent_attention(q_nope, q_rope,
                                jnp.concatenate([kc_nope, k_nope], axis=1),
                                jnp.concatenate([kc_rope, k_rope], axis=1),
                                jnp.concatenate([vc, v], axis=1))
        y = merge_branches(proj, attn, w_pool[layer], pool_scale[layer], w_out[layer])
        x_mid = x + gt_m * rmsnorm(y, g_mix_post[layer])

        hf = modulate(rmsnorm(x_mid, g_ffn_pre[layer]), sh_f, sc_f)
        x_new = x_mid + gt_f * rmsnorm(
            peer_ffn(hf, peer_wq[layer], peer_keys[layer], peer_u[layer], peer_v[layer]),
            g_ffn_post[layer])

        if not last:
            qc_nope, qc_rope = mla_q(proj_c[..., Q_OFF:POOL_OFF], g_q_lora[layer], w_uq[layer])
            attn_c = mla_attend(qc_nope, qc_rope, kc_nope, kc_rope, vc)
            attn_c = attn_c.reshape(attn_c.shape[:2] + (N_HEADS * V_HEAD_DIM,))
            yc = merge_branches(proj_c, attn_c, w_pool[layer], pool_scale[layer], w_out[layer])
            ctx = ctx + cgt_m * rmsnorm(yc, g_mix_post[layer])
            hcf = modulate(rmsnorm(ctx, g_ffn_pre[layer]), csh_f, csc_f)
            ctx = ctx + cgt_f * rmsnorm(
                peer_ffn(hcf, peer_wq[layer], peer_keys[layer], peer_u[layer], peer_v[layer]),
                g_ffn_post[layer])
        x = x_new
    return x
```

```cpp
#include <hip/hip_runtime.h>
#include <hip/hip_cooperative_groups.h>
#include <cstdint>
#include <cstdio>
namespace cg = cooperative_groups;

#ifndef MK_N_LAUNCHES
#define MK_N_LAUNCHES 1
#endif

#define LAS __attribute__((address_space(3)))
typedef unsigned short bf16_t;
typedef short bf16x8 __attribute__((ext_vector_type(8)));
typedef short s16x4 __attribute__((ext_vector_type(4)));
typedef float f32x2 __attribute__((ext_vector_type(2)));
typedef float f32x4 __attribute__((ext_vector_type(4)));
typedef float f32x16 __attribute__((ext_vector_type(16)));
typedef unsigned u32x2 __attribute__((ext_vector_type(2)));
typedef unsigned u32x4 __attribute__((ext_vector_type(4)));
typedef __bf16 bf16x2_t __attribute__((ext_vector_type(2)));

constexpr int DM = 1024, NB = 32, SEQ = 2048, CTXL = 256, TL = NB * SEQ, TC = NB * CTXL, TALL = TL + TC;
constexpr int NH = 8, DQK = 192, QW = NH * DQK, NKEY = CTXL + SEQ;
constexpr int NWIN = 3584;
constexpr int INW = 3520;
constexpr float EPS = 1e-6f;
constexpr float C2 = 0.07216878364870323f * 1.4426950408889634f;
constexpr int NWAVES = 8, NTHREADS = 512;

constexpr size_t MiB = 1u << 20;
constexpr size_t WS_MOD = 1 * MiB;
constexpr size_t WS_ROPE = 2 * MiB;
constexpr size_t WS_SSQCQ = 3 * MiB;
constexpr size_t WS_SSQY = 4 * MiB;
constexpr size_t WS_WIN = 8 * MiB;
constexpr size_t WS_WQ = 15 * MiB;
constexpr size_t WS_WUV = 16 * MiB;
constexpr size_t WS_WPOOL = 16 * MiB + 512 * 1024;
constexpr size_t WS_KEYS = 17 * MiB;
constexpr size_t WS_WOUT = 18 * MiB;
constexpr size_t WS_WPQ = 20 * MiB;
constexpr size_t WS_PU = 24 * MiB;
constexpr size_t WS_PV = 56 * MiB;
constexpr size_t WS_HN = 88 * MiB;
constexpr size_t WS_CQ = 232 * MiB;
constexpr size_t WS_KVRAW = 264 * MiB;
constexpr size_t WS_KF = 318 * MiB;
constexpr size_t WS_XP = 345 * MiB;
constexpr size_t WS_GT = 473 * MiB;
constexpr size_t WS_Q = 729 * MiB;
constexpr size_t WS_S = WS_Q + 128 * MiB;
constexpr size_t WS_END = 921 * MiB;

constexpr int RING_BYTES = 131072;
constexpr int VEC_OFF = RING_BYTES;
constexpr int MISC_OFF = VEC_OFF + 5 * 4096;
constexpr int LDS_BYTES = MISC_OFF + 1024;

__device__ __forceinline__ unsigned cvtpk(float lo, float hi) { f32x2 v = {lo, hi}; bf16x2_t b = __builtin_convertvector(v, bf16x2_t); return __builtin_bit_cast(unsigned, b); }
__device__ __forceinline__ float bf_lo(unsigned w) { return __uint_as_float(w << 16); }
__device__ __forceinline__ float bf_hi(unsigned w) { return __uint_as_float(w & 0xffff0000u); }
__device__ __forceinline__ float wave_sum(float v) {
#pragma unroll
    for (int o = 1; o < 64; o <<= 1) v += __shfl_xor(v, o);
    return v;
}
__device__ __forceinline__ float dot2(unsigned a, unsigned b, float c) { return __builtin_amdgcn_fdot2_f32_bf16(__builtin_bit_cast(bf16x2_t, a), __builtin_bit_cast(bf16x2_t, b), c, false); }
__device__ __forceinline__ float fast_sigmoid(float x) { return __builtin_amdgcn_rcpf(1.0f + __builtin_amdgcn_exp2f(-1.4426950408889634f * x)); }
__host__ __device__ __forceinline__ int rope_src(int j) { const int p = j >> 1; return (p >> 4) * 32 + (j & 1) * 16 + (p & 15); }

namespace pg8 {
constexpr int BM = 256, BK = 64, HALF = 128, HTB = HALF * BK * 2, STAGE_BYTES = 8 * HTB, NXCD = 8, WGM = 8;
__host__ __device__ __forceinline__ int lds_byte(int r, int c) { const int st = (r >> 4) * 2 + (c >> 5), rr = r & 15, cc = c & 31, ob = rr * 64 + cc * 2; return st * 1024 + (ob ^ (((ob >> 9) & 1) << 5)); }
__host__ __device__ __forceinline__ void stage_rc(int b, int& R, int& C) { const int st = b / 1024, sb = b % 1024, swz = sb ^ (((sb >> 9) & 1) << 5); R = (st >> 1) * 16 + swz / 64; C = (st & 1) * 32 + (swz % 64) / 2; }
__host__ __device__ __forceinline__ int perm32(int rho) { const int n = rho >> 4, i = rho & 15; return 8 * (i >> 2) + 4 * n + (i & 3); }

struct Unit { int pm, pn; long aoff, boff; };
struct Gemm { const bf16_t* A; const bf16_t* Bt; int lda, ldb, K; };

__device__ __forceinline__ bool grouped_tile(long L, int nM, int nN, int& pm, int& pn) {
    const int nwg = nM * nN; if (L >= nwg) return false;
    int wgid = (int)L; { const int q = nwg / NXCD, r = nwg % NXCD, xcd = wgid % NXCD, off = wgid / NXCD; wgid = (xcd < r ? xcd * (q + 1) : r * (q + 1) + (xcd - r) * q) + off; }
    const int nig = WGM * nN, gid = wgid / nig, fm = gid * WGM, gsz = (nM - fm) < WGM ? (nM - fm) : WGM;
    pm = fm + ((wgid % nig) % gsz); pn = (wgid % nig) / gsz; return true;
}

template <class Epi, class Sched, bool ALIGN_EPI>
__device__ __forceinline__ void gemm_phase(LAS unsigned char* lds, const Gemm g, const Sched& S, const Epi& E) {
    int tid = threadIdx.x; asm volatile("" : "+v"(tid));
    const int wid = __builtin_amdgcn_readfirstlane(tid >> 6), lane = tid & 63, wr = wid >> 2, wc = wid & 3, fr = lane & 15, fq = lane >> 4;
    const int nt = g.K / BK;
    unsigned voffA[2], voffB[2];
#pragma unroll
    for (int i = 0; i < 2; ++i) { int R, C; stage_rc(tid * 16 + i * 8192, R, C); const int Rb = Epi::PERM ? ((R & ~31) + perm32(R & 31)) : R;
        voffA[i] = (unsigned)(R * g.lda + C) * 2u; voffB[i] = (unsigned)(Rb * g.ldb + C) * 2u; }
    const size_t kstep = (size_t)(BK * 2);
    const size_t hA = (size_t)HALF * g.lda * 2, hB = (size_t)HALF * g.ldb * 2;
    const unsigned ldsw = (unsigned)wid * 1024u;
    const int aoff = lds_byte(wr * 64 + fr, fq * 8), boff = lds_byte(wc * 32 + fr, fq * 8);
#define PG8_SA(b, h) (((b) * 2 + (h)) * HTB)
#define PG8_SB(b, h) ((4 + (b) * 2 + (h)) * HTB)
#define PG8_STAGE(bufoff, gbase, voff) do { _Pragma("unroll") for (int _i = 0; _i < 2; ++_i) \
        __builtin_amdgcn_global_load_lds((const unsigned*)((const char*)(gbase) + (voff)[_i]), (LAS unsigned*)(lds + (bufoff) + ldsw + _i * 8192), 16, 0, 0); } while (0)
#define PG8_LDA(dst, b, h) do { _Pragma("unroll") for (int m = 0; m < 4; ++m) _Pragma("unroll") for (int k = 0; k < 2; ++k) dst[m][k] = *(const LAS bf16x8*)(lds + PG8_SA(b, h) + aoff + m * 2048 + k * 1024); } while (0)
#define PG8_LDB(dst, b, h) do { _Pragma("unroll") for (int n = 0; n < 2; ++n) _Pragma("unroll") for (int k = 0; k < 2; ++k) dst[n][k] = *(const LAS bf16x8*)(lds + PG8_SB(b, h) + boff + n * 2048 + k * 1024); } while (0)
#define PG8_MMA(ai, bj, At, Bt) do { __builtin_amdgcn_s_setprio(1); _Pragma("unroll") for (int m = 0; m < 4; ++m) _Pragma("unroll") for (int n = 0; n < 2; ++n) _Pragma("unroll") for (int k = 0; k < 2; ++k) \
        acc[ai][bj][m][n] = __builtin_amdgcn_mfma_f32_16x16x32_bf16(Bt[n][k], At[m][k], acc[ai][bj][m][n], 0, 0, 0); __builtin_amdgcn_s_setprio(0); } while (0)
#define PG8_WAIT_V(n) asm volatile("s_waitcnt vmcnt(" #n ")" ::: "memory")
#define PG8_WAIT_L(n) asm volatile("s_waitcnt lgkmcnt(" #n ")" ::: "memory")
#define PG8_BAR __builtin_amdgcn_s_barrier()
#define PG8_SCHED __builtin_amdgcn_sched_barrier(0)
    Unit cur, nxt; int ui = 0;
    if (!S.next(0, cur)) return;
    f32x4 acc[2][2][4][2];
#pragma unroll
    for (int a = 0; a < 2; ++a)
#pragma unroll
        for (int b = 0; b < 2; ++b)
#pragma unroll
            for (int m = 0; m < 4; ++m)
#pragma unroll
                for (int n = 0; n < 2; ++n) acc[a][b][m][n] = (f32x4){0.f, 0.f, 0.f, 0.f};
    bf16x8 At[4][2], B0[2][2], B1[2][2];
    const char* cA = (const char*)g.A + cur.aoff; const char* cB = (const char*)g.Bt + cur.boff;
    PG8_STAGE(PG8_SB(0, 0), cB, voffB); PG8_STAGE(PG8_SB(0, 1), cB + hB, voffB); PG8_STAGE(PG8_SA(0, 0), cA, voffA); PG8_STAGE(PG8_SA(0, 1), cA + hA, voffA);
    if (wr == 1) PG8_BAR;
    PG8_WAIT_V(2); PG8_BAR;
    PG8_STAGE(PG8_SB(1, 0), cB + kstep, voffB); PG8_STAGE(PG8_SA(1, 0), cA + kstep, voffA); PG8_STAGE(PG8_SB(1, 1), cB + hB + kstep, voffB);
    PG8_WAIT_V(6); PG8_BAR;
    for (;;) {
        const bool has_next = S.next(ui + 1, nxt);
        const char* nA = has_next ? (const char*)g.A + nxt.aoff : cA; const char* nB = has_next ? (const char*)g.Bt + nxt.boff : cB;
#pragma nounroll
        for (int t = 0; t < nt; t += 2) {
            const bool last = (t == nt - 2);
            const char* a1 = cA + (size_t)(t + 1) * kstep;
            const char* a2 = last ? nA : cA + (size_t)(t + 2) * kstep; const char* b2 = last ? nB : cB + (size_t)(t + 2) * kstep;
            const char* a3 = a2 + kstep; const char* b3 = b2 + kstep;
            PG8_LDB(B0, 0, 0); PG8_LDB(B1, 0, 1); PG8_SCHED; PG8_LDA(At, 0, 0); PG8_STAGE(PG8_SA(1, 1), a1 + hA, voffA);
            PG8_WAIT_V(8); PG8_WAIT_L(0); PG8_BAR; PG8_MMA(0, 0, At, B0); PG8_MMA(0, 1, At, B1); PG8_BAR; PG8_SCHED;
            PG8_LDA(At, 0, 1); PG8_STAGE(PG8_SB(0, 0), b2, voffB); PG8_STAGE(PG8_SB(0, 1), b2 + hB, voffB); PG8_STAGE(PG8_SA(0, 0), a2, voffA);
            PG8_WAIT_V(8); PG8_WAIT_L(0); PG8_BAR; PG8_MMA(1, 0, At, B0); PG8_MMA(1, 1, At, B1); PG8_BAR; PG8_SCHED;
            PG8_LDB(B0, 1, 0); PG8_LDB(B1, 1, 1); PG8_SCHED; PG8_LDA(At, 1, 0); PG8_STAGE(PG8_SA(0, 1), a2 + hA, voffA);
            PG8_WAIT_V(8); PG8_WAIT_L(0); PG8_BAR; PG8_MMA(0, 0, At, B0); PG8_MMA(0, 1, At, B1); PG8_BAR; PG8_SCHED;
            PG8_LDA(At, 1, 1); PG8_STAGE(PG8_SB(1, 0), b3, voffB); PG8_STAGE(PG8_SB(1, 1), b3 + hB, voffB); PG8_STAGE(PG8_SA(1, 0), a3, voffA);
            PG8_WAIT_V(8); PG8_WAIT_L(0); PG8_BAR; PG8_MMA(1, 0, At, B0); PG8_MMA(1, 1, At, B1); PG8_BAR; PG8_SCHED;
        }
        if constexpr (ALIGN_EPI) { if (wr == 0) PG8_BAR; }
        E(acc, cur, wr, wc, fr, fq);
        if (!has_next) break;
#pragma unroll
        for (int a = 0; a < 2; ++a)
#pragma unroll
            for (int b = 0; b < 2; ++b)
#pragma unroll
                for (int m = 0; m < 4; ++m)
#pragma unroll
                    for (int n = 0; n < 2; ++n) acc[a][b][m][n] = (f32x4){0.f, 0.f, 0.f, 0.f};
        cur = nxt; cA = nA; cB = nB; ++ui;
        if constexpr (ALIGN_EPI) { if (wr == 1) PG8_BAR; }
    }
    PG8_WAIT_V(0);
    if constexpr (!ALIGN_EPI) { if (wr == 0) PG8_BAR; }
    PG8_BAR;
#undef PG8_SA
#undef PG8_SB
#undef PG8_STAGE
#undef PG8_LDA
#undef PG8_LDB
#undef PG8_MMA
#undef PG8_WAIT_V
#undef PG8_WAIT_L
#undef PG8_BAR
#undef PG8_SCHED
}
}
using pg8::Unit;

struct SchedIn {
    int G, c;
    __device__ __forceinline__ bool next(int i, Unit& u) const {
        const long L = (long)i * G + c; if (L >= 256 * 14 + 32) return false;
        int pm, pn;
        if (L < 256 * 14) pg8::grouped_tile(L, 256, 14, pm, pn); else { pm = 256 + (int)(L - 256 * 14); pn = 1; }
        u.pm = pm; u.pn = pn; u.aoff = (long)pm * 256 * DM * 2; u.boff = (long)pn * 256 * DM * 2; return true;
    }
};
struct SchedQ {
    int G, c;
    __device__ __forceinline__ bool next(int i, Unit& u) const {
        const long L = (long)i * G + c; int pm, pn; if (!pg8::grouped_tile(L, 256, 6, pm, pn)) return false;
        u.pm = pm; u.pn = pn; u.aoff = (long)pm * 256 * 256 * 2; u.boff = (long)pn * 256 * 256 * 2; return true;
    }
};
struct SchedRow {
    int pm, pn0, n; long a_base, a_pn, b_base, b_pn;
    __device__ __forceinline__ bool next(int i, Unit& u) const {
        if (i >= n) return false; u.pm = pm; u.pn = pn0 + i; u.aoff = a_base + (long)(pn0 + i) * a_pn; u.boff = b_base + (long)(pn0 + i) * b_pn; return true;
    }
};

#define EPI_ROWS_BEGIN _Pragma("unroll") for (int ai = 0; ai < 2; ++ai) _Pragma("unroll") for (int m = 0; m < 4; ++m) { const int row = row0 + ai * 128 + m * 16;
#define EPI_ROWS_END asm volatile("" ::: "memory"); }
__device__ __forceinline__ u32x4 pack8(f32x4 v0, f32x4 v1) { u32x4 w; w.x = cvtpk(v0[0], v0[1]); w.y = cvtpk(v0[2], v0[3]); w.z = cvtpk(v1[0], v1[1]); w.w = cvtpk(v1[2], v1[3]); return w; }

struct EpiIn {
    static constexpr bool PERM = true;
    bf16_t* CQ; float* SSQ; float* KVRAW; bf16_t* XP; bf16_t* GT;
    __device__ __forceinline__ void operator()(const f32x4 (&acc)[2][2][4][2], const Unit& u, int wr, int wc, int fr, int fq) const {
        const int row0 = u.pm * 256 + wr * 64 + fr, cb = wc * 32 + 8 * fq, pn = u.pn;
        if (pn == 0) {
            EPI_ROWS_BEGIN  float s = 0.f;
#pragma unroll
                for (int bj = 0; bj < 2; ++bj) { const f32x4 v0 = acc[ai][bj][m][0], v1 = acc[ai][bj][m][1];
                    s += (v0[0] * v0[0] + v0[1] * v0[1]) + (v0[2] * v0[2] + v0[3] * v0[3]) + (v1[0] * v1[0] + v1[1] * v1[1]) + (v1[2] * v1[2] + v1[3] * v1[3]);
                    *(u32x4*)(CQ + (size_t)row * 256 + bj * 128 + cb) = pack8(v0, v1); }
                s += __shfl_xor(s, 16); s += __shfl_xor(s, 32);
                if (fq == 0) SSQ[(size_t)row * 4 + wc] = s;  EPI_ROWS_END
        } else if (pn == 1) {
            EPI_ROWS_BEGIN
#pragma unroll
                for (int bj = 0; bj < 2; ++bj) { const int col = bj * 128 + cb;
                    if (col < 192) { float* p = KVRAW + (size_t)row * 192 + col; *(f32x4*)p = acc[ai][bj][m][0]; *(f32x4*)(p + 4) = acc[ai][bj][m][1]; } }  EPI_ROWS_END
        } else if (pn < 6) {
            EPI_ROWS_BEGIN
#pragma unroll
                for (int bj = 0; bj < 2; ++bj) *(u32x4*)(XP + (size_t)row * 1024 + (pn - 2) * 256 + bj * 128 + cb) = pack8(acc[ai][bj][m][0], acc[ai][bj][m][1]);  EPI_ROWS_END
        } else {
            EPI_ROWS_BEGIN
#pragma unroll
                for (int bj = 0; bj < 2; ++bj) { f32x4 v0 = acc[ai][bj][m][0], v1 = acc[ai][bj][m][1];
#pragma unroll
                    for (int e = 0; e < 4; ++e) { v0[e] = fast_sigmoid(v0[e]); v1[e] = fast_sigmoid(v1[e]); }
                    *(u32x4*)(GT + (size_t)row * 2048 + (pn - 6) * 256 + bj * 128 + cb) = pack8(v0, v1); }  EPI_ROWS_END
        }
    }
};

struct EpiQ {
    static constexpr bool PERM = true;
    bf16_t* Q; const float* SSQ; const float* TAB;
    __device__ __forceinline__ void operator()(const f32x4 (&acc)[2][2][4][2], const Unit& u, int wr, int wc, int fr, int fq) const {
        const int row0 = u.pm * 256 + wr * 64 + fr, cb = wc * 32 + 8 * fq;
        EPI_ROWS_BEGIN  const f32x4 sq = *(const f32x4*)(SSQ + (size_t)row * 4);
            const float rs = rsqrtf(((sq[0] + sq[1]) + (sq[2] + sq[3])) * (1.0f / 256.0f) + EPS) * C2;
            const int t = row & (SEQ - 1), vr = t >> 6, vc = t & 63;
#pragma unroll
            for (int bj = 0; bj < 2; ++bj) { const int col = u.pn * 256 + bj * 128 + cb, h = col / DQK, hc = col - h * DQK;
                f32x4 v0 = acc[ai][bj][m][0] * rs, v1 = acc[ai][bj][m][1] * rs;
                if (hc >= 128) { const int p0 = (hc - 128) >> 1, v = (p0 >> 4) ? vc : vr; const float* tp = TAB + (v * 16 + (p0 & 15)) * 2;
                    const f32x4 t0 = *(const f32x4*)tp, t1 = *(const f32x4*)(tp + 4);
                    f32x4 r0, r1;
                    r0[0] = v0[0] * t0[0] - v0[1] * t0[1]; r0[1] = v0[0] * t0[1] + v0[1] * t0[0]; r0[2] = v0[2] * t0[2] - v0[3] * t0[3]; r0[3] = v0[2] * t0[3] + v0[3] * t0[2];
                    r1[0] = v1[0] * t1[0] - v1[1] * t1[1]; r1[1] = v1[0] * t1[1] + v1[1] * t1[0]; r1[2] = v1[2] * t1[2] - v1[3] * t1[3]; r1[3] = v1[2] * t1[3] + v1[3] * t1[2];
                    v0 = r0; v1 = r1; }
                *(u32x4*)(Q + (size_t)row * QW + col) = pack8(v0, v1); }  EPI_ROWS_END
    }
};

struct EpiU {
    static constexpr bool PERM = true;
    bf16_t* MG; const bf16_t* GT;
    __device__ __forceinline__ void operator()(const f32x4 (&acc)[2][2][4][2], const Unit& u, int wr, int wc, int fr, int fq) const {
        const int row0 = u.pm * 256 + wr * 64 + fr, cb = wc * 32 + 8 * fq;
        EPI_ROWS_BEGIN
#pragma unroll
            for (int bj = 0; bj < 2; ++bj) { const int col = u.pn * 256 + bj * 128 + cb; const u32x4 gw = *(const u32x4*)(GT + (size_t)row * 2048 + col);
                f32x4 v0 = acc[ai][bj][m][0], v1 = acc[ai][bj][m][1];
                v0[0] *= bf_lo(gw.x); v0[1] *= bf_hi(gw.x); v0[2] *= bf_lo(gw.y); v0[3] *= bf_hi(gw.y); v1[0] *= bf_lo(gw.z); v1[1] *= bf_hi(gw.z); v1[2] *= bf_lo(gw.w); v1[3] *= bf_hi(gw.w);
                *(u32x4*)(MG + (size_t)row * 1024 + col) = pack8(v0, v1); }  EPI_ROWS_END
    }
};
struct EpiP {
    static constexpr bool PERM = true;
    bf16_t* MG; const bf16_t* GT; const LAS float* PS;
    __device__ __forceinline__ void operator()(const f32x4 (&acc)[2][2][4][2], const Unit& u, int wr, int wc, int fr, int fq) const {
        const int row0 = u.pm * 256 + wr * 64 + fr, cb = wc * 32 + 8 * fq;
        EPI_ROWS_BEGIN
#pragma unroll
            for (int bj = 0; bj < 2; ++bj) { const int col = u.pn * 256 + bj * 128 + cb; const u32x4 gw = *(const u32x4*)(GT + (size_t)row * 2048 + 1024 + col);
                const u32x4 mw = *(const u32x4*)(MG + (size_t)row * 1024 + col);
                const f32x4 p0 = *(const LAS f32x4*)(PS + col), p1 = *(const LAS f32x4*)(PS + col + 4);
                f32x4 v0 = acc[ai][bj][m][0] * p0, v1 = acc[ai][bj][m][1] * p1;
                v0[0] = bf_lo(mw.x) + v0[0] * bf_lo(gw.x); v0[1] = bf_hi(mw.x) + v0[1] * bf_hi(gw.x); v0[2] = bf_lo(mw.y) + v0[2] * bf_lo(gw.y); v0[3] = bf_hi(mw.y) + v0[3] * bf_hi(gw.y);
                v1[0] = bf_lo(mw.z) + v1[0] * bf_lo(gw.z); v1[1] = bf_hi(mw.z) + v1[1] * bf_hi(gw.z); v1[2] = bf_lo(mw.w) + v1[2] * bf_lo(gw.w); v1[3] = bf_hi(mw.w) + v1[3] * bf_hi(gw.w);
                *(u32x4*)(MG + (size_t)row * 1024 + col) = pack8(v0, v1); }  EPI_ROWS_END
    }
};
struct EpiO {
    static constexpr bool PERM = true;
    bf16_t* Y; float* SSQ;
    __device__ __forceinline__ void operator()(const f32x4 (&acc)[2][2][4][2], const Unit& u, int wr, int wc, int fr, int fq) const {
        const int row0 = u.pm * 256 + wr * 64 + fr, cb = wc * 32 + 8 * fq;
        EPI_ROWS_BEGIN  float s = 0.f;
#pragma unroll
            for (int bj = 0; bj < 2; ++bj) { const f32x4 v0 = acc[ai][bj][m][0], v1 = acc[ai][bj][m][1];
                s += (v0[0] * v0[0] + v0[1] * v0[1]) + (v0[2] * v0[2] + v0[3] * v0[3]) + (v1[0] * v1[0] + v1[1] * v1[1]) + (v1[2] * v1[2] + v1[3] * v1[3]);
                *(u32x4*)(Y + (size_t)row * 1024 + u.pn * 256 + bj * 128 + cb) = pack8(v0, v1); }
            s += __shfl_xor(s, 16); s += __shfl_xor(s, 32);
            if (fq == 0) SSQ[(size_t)row * 16 + u.pn * 4 + wc] = s;  EPI_ROWS_END
    }
};
struct EpiStore {
    static constexpr bool PERM = true;
    bf16_t* O; int ld;
    __device__ __forceinline__ void operator()(const f32x4 (&acc)[2][2][4][2], const Unit& u, int wr, int wc, int fr, int fq) const {
        const int row0 = u.pm * 256 + wr * 64 + fr, cb = wc * 32 + 8 * fq;
        EPI_ROWS_BEGIN
#pragma unroll
            for (int bj = 0; bj < 2; ++bj) *(u32x4*)(O + (size_t)row * ld + u.pn * 256 + bj * 128 + cb) = pack8(acc[ai][bj][m][0], acc[ai][bj][m][1]);  EPI_ROWS_END
    }
};
struct EpiS {
    static constexpr bool PERM = true;
    float* S;
    __device__ __forceinline__ void operator()(const f32x4 (&acc)[2][2][4][2], const Unit& u, int wr, int wc, int fr, int fq) const {
        const int row0 = wr * 64 + fr, cb = wc * 32 + 8 * fq;
        EPI_ROWS_BEGIN
#pragma unroll
            for (int bj = 0; bj < 2; ++bj) { float* p = S + (size_t)row * 256 + bj * 128 + cb; *(f32x4*)p = acc[ai][bj][m][0]; *(f32x4*)(p + 4) = acc[ai][bj][m][1]; }  EPI_ROWS_END
    }
};

namespace att {
constexpr int KSTR = 400, SHM_K = 64 * KSTR, SHM_V = 16384;
constexpr int OFF_V = 0, OFF_K = 2 * SHM_V, OFF_WS = OFF_K + 2 * SHM_K, OFF_QL = OFF_WS + NWAVES * 256, NQL = 8, ATT_LDS = OFF_QL + NWAVES * NQL * 1024;
#define SBAR() __builtin_amdgcn_sched_barrier(0)
__device__ __forceinline__ int crow(int r, int hi) { return (r & 3) + 8 * (r >> 2) + 4 * hi; }
__device__ __forceinline__ int v_st(int k, int c) { const int kk = (k & ~0xC) | ((k & 4) << 1) | ((k & 8) >> 1); return ((kk >> 3) * 4 + (c >> 5)) * 512 + ((kk & 7) * 32 + (c & 31)) * 2; }
__device__ __forceinline__ int v_rd_base(int lane) { return ((lane & 3) << 3) | (((lane >> 2) & 3) << 6) | (((lane >> 4) & 1) << 5) | (((lane >> 5) & 1) << 8); }
constexpr int v_rd_off(int d0, int ks, int half) { return d0 * 512 + ks * 4096 + half * 2048; }
template <int OFF> __device__ __forceinline__ s16x4 tr_read(int vb) { s16x4 r; asm volatile("ds_read_b64_tr_b16 %0, %1 offset:%2" : "=&v"(r) : "v"(vb), "i"(OFF) : "memory"); return r; }
template <int D0> __device__ __forceinline__ void pv_one(f32x16& od, int vb, bf16x8 pa0, bf16x8 pa1, bf16x8 pa2, bf16x8 pa3) {
    const s16x4 l0 = tr_read<v_rd_off(D0, 0, 0)>(vb), h0 = tr_read<v_rd_off(D0, 0, 1)>(vb), l1 = tr_read<v_rd_off(D0, 1, 0)>(vb), h1 = tr_read<v_rd_off(D0, 1, 1)>(vb);
    const s16x4 l2 = tr_read<v_rd_off(D0, 2, 0)>(vb), h2 = tr_read<v_rd_off(D0, 2, 1)>(vb), l3 = tr_read<v_rd_off(D0, 3, 0)>(vb), h3 = tr_read<v_rd_off(D0, 3, 1)>(vb);
    asm volatile("s_waitcnt lgkmcnt(0)" ::: "memory"); SBAR();
#define PK(L, H) (bf16x8){L[0], L[1], L[2], L[3], H[0], H[1], H[2], H[3]}
    od = __builtin_amdgcn_mfma_f32_32x32x16_bf16(pa0, PK(l0, h0), od, 0, 0, 0);
    od = __builtin_amdgcn_mfma_f32_32x32x16_bf16(pa1, PK(l1, h1), od, 0, 0, 0);
    od = __builtin_amdgcn_mfma_f32_32x32x16_bf16(pa2, PK(l2, h2), od, 0, 0, 0);
    od = __builtin_amdgcn_mfma_f32_32x32x16_bf16(pa3, PK(l3, h3), od, 0, 0, 0);
#undef PK
}
__device__ __forceinline__ void pv_d0(f32x16* o, int vb, bf16x8 pa0, bf16x8 pa1, bf16x8 pa2, bf16x8 pa3) {
    pv_one<0>(o[0], vb, pa0, pa1, pa2, pa3); pv_one<1>(o[1], vb, pa0, pa1, pa2, pa3); pv_one<2>(o[2], vb, pa0, pa1, pa2, pa3); pv_one<3>(o[3], vb, pa0, pa1, pa2, pa3);
}
constexpr float THR = 8.0f;
__device__ __forceinline__ void partialSM(f32x16& p0, f32x16& p1, float& m_reg, float& mn, float& alpha) {
    float pmax = p0[0];
#pragma unroll
    for (int r = 1; r < 16; ++r) pmax = fmaxf(pmax, p0[r]);
#pragma unroll
    for (int r = 0; r < 16; ++r) pmax = fmaxf(pmax, p1[r]);
    { auto rr = __builtin_amdgcn_permlane32_swap(__float_as_uint(pmax), __float_as_uint(pmax), false, false); pmax = fmaxf(__uint_as_float(rr[0]), __uint_as_float(rr[1])); }
    if (__builtin_expect(__all(pmax - m_reg <= THR), 1)) { mn = m_reg; alpha = 1.f; }
    else { mn = fmaxf(m_reg, pmax); alpha = __builtin_amdgcn_exp2f(m_reg - mn); m_reg = mn; }
#pragma unroll
    for (int r = 0; r < 16; ++r) { p0[r] -= mn; p1[r] -= mn; }
#pragma unroll
    for (int r = 0; r < 16; ++r) p0[r] = __builtin_amdgcn_exp2f(p0[r]);
}
__device__ __forceinline__ void finishSM(f32x16& p0, f32x16& p1, float alpha, float& l_reg, bf16x8& pa0, bf16x8& pa1, bf16x8& pa2, bf16x8& pa3) {
#pragma unroll
    for (int r = 0; r < 16; ++r) p1[r] = __builtin_amdgcn_exp2f(p1[r]);
    float ps = 0;
#pragma unroll
    for (int r = 0; r < 16; ++r) ps += p0[r];
#pragma unroll
    for (int r = 0; r < 16; ++r) ps += p1[r];
    { auto rr = __builtin_amdgcn_permlane32_swap(__float_as_uint(ps), __float_as_uint(ps), false, false); ps = __uint_as_float(rr[0]) + __uint_as_float(rr[1]); }
    l_reg = l_reg * alpha + ps;
#define PK4(P, BASE, OUT) do { unsigned a0 = cvtpk(P[BASE + 0], P[BASE + 1]), a1 = cvtpk(P[BASE + 2], P[BASE + 3]);   \
    unsigned b0 = cvtpk(P[BASE + 4], P[BASE + 5]), b1 = cvtpk(P[BASE + 6], P[BASE + 7]);                              \
    auto r0 = __builtin_amdgcn_permlane32_swap(a0, b0, false, false); auto r1 = __builtin_amdgcn_permlane32_swap(a1, b1, false, false); \
    u32x4 w = {r0[0], r1[0], r0[1], r1[1]}; OUT = *reinterpret_cast<bf16x8*>(&w); } while (0)
    PK4(p0, 0, pa0); PK4(p0, 8, pa1); PK4(p1, 0, pa2); PK4(p1, 8, pa3);
#undef PK4
}
__device__ __forceinline__ void qkt(f32x16& p0, f32x16& p1, const char* Ks, const bf16x8* qr, const char* ql, int r32, int hi) {
    p0 = f32x16{}; p1 = f32x16{};
#pragma unroll
    for (int d0 = 0; d0 < 12; ++d0) { const int cbb = (d0 * 16 + hi * 8) * 2;
        const bf16x8 b0 = *reinterpret_cast<const bf16x8*>(Ks + r32 * KSTR + cbb);
        const bf16x8 b1 = *reinterpret_cast<const bf16x8*>(Ks + (32 + r32) * KSTR + cbb);
        const bf16x8 qf = (d0 < 12 - NQL) ? qr[d0] : *reinterpret_cast<const bf16x8*>(ql + (d0 - (12 - NQL)) * 1024);
        p0 = __builtin_amdgcn_mfma_f32_32x32x16_bf16(b0, qf, p0, 0, 0, 0);
        p1 = __builtin_amdgcn_mfma_f32_32x32x16_bf16(b1, qf, p1, 0, 0, 0);
        if ((d0 & 3) == 3) SBAR(); }
}
__device__ __forceinline__ void attn_unit(const bf16_t* __restrict__ Qg, const bf16_t* __restrict__ Kb, bf16_t* __restrict__ Og, int token0, int h, char* lds) {
    const int tid = threadIdx.x, wid = tid >> 6, lane = tid & 63, r32 = lane & 31, hi = lane >> 5;
    char* V_lds = lds + OFF_V; char* K_lds = lds + OFF_K;
    float* ws = (float*)(lds + OFF_WS) + wid * 64; float* li_l = ws; float* al_l = ws + 32;
    float m_reg = -1e30f, l_reg = 0; f32x16 o[4] = {}; bf16x8 qr[12 - NQL];
    const bf16_t* Qw = Qg + (size_t)(token0 + wid * 32 + r32) * QW + h * DQK + hi * 8;
    char* ql = lds + OFF_QL + wid * (NQL * 1024) + lane * 16;
#pragma unroll
    for (int d0 = 0; d0 < 12 - NQL; ++d0) qr[d0] = *reinterpret_cast<const bf16x8*>(Qw + d0 * 16);
#pragma unroll
    for (int d0 = 12 - NQL; d0 < 12; ++d0) *reinterpret_cast<bf16x8*>(ql + (d0 - (12 - NQL)) * 1024) = *reinterpret_cast<const bf16x8*>(Qw + d0 * 16);
    const int skey = tid >> 3, sc8 = tid & 7;
    const int kst = skey * KSTR + sc8 * 16, vst = v_st(skey, sc8 * 8);
    const int vb0 = (int)(uintptr_t)V_lds + v_rd_base(lane);
    bf16x8 sA[3];
#define SLOAD(S_, t_) do { const bf16_t* tb_ = Kb + (size_t)(t_) * 64 * DQK + skey * DQK + sc8 * 8; _Pragma("unroll") for (int i = 0; i < 3; ++i) S_[i] = *reinterpret_cast<const bf16x8*>(tb_ + i * 64); } while (0)
#define SWRITE(b_, S_) do { _Pragma("unroll") for (int i = 0; i < 3; ++i) { *(bf16x8*)(K_lds + (b_) * SHM_K + kst + i * 128) = S_[i]; if (i < 2) *(bf16x8*)(V_lds + (b_) * SHM_V + vst + i * 1024) = S_[i]; } } while (0)
#define SWAIT() asm volatile("s_waitcnt vmcnt(0)" ::: "memory")
#define RESC(a) do { if (__any((a) < 1.f)) { if (hi == 0) al_l[r32] = (a); asm volatile("s_waitcnt lgkmcnt(0)" ::: "memory"); \
    _Pragma("unroll") for (int d = 0; d < 4; ++d) _Pragma("unroll") for (int r = 0; r < 16; ++r) o[d][r] *= al_l[crow(r, hi)]; } } while (0)
    f32x16 pA0, pA1, pB0, pB1; float mnA, mnB, alA, alB; bf16x8 pa0, pa1, pa2, pa3; constexpr int NT = NKEY / 64;
    SLOAD(sA, 0); asm volatile("s_waitcnt vmcnt(0)" ::: "memory"); SWRITE(0, sA); __syncthreads();
    qkt(pA0, pA1, K_lds, qr, ql, r32, hi); partialSM(pA0, pA1, m_reg, mnA, alA);
    SLOAD(sA, 1);
    SWAIT(); SWRITE(1, sA); __syncthreads();
    for (int j = 1; j + 1 < NT; j += 2) {
        SBAR(); qkt(pB0, pB1, K_lds + SHM_K, qr, ql, r32, hi);
        finishSM(pA0, pA1, alA, l_reg, pa0, pa1, pa2, pa3); SBAR();
        SLOAD(sA, j + 1); SBAR();
        pv_d0(o, vb0, pa0, pa1, pa2, pa3); partialSM(pB0, pB1, m_reg, mnB, alB);
        __syncthreads(); SWAIT(); SWRITE(0, sA);
        RESC(alB); __syncthreads();
        SBAR(); qkt(pA0, pA1, K_lds, qr, ql, r32, hi);
        finishSM(pB0, pB1, alB, l_reg, pa0, pa1, pa2, pa3); SBAR();
        SLOAD(sA, j + 2); SBAR();
        pv_d0(o, vb0 + SHM_V, pa0, pa1, pa2, pa3); partialSM(pA0, pA1, m_reg, mnA, alA);
        __syncthreads(); SWAIT(); SWRITE(1, sA);
        RESC(alA); __syncthreads();
    }
    SBAR(); qkt(pB0, pB1, K_lds + SHM_K, qr, ql, r32, hi);
    finishSM(pA0, pA1, alA, l_reg, pa0, pa1, pa2, pa3); SBAR();
    pv_d0(o, vb0, pa0, pa1, pa2, pa3); partialSM(pB0, pB1, m_reg, mnB, alB);
    __syncthreads(); RESC(alB);
    finishSM(pB0, pB1, alB, l_reg, pa0, pa1, pa2, pa3); SBAR();
    pv_d0(o, vb0 + SHM_V, pa0, pa1, pa2, pa3);
    if (hi == 0) li_l[r32] = l_reg; asm volatile("s_waitcnt lgkmcnt(0)" ::: "memory");
    float rli[16];
#pragma unroll
    for (int r = 0; r < 16; ++r) rli[r] = __builtin_amdgcn_rcpf(li_l[crow(r, hi)]);
    __syncthreads();
    int le = lane; asm volatile("" : "+v"(le));
    const int r32e = le & 31, hie = le >> 5;
    bf16_t* stg = (bf16_t*)(lds + wid * 8192) + (hie * 4) * 128 + r32e;
#pragma unroll
    for (int r = 0; r < 16; ++r) { const int orow = (r & 3) + 8 * (r >> 2);
#pragma unroll
        for (int d0 = 0; d0 < 4; ++d0) stg[orow * 128 + d0 * 32] = (bf16_t)(cvtpk(o[d0][r] * rli[r], 0.f) & 0xffffu); }
    asm volatile("s_waitcnt lgkmcnt(0)" ::: "memory");
    const bf16_t* stg2 = (const bf16_t*)(lds + wid * 8192) + (le >> 4) * 128 + (le & 15) * 8;
    bf16_t* Ow = Og + (size_t)(token0 + wid * 32 + (le >> 4)) * 1024 + h * 128 + (le & 15) * 8;
#pragma unroll
    for (int i = 0; i < 8; ++i) { const u32x4 v = *(const u32x4*)(stg2 + i * 4 * 128); *(u32x4*)(Ow + (size_t)i * 4 * 1024) = v; }
    __syncthreads();
#undef SLOAD
#undef SWRITE
#undef SWAIT
#undef RESC
}
#undef SBAR
}

struct Args { const float* in[22]; float* out; unsigned char* ws; int ph_lo, ph_hi; };

template <class RowMap>
__device__ __forceinline__ void transpose_item(const float* __restrict__ W, int K, int N, bf16_t* __restrict__ WT, LAS float* scr, int item, int lane, const RowMap& rowmap) {
    const int nblk = N / 32, kb = item / nblk, nb = item % nblk, k0 = 64 * kb, n0 = 32 * nb;
#pragma unroll 8
    for (int i = 0; i < 32; ++i) { const int kk = 2 * i + (lane >> 5); scr[kk * 33 + (lane & 31)] = W[(size_t)(k0 + kk) * N + n0 + (lane & 31)]; }
    asm volatile("s_waitcnt lgkmcnt(0)" ::: "memory");
    const int c = lane & 7;
#pragma unroll
    for (int j = 0; j < 4; ++j) { const int n = (lane >> 3) + 8 * j; const LAS float* s = scr + (8 * c) * 33 + n;
        u32x4 o; o.x = cvtpk(s[0 * 33], s[1 * 33]); o.y = cvtpk(s[2 * 33], s[3 * 33]); o.z = cvtpk(s[4 * 33], s[5 * 33]); o.w = cvtpk(s[6 * 33], s[7 * 33]);
        *(u32x4*)(WT + (size_t)rowmap(n0 + n) * K + k0 + 8 * c) = o; }
    asm volatile("s_waitcnt lgkmcnt(0)" ::: "memory");
}
struct MapIn { __device__ __forceinline__ int operator()(int n) const {
    if (n < 128) return 256 + n;
    if (n < 192) { const int s = n - 128, axis = s >> 5, e = (s >> 4) & 1, f = s & 15; return 384 + 2 * (axis * 16 + f) + e; }
    if (n < 448) return n - 192;
    if (n < 1472) return 512 + (n - 448);
    return 1536 + (n - 1472); } };
struct MapId { __device__ __forceinline__ int operator()(int n) const { return n; } };

__device__ __forceinline__ unsigned f2key(float f) { const unsigned u = __float_as_uint(f); return (u & 0x80000000u) ? ~u : (u | 0x80000000u); }
__device__ __forceinline__ float key2f(unsigned k) { const unsigned u = (k & 0x80000000u) ? (k & 0x7fffffffu) : ~k; return __uint_as_float(u); }
__device__ __forceinline__ void topk_head(const f32x4 sc, int lane, int ca, int cb, int& expert, float& gate) {
    const int j = lane & 31;
    unsigned k0 = (f2key(sc[0]) & ~0x7Fu) | (unsigned)(127 - (4 * j + 0)), k1 = (f2key(sc[1]) & ~0x7Fu) | (unsigned)(127 - (4 * j + 1));
    unsigned k2 = (f2key(sc[2]) & ~0x7Fu) | (unsigned)(127 - (4 * j + 2)), k3 = (f2key(sc[3]) & ~0x7Fu) | (unsigned)(127 - (4 * j + 3));
    unsigned mine = 0u;
#pragma unroll 1
    for (int it = 0; it < 16; ++it) {
        unsigned mx = max(max(k0, k1), max(k2, k3));
#pragma unroll
        for (int o = 1; o < 32; o <<= 1) mx = max(mx, (unsigned)__shfl_xor((int)mx, o));
        if (j == it) mine = mx;
        k0 = (k0 == mx) ? 0u : k0; k1 = (k1 == mx) ? 0u : k1; k2 = (k2 == mx) ? 0u : k2; k3 = (k3 == mx) ? 0u : k3;
    }
    const float val = key2f(mine & ~0x7Fu); const int kid = 127 - (int)(mine & 0x7Fu);
    const float s0 = __shfl(val, ca), s1 = __shfl(val, 32 + cb);
    const int i0 = __shfl(kid, ca), i1 = __shfl(kid, 32 + cb);
    const int myexp = i0 * 128 + i1;
    unsigned ck = (lane < 50) ? ((f2key(s0 + s1) & ~0x3Fu) | (unsigned)(63 - lane)) : 0u;
    unsigned best = 0u;
#pragma unroll 1
    for (int it = 0; it < 16; ++it) {
        unsigned mx = ck;
#pragma unroll
        for (int o = 1; o < 64; o <<= 1) mx = max(mx, (unsigned)__shfl_xor((int)mx, o));
        if (lane == it) best = mx;
        ck = (ck == mx) ? 0u : ck;
    }
    const float bv = key2f(best & ~0x3Fu); const int bc = 63 - (int)(best & 0x3Fu);
    expert = __shfl(myexp, bc);
    const float top = __shfl(bv, 0);
    float ex = (lane < 16) ? __builtin_amdgcn_exp2f((bv - top) * 1.4426950408889634f) : 0.f;
    float sum = ex;
#pragma unroll
    for (int o = 1; o < 16; o <<= 1) sum += __shfl_xor(sum, o);
    gate = ex / sum;
}

#define DECL_PTRS \
    unsigned char* ws = args.ws; \
    const float* x = args.in[0]; const float* cvec = args.in[1]; const float* ctx = args.in[2]; const float* c_ctx = args.in[3]; \
    const float* w_ada = args.in[4]; const float* b_ada = args.in[5]; const float* g_mix_pre = args.in[6]; const float* g_mix_post = args.in[7]; \
    const float* g_ffn_pre = args.in[8]; const float* g_ffn_post = args.in[9]; const float* w_in = args.in[10]; const float* g_q_lora = args.in[11]; \
    const float* w_uq = args.in[12]; const float* g_kv_lora = args.in[13]; const float* w_ukv = args.in[14]; const float* w_pool = args.in[15]; \
    const float* pool_scale = args.in[16]; const float* w_out = args.in[17]; const float* peer_wq = args.in[18]; const float* peer_keys = args.in[19]; \
    const float* peer_u = args.in[20]; const float* peer_v = args.in[21]; \
    float* out = args.out; \
    float* MOD = (float*)(ws + WS_MOD); float* TAB = (float*)(ws + WS_ROPE); float* SSQCQ = (float*)(ws + WS_SSQCQ); float* SSQY = (float*)(ws + WS_SSQY); \
    bf16_t* WIN = (bf16_t*)(ws + WS_WIN); bf16_t* WQ = (bf16_t*)(ws + WS_WQ); bf16_t* WUV = (bf16_t*)(ws + WS_WUV); bf16_t* WPOOL = (bf16_t*)(ws + WS_WPOOL); \
    bf16_t* KEYS = (bf16_t*)(ws + WS_KEYS); bf16_t* WOUT = (bf16_t*)(ws + WS_WOUT); bf16_t* WPQ = (bf16_t*)(ws + WS_WPQ); \
    bf16_t* PU = (bf16_t*)(ws + WS_PU); bf16_t* PV = (bf16_t*)(ws + WS_PV); \
    bf16_t* HN = (bf16_t*)(ws + WS_HN); bf16_t* OLAT = HN; bf16_t* MG = HN; bf16_t* HF = HN; \
    bf16_t* CQ = (bf16_t*)(ws + WS_CQ); int* EIDX = (int*)(ws + WS_CQ); \
    float* KVRAW = (float*)(ws + WS_KVRAW); float* EW = (float*)(ws + WS_KVRAW); \
    bf16_t* KF = (bf16_t*)(ws + WS_KF); bf16_t* XP = (bf16_t*)(ws + WS_XP); bf16_t* GT = (bf16_t*)(ws + WS_GT); bf16_t* QP = GT; \
    bf16_t* QB = (bf16_t*)(ws + WS_Q); bf16_t* POOLED = QB; bf16_t* YB = QB; float* SB = (float*)(ws + WS_S);
__global__ void __launch_bounds__(NTHREADS, 2) mk_fwd(Args args) {
    extern __shared__ __attribute__((aligned(16))) unsigned char lds[];
    const int tid = threadIdx.x, lane = tid & 63, wave = __builtin_amdgcn_readfirstlane(tid >> 6);
    const int G = gridDim.x, bx = blockIdx.x, vcu = (G % 8 == 0) ? (bx % 8) * (G / 8) + bx / 8 : bx;
    const int gw = vcu * NWAVES + wave, NGW = G * NWAVES;
    LAS unsigned char* ring = (LAS unsigned char*)lds;
    LAS float* VEC = (LAS float*)(lds + VEC_OFF);
    const int lo = args.ph_lo, hi_ = args.ph_hi;
#ifndef TAIL_MASK
#define TAIL_MASK 255
#endif
#define TM(k) if constexpr ((TAIL_MASK >> (k)) & 1)
#ifndef PH_MASK
#define PH_MASK 63
#endif
#define IN(k) (((PH_MASK >> (k)) & 1) && lo <= (k) && (k) < hi_)
#define SEAM(k) do { if (IN(k) && IN((k) + 1)) { cg::this_grid().sync(); } } while (0)


#ifndef DBG_AT
#define DBG_AT 0
#endif
#define DBG_COPY(k, SRC, LD) if (DBG_AT == (k)) { DECL_PTRS for (size_t i = (size_t)gw * 64 + lane; i < (size_t)TL * 1024 / 8; i += (size_t)NGW * 64) { const size_t row = i >> 7, c8 = i & 127; \
        const u32x4 w = *(const u32x4*)((const bf16_t*)(SRC) + row * (LD) + c8 * 8); float* o = out + row * 1024 + c8 * 8; \
        *(f32x4*)o = (f32x4){bf_lo(w.x), bf_hi(w.x), bf_lo(w.y), bf_hi(w.y)}; *(f32x4*)(o + 4) = (f32x4){bf_lo(w.z), bf_hi(w.z), bf_lo(w.w), bf_hi(w.w)}; } }

#ifndef DBG_TAIL
#define DBG_TAIL 0
#endif
#define DBG_TCOPY(k, SRC) if (DBG_TAIL == (k)) { asm volatile("s_waitcnt vmcnt(0)" ::: "memory"); __syncthreads(); for (int i = tid; i < 256 * 128; i += NTHREADS) { const size_t row = (size_t)tok0 + (i >> 7); const int c8 = i & 127; \
        const u32x4 w = *(const u32x4*)((const bf16_t*)(SRC) + row * 1024 + c8 * 8); float* o = out + row * 1024 + c8 * 8; \
        *(f32x4*)o = (f32x4){bf_lo(w.x), bf_hi(w.x), bf_lo(w.y), bf_hi(w.y)}; *(f32x4*)(o + 4) = (f32x4){bf_lo(w.z), bf_hi(w.z), bf_lo(w.w), bf_hi(w.w)}; } continue; }
    if (IN(0)) {
        DECL_PTRS
        LAS float* scr = (LAS float*)(lds + wave * 16384);
        for (int it = gw; it < 192 * 3; it += NGW) {
            const int ct = it % 192, rg = it / 192, half = lane >> 5, col = ct * 32 + (lane & 31), r0 = rg * 11;
            float acc[11];
#pragma unroll
            for (int j = 0; j < 11; ++j) acc[j] = 0.f;
            for (int kc = 0; kc < 16; ++kc) {
#pragma unroll
                for (int j = 0; j < 11; ++j) { const int r = r0 + j; const float v = (r < 32) ? cvec[(size_t)r * DM + kc * 64 + lane] : c_ctx[kc * 64 + lane];
                    scr[j * 64 + lane] = v / (1.0f + __expf(-v)); }
                asm volatile("s_waitcnt lgkmcnt(0)" ::: "memory");
#pragma unroll 4
                for (int i = 0; i < 32; ++i) { const int kk = 2 * i + half; const float w = w_ada[(size_t)(kc * 64 + kk) * 6144 + col];
#pragma unroll
                    for (int j = 0; j < 11; ++j) acc[j] += scr[j * 64 + kk] * w; }
                asm volatile("s_waitcnt lgkmcnt(0)" ::: "memory");
            }
#pragma unroll
            for (int j = 0; j < 11; ++j) { acc[j] += __shfl_xor(acc[j], 32); if (half == 0) MOD[(size_t)(r0 + j) * 6144 + col] = acc[j] + b_ada[col]; }
        }
        for (int i = gw * 64 + lane; i < 64 * 16; i += NGW * 64) { const int v = i >> 4, f = i & 15; const float inv = powf(10000.0f, -(float)f / 16.0f), ang = (float)v * inv;
            TAB[i * 2] = cosf(ang); TAB[i * 2 + 1] = sinf(ang); }
        for (int it = gw; it < 16 * 110; it += NGW) transpose_item(w_in, DM, INW, WIN, scr, it, lane, MapIn());
        for (int it = gw; it < 16 * 32; it += NGW) transpose_item(w_out, DM, DM, WOUT, scr, it, lane, MapId());
        for (int it = gw; it < 16 * 64; it += NGW) transpose_item(peer_wq, DM, 2048, WPQ, scr, it, lane, MapId());
        for (int i = gw * 64 + lane; i < 64 * 1024 / 8; i += NGW * 64) *(u32x4*)(WIN + (size_t)448 * 1024 + (size_t)i * 8) = (u32x4){0u, 0u, 0u, 0u};
        for (int it = gw; it < QW * 4; it += NGW) {
            const int n = it >> 2, r = (it & 3) * 64 + lane, h = n / DQK, cc = n - h * DQK; float v;
            if (cc < 128) { const float* a = w_uq + (size_t)r * QW + h * DQK; const float* b = w_ukv + (size_t)cc * 2048 + h * 256; float s0 = 0.f, s1 = 0.f, s2 = 0.f, s3 = 0.f;
#pragma unroll 8
                for (int d = 0; d < 128; d += 4) { const f32x4 av = *(const f32x4*)(a + d), bv = *(const f32x4*)(b + d); s0 += av[0] * bv[0]; s1 += av[1] * bv[1]; s2 += av[2] * bv[2]; s3 += av[3] * bv[3]; }
                v = (s0 + s1) + (s2 + s3); }
            else v = w_uq[(size_t)r * QW + h * DQK + 128 + rope_src(cc - 128)];
            WQ[(size_t)n * 256 + r] = (bf16_t)(cvtpk(v * g_q_lora[r], 0.f) & 0xffffu);
        }
        for (int i = gw * 64 + lane; i < 1024 * 256; i += NGW * 64) { const int n = i >> 8, k = i & 255, h = n >> 7, d = n & 127, hh = k >> 7, c = k & 127;
            const float v = (hh == (h & 1)) ? w_ukv[(size_t)c * 2048 + h * 256 + 128 + d] : 0.f; WUV[i] = (bf16_t)(cvtpk(v, 0.f) & 0xffffu); }
        for (int i = gw * 64 + lane; i < 1024 * 256; i += NGW * 64) { const int n = i >> 8, k = i & 255, g = n >> 8, d = n & 255;
            WPOOL[i] = (bf16_t)(cvtpk(w_pool[((size_t)g * 256 + k) * 256 + d], 0.f) & 0xffffu); }
        for (int i = gw * 64 + lane; i < 256 * 256; i += NGW * 64) { const int n = i >> 8, k = i & 255, p = n >> 7, key = n & 127, pp = k >> 7, c = k & 127;
            const float v = (p == pp) ? peer_keys[((size_t)p * 128 + key) * 128 + c] : 0.f; KEYS[i] = (bf16_t)(cvtpk(v, 0.f) & 0xffffu); }
        for (size_t i = (size_t)gw * 64 + lane; i < (size_t)2 * 16384 * 1024 / 8; i += (size_t)NGW * 64) {
            const bool isu = i < (size_t)16384 * 1024 / 8; const size_t j = isu ? i : i - (size_t)16384 * 1024 / 8;
            const float* s = (isu ? peer_u : peer_v) + j * 8; const f32x4 a = *(const f32x4*)s, b = *(const f32x4*)(s + 4);
            *(u32x4*)((isu ? PU : PV) + j * 8) = pack8(a, b); }
    }
    SEAM(0);

    if (IN(1)) {
        DECL_PTRS
        for (int blk = vcu; blk < 256; blk += G) {
            const int b = blk >> 3;
            __syncthreads();
            for (int k = tid; k < DM; k += NTHREADS) { const float g = g_mix_pre[k];
                VEC[k] = g * (1.0f + MOD[(size_t)b * 6144 + 1024 + k]); VEC[1024 + k] = MOD[(size_t)b * 6144 + k];
                VEC[2048 + k] = g * (1.0f + MOD[(size_t)32 * 6144 + 1024 + k]); VEC[3072 + k] = MOD[(size_t)32 * 6144 + k]; }
            __syncthreads();
            for (int rr = wave; rr < 288; rr += NWAVES) {
                const bool isc = rr >= 256; const int row = isc ? TL + blk * 32 + (rr - 256) : blk * 256 + rr;
                const float* xr = isc ? ctx + (size_t)(blk * 32 + rr - 256) * DM : x + (size_t)row * DM;
                const LAS float* Gv = VEC + (isc ? 2048 : 0); const LAS float* Sv = Gv + 1024;
                f32x4 v[4]; float s = 0.f;
#pragma unroll
                for (int j = 0; j < 4; ++j) { v[j] = *(const f32x4*)(xr + 4 * lane + 256 * j); s += (v[j][0] * v[j][0] + v[j][1] * v[j][1]) + (v[j][2] * v[j][2] + v[j][3] * v[j][3]); }
                const float rs = rsqrtf(wave_sum(s) * (1.0f / DM) + EPS);
#pragma unroll
                for (int j = 0; j < 4; ++j) { const f32x4 gg = *(const LAS f32x4*)(Gv + 4 * lane + 256 * j), sh = *(const LAS f32x4*)(Sv + 4 * lane + 256 * j);
                    const f32x4 o = v[j] * rs * gg + sh; u32x2 w; w.x = cvtpk(o[0], o[1]); w.y = cvtpk(o[2], o[3]);
                    *(u32x2*)(HN + (size_t)row * DM + 4 * lane + 256 * j) = w; }
            }
        }
    }
    SEAM(1);

    if (IN(2)) {
        DECL_PTRS
        pg8::Gemm g{HN, WIN, DM, DM, DM}; SchedIn S{G, bx}; EpiIn E{CQ, SSQCQ, KVRAW, XP, GT};
        pg8::gemm_phase<EpiIn, SchedIn, true>(ring, g, S, E);
    }
    SEAM(2);

    if (IN(3) && DBG_AT == 3) { DBG_COPY(3, GT, 2048) }
    if (IN(3) && !(DBG_AT && DBG_AT <= 3)) {
        DECL_PTRS
        for (int row = gw; row < TALL; row += NGW) {
            const bool isc = row >= TL; int b, key, t = 0;
            if (isc) { const int j = row - TL; b = j >> 8; key = j & 255; } else { b = row >> 11; t = row & 2047; key = 256 + t; }
            f32x4 v = (f32x4){0.f, 0.f, 0.f, 0.f};
            if (lane < 48) v = *(const f32x4*)(KVRAW + (size_t)row * 192 + 4 * lane);
            float s = (lane < 32) ? (v[0] * v[0] + v[1] * v[1]) + (v[2] * v[2] + v[3] * v[3]) : 0.f;
            const float rs = rsqrtf(wave_sum(s) * (1.0f / 128.0f) + EPS);
            f32x4 o;
            if (lane < 32) { const f32x4 gk = *(const f32x4*)(g_kv_lora + 4 * lane); o = v * rs * gk; }
            else if (!isc && lane < 48) { const int p0 = 2 * (lane - 32), vv = (p0 >> 4) ? (t & 63) : (t >> 6); const f32x4 tc = *(const f32x4*)(TAB + (vv * 16 + (p0 & 15)) * 2);
                o[0] = v[0] * tc[0] - v[1] * tc[1]; o[1] = v[0] * tc[1] + v[1] * tc[0]; o[2] = v[2] * tc[2] - v[3] * tc[3]; o[3] = v[2] * tc[3] + v[3] * tc[2]; }
            else o = v;
            if (lane < 48) { u32x2 w; w.x = cvtpk(o[0], o[1]); w.y = cvtpk(o[2], o[3]); *(u32x2*)(KF + ((size_t)b * NKEY + key) * DQK + 4 * lane) = w; }
        }
        pg8::Gemm g{CQ, WQ, 256, 256, 256}; SchedQ S{G, bx}; EpiQ E{QB, SSQCQ, TAB};
        pg8::gemm_phase<EpiQ, SchedQ, true>(ring, g, S, E);
    }
    SEAM(3);

    if (IN(4) && !(DBG_AT && DBG_AT <= 4)) {
        DECL_PTRS
        const int ipb = (2048 + G - 1) / G;
        for (int i = 0; i < ipb; ++i) { const int uid = vcu * ipb + i; if (uid >= 2048) break;
            const int b = uid >> 6, rem = uid & 63, h = rem >> 3, qb = rem & 7;
            att::attn_unit(QB, KF + (size_t)b * NKEY * DQK, OLAT, b * SEQ + qb * 256, h, (char*)lds); }
    }
    SEAM(4);

    if (IN(5) && DBG_AT == 5) { DBG_COPY(5, OLAT, 1024) }
    if (IN(5) && !(DBG_AT && DBG_AT <= 5)) {
        DECL_PTRS
        for (int pm = vcu; pm < 256; pm += G) {
            const int b = pm >> 3, tok0 = pm * 256;
            __syncthreads();
            for (int k = tid; k < DM; k += NTHREADS) { const float* mb = MOD + (size_t)b * 6144;
                VEC[k] = mb[2048 + k] * g_mix_post[k];
                VEC[1024 + k] = g_ffn_pre[k] * (1.0f + mb[4096 + k]);
                VEC[2048 + k] = mb[3072 + k];
                VEC[3072 + k] = mb[5120 + k] * g_ffn_post[k];
                VEC[4096 + k] = pool_scale[k]; }
            TM(0) { int td = tid; asm volatile("" : "+v"(td)); const int g = td >> 7, hw = 1 << g, s0 = (pm & 7) * 256; const unsigned* xp32 = (const unsigned*)XP + (size_t)b * SEQ * 512 + td; unsigned* po = (unsigned*)POOLED + (size_t)b * SEQ * 512 + td;
              float sa = 0.f, sb = 0.f; { const int l0 = max(s0 - hw, 0), h0 = min(s0 + hw, SEQ); for (int j = l0; j < h0; ++j) { const unsigned w = xp32[(size_t)j * 512]; sa += bf_lo(w); sb += bf_hi(w); } }
#pragma unroll 4
              for (int s = s0; s < s0 + 256; ++s) { const int l0 = max(s - hw, 0), h0 = min(s + hw, SEQ); const float rc = 1.0f / (float)(h0 - l0);
                  const unsigned w = xp32[(size_t)s * 512]; po[(size_t)s * 512] = cvtpk(sa * rc - bf_lo(w), sb * rc - bf_hi(w));
                  if (s + hw < SEQ) { const unsigned wn = xp32[(size_t)(s + hw) * 512]; sa += bf_lo(wn); sb += bf_hi(wn); }
                  if (s - hw >= 0) { const unsigned wo = xp32[(size_t)(s - hw) * 512]; sa -= bf_lo(wo); sb -= bf_hi(wo); } } }
            asm volatile("s_waitcnt vmcnt(0)" ::: "memory"); __syncthreads();
            DBG_TCOPY(1, POOLED)
            TM(1) { pg8::Gemm g{OLAT, WUV, DM, 256, 256}; SchedRow S{pm, 0, 4, (long)tok0 * DM * 2, 512, 0, 256 * 256 * 2}; EpiU E{MG, GT}; pg8::gemm_phase<EpiU, SchedRow, true>(ring, g, S, E); }
            DBG_TCOPY(4, MG)
            TM(2) { pg8::Gemm g{POOLED, WPOOL, DM, 256, 256}; SchedRow S{pm, 0, 4, (long)tok0 * DM * 2, 512, 0, 256 * 256 * 2}; EpiP E{MG, GT, VEC + 4096}; pg8::gemm_phase<EpiP, SchedRow, true>(ring, g, S, E); }
            DBG_TCOPY(2, MG)
            TM(3) { pg8::Gemm g{MG, WOUT, DM, DM, DM}; SchedRow S{pm, 0, 4, (long)tok0 * DM * 2, 0, 0, 256 * DM * 2}; EpiO E{YB, SSQY}; pg8::gemm_phase<EpiO, SchedRow, true>(ring, g, S, E); }
            DBG_TCOPY(3, YB)
            TM(4) for (int rr = wave * 32; rr < wave * 32 + 32; ++rr) {
                int ln = lane; asm volatile("" : "+v"(ln));
                const size_t row = (size_t)tok0 + rr; const int c0 = 8 * ln, c1 = 512 + 8 * ln;
                const f32x4 q0 = *(const f32x4*)(SSQY + row * 16), q1 = *(const f32x4*)(SSQY + row * 16 + 4), q2 = *(const f32x4*)(SSQY + row * 16 + 8), q3 = *(const f32x4*)(SSQY + row * 16 + 12);
                const f32x4 qs = (q0 + q1) + (q2 + q3); const float ry = rsqrtf(((qs[0] + qs[1]) + (qs[2] + qs[3])) * (1.0f / DM) + EPS);
                const u32x4 y0 = *(const u32x4*)(YB + row * DM + c0), y1 = *(const u32x4*)(YB + row * DM + c1);
                float xm[16]; float yv[16] = {bf_lo(y0.x), bf_hi(y0.x), bf_lo(y0.y), bf_hi(y0.y), bf_lo(y0.z), bf_hi(y0.z), bf_lo(y0.w), bf_hi(y0.w), bf_lo(y1.x), bf_hi(y1.x), bf_lo(y1.y), bf_hi(y1.y), bf_lo(y1.z), bf_hi(y1.z), bf_lo(y1.w), bf_hi(y1.w)};
                float s = 0.f;
#pragma unroll
                for (int q = 0; q < 4; ++q) { const int cc = (q < 2 ? c0 : c1) + (q & 1) * 4; const f32x4 xv = *(const f32x4*)(x + row * DM + cc), a1 = *(const LAS f32x4*)(VEC + cc);
#pragma unroll
                    for (int e = 0; e < 4; ++e) { const float m_ = xv[e] + a1[e] * (yv[q * 4 + e] * ry); xm[q * 4 + e] = m_; s += m_ * m_; }
                    *(f32x4*)(out + row * DM + cc) = (f32x4){xm[q * 4], xm[q * 4 + 1], xm[q * 4 + 2], xm[q * 4 + 3]}; }
                const float rm = rsqrtf(wave_sum(s) * (1.0f / DM) + EPS);
                u32x4 h0, h1; float hv[16];
#pragma unroll
                for (int q = 0; q < 4; ++q) { const int cc = (q < 2 ? c0 : c1) + (q & 1) * 4; const f32x4 a2 = *(const LAS f32x4*)(VEC + 1024 + cc), a3 = *(const LAS f32x4*)(VEC + 2048 + cc);
#pragma unroll
                    for (int e = 0; e < 4; ++e) hv[q * 4 + e] = xm[q * 4 + e] * rm * a2[e] + a3[e]; }
                h0.x = cvtpk(hv[0], hv[1]); h0.y = cvtpk(hv[2], hv[3]); h0.z = cvtpk(hv[4], hv[5]); h0.w = cvtpk(hv[6], hv[7]);
                h1.x = cvtpk(hv[8], hv[9]); h1.y = cvtpk(hv[10], hv[11]); h1.z = cvtpk(hv[12], hv[13]); h1.w = cvtpk(hv[14], hv[15]);
                *(u32x4*)(HF + row * DM + c0) = h0; *(u32x4*)(HF + row * DM + c1) = h1;
            }
            asm volatile("s_waitcnt vmcnt(0)" ::: "memory"); __syncthreads();
            TM(5) { pg8::Gemm g{HF, WPQ, DM, DM, DM}; SchedRow S{pm, 0, 8, (long)tok0 * DM * 2, 0, 0, 256 * DM * 2}; EpiStore E{QP, 2048}; pg8::gemm_phase<EpiStore, SchedRow, true>(ring, g, S, E); }
            float* Sblk = SB + (size_t)pm * 65536;
            TM(6) for (int h = 0; h < NH; ++h) {
                { pg8::Gemm g{QP, KEYS, 2048, 256, 256}; SchedRow S{pm, h, 1, (long)tok0 * 2048 * 2, 512, 0, 0}; EpiS E{Sblk}; pg8::gemm_phase<EpiS, SchedRow, true>(ring, g, S, E); }
                int ln = lane; asm volatile("" : "+v"(ln));
                int ca, cb; { const int c = ln; const int a = (c >= 16) + (c >= 24) + (c >= 29) + (c >= 33) + (c >= 36) + (c >= 38) + (c >= 40) + (c >= 42);
                    const int offs = (a == 0) ? 0 : (a == 1) ? 16 : (a == 2) ? 24 : (a == 3) ? 29 : (a == 4) ? 33 : (a == 5) ? 36 : (a == 6) ? 38 : (a == 7) ? 40 : 42;
                    if (c >= 42) { ca = min(8 + (c - 42), 15); cb = 0; } else { ca = a; cb = c - offs; } }
                for (int rr = wave * 32; rr < wave * 32 + 32; ++rr) {
                    const f32x4 sc = *(const f32x4*)(Sblk + (size_t)rr * 256 + (ln >> 5) * 128 + 4 * (ln & 31));
                    int ex; float gt; topk_head(sc, ln, ca, cb, ex, gt);
                    if (ln < 16) { EIDX[((size_t)tok0 + rr) * 128 + h * 16 + ln] = ex; EW[((size_t)tok0 + rr) * 128 + h * 16 + ln] = gt; }
                }
                asm volatile("s_waitcnt vmcnt(0)" ::: "memory"); __syncthreads();
            }
            TM(7) for (int rr = wave * 32; rr < wave * 32 + 32; ++rr) {
                int ln = lane; asm volatile("" : "+v"(ln));
                const size_t row = (size_t)tok0 + rr; const int c0 = 8 * ln, c1 = 512 + 8 * ln;
                const int idA = EIDX[row * 128 + ln], idB = EIDX[row * 128 + 64 + ln]; const float wA = EW[row * 128 + ln], wB = EW[row * 128 + 64 + ln];
                const u32x4 xa = *(const u32x4*)(HF + row * DM + c0), xb = *(const u32x4*)(HF + row * DM + c1);
                float dA = 0.f, dB = 0.f;
#pragma unroll 2
                for (int q = 0; q < 16; ++q) {
                    float r[8];
#pragma unroll
                    for (int i = 0; i < 8; ++i) { const int id = __builtin_amdgcn_readlane((q < 8) ? idA : idB, (q & 7) * 8 + i); const u32x4* up = (const u32x4*)(PU + (size_t)id * DM) + ln;
                        const u32x4 u0 = up[0], u1 = up[64]; float d = dot2(u0.x, xa.x, 0.f); d = dot2(u0.y, xa.y, d); d = dot2(u0.z, xa.z, d); d = dot2(u0.w, xa.w, d);
                        d = dot2(u1.x, xb.x, d); d = dot2(u1.y, xb.y, d); d = dot2(u1.z, xb.z, d); d = dot2(u1.w, xb.w, d); r[i] = d; }
                    float r4[4], r2[2], r1;
#pragma unroll
                    for (int i = 0; i < 4; ++i) { const bool b0 = ln & 1; const float keep = b0 ? r[2 * i + 1] : r[2 * i], send = b0 ? r[2 * i] : r[2 * i + 1]; r4[i] = keep + __shfl_xor(send, 1); }
#pragma unroll
                    for (int i = 0; i < 2; ++i) { const bool b1 = ln & 2; const float keep = b1 ? r4[2 * i + 1] : r4[2 * i], send = b1 ? r4[2 * i] : r4[2 * i + 1]; r2[i] = keep + __shfl_xor(send, 2); }
                    { const bool b2 = ln & 4; const float keep = b2 ? r2[1] : r2[0], send = b2 ? r2[0] : r2[1]; r1 = keep + __shfl_xor(send, 4); }
                    r1 += __shfl_xor(r1, 8); r1 += __shfl_xor(r1, 16); r1 += __shfl_xor(r1, 32);
                    if ((ln >> 3) == (q & 7)) { if (q < 8) dA = r1; else dB = r1; }
                }
                const float aA = 0.5f * dA * (1.0f + erff(dA * 0.70710678118654752f)) * wA, aB = 0.5f * dB * (1.0f + erff(dB * 0.70710678118654752f)) * wB;
                float acc[16];
#pragma unroll
                for (int i = 0; i < 16; ++i) acc[i] = 0.f;
#pragma unroll 2
                for (int q = 0; q < 16; ++q) {
#pragma unroll
                    for (int i = 0; i < 8; ++i) { const int sl = (q & 7) * 8 + i; const int id = __builtin_amdgcn_readlane((q < 8) ? idA : idB, sl);
                        const float a = __uint_as_float(__builtin_amdgcn_readlane(__float_as_uint((q < 8) ? aA : aB), sl));
                        const u32x4* vp = (const u32x4*)(PV + (size_t)id * DM) + ln; const u32x4 v0 = vp[0], v1 = vp[64];
                        acc[0] += a * bf_lo(v0.x); acc[1] += a * bf_hi(v0.x); acc[2] += a * bf_lo(v0.y); acc[3] += a * bf_hi(v0.y); acc[4] += a * bf_lo(v0.z); acc[5] += a * bf_hi(v0.z); acc[6] += a * bf_lo(v0.w); acc[7] += a * bf_hi(v0.w);
                        acc[8] += a * bf_lo(v1.x); acc[9] += a * bf_hi(v1.x); acc[10] += a * bf_lo(v1.y); acc[11] += a * bf_hi(v1.y); acc[12] += a * bf_lo(v1.z); acc[13] += a * bf_hi(v1.z); acc[14] += a * bf_lo(v1.w); acc[15] += a * bf_hi(v1.w); }
                }
                float s = 0.f;
#pragma unroll
                for (int i = 0; i < 16; ++i) s += acc[i] * acc[i];
                const float rp = rsqrtf(wave_sum(s) * (1.0f / DM) + EPS);
#pragma unroll
                for (int q = 0; q < 4; ++q) { const int cc = (q < 2 ? c0 : c1) + (q & 1) * 4; const f32x4 a4 = *(const LAS f32x4*)(VEC + 3072 + cc); f32x4 xm = *(const f32x4*)(out + row * DM + cc);
#pragma unroll
                    for (int e = 0; e < 4; ++e) xm[e] += a4[e] * (acc[q * 4 + e] * rp);
                    *(f32x4*)(out + row * DM + cc) = xm; }
            }
        }
    }
#undef IN
#undef SEAM
}

extern "C" void kernel_launch(void* const* d_in, const int* in_sizes, int n_in, void* d_out, int out_size, void* d_ws, size_t ws_size, hipStream_t stream) {
    static int grid = 0;
    if (grid == 0) {
        if (n_in != 22 || out_size != TL * DM || ws_size < WS_END) { fprintf(stderr, "kernel_launch: unexpected shapes: n_in %d out %d ws %zu (need %zu)\n", n_in, out_size, ws_size, (size_t)WS_END); grid = -1; return; }
        int dev = 0, cus = 0, per_cu = 0;
        hipGetDevice(&dev); hipDeviceGetAttribute(&cus, hipDeviceAttributeMultiprocessorCount, dev);
        hipFuncSetAttribute((const void*)mk_fwd, hipFuncAttributeMaxDynamicSharedMemorySize, LDS_BYTES);
        hipOccupancyMaxActiveBlocksPerMultiprocessor(&per_cu, (const void*)mk_fwd, NTHREADS, LDS_BYTES);
        (void)hipGetLastError();
        if (per_cu < 1) { fprintf(stderr, "kernel_launch: occupancy query says %d blocks per CU\n", per_cu); }
        grid = cus;
    }
    if (grid < 0) return;
    Args a{};
    for (int i = 0; i < 22; ++i) a.in[i] = (const float*)d_in[i];
    a.out = (float*)d_out; a.ws = (unsigned char*)d_ws;
    if (MK_N_LAUNCHES == 1) {
        a.ph_lo = 0; a.ph_hi = 6; void* kargs[] = {&a};
        hipError_t e = hipLaunchCooperativeKernel((const void*)mk_fwd, dim3(grid), dim3(NTHREADS), kargs, LDS_BYTES, stream);
        if (e != hipSuccess) fprintf(stderr, "cooperative launch failed: %s (grid %d)\n", hipGetErrorString(e), grid);
    } else {
        for (int p = 0; p < 6; ++p) { a.ph_lo = p; a.ph_hi = p + 1; hipLaunchKernelGGL(mk_fwd, dim3(grid), dim3(NTHREADS), LDS_BYTES, stream, a); }
    }
}
```

```cpp
#include <hip/hip_runtime.h>
#include <hip/hip_cooperative_groups.h>
#include <cstdint>
#include <cstdio>
namespace cg = cooperative_groups;

#ifndef PEER_I8
#define PEER_I8 1
#endif
#ifndef PEER_FOLD
#define PEER_FOLD 1
#endif
#ifndef S_I16
#define S_I16 1
#endif
#ifndef PEER_XCD
#define PEER_XCD 1
#endif
#ifndef PEER_FP8
#define PEER_FP8 1
#endif
#ifndef MK_N_LAUNCHES
#define MK_N_LAUNCHES 1
#endif

#define LAS __attribute__((address_space(3)))
typedef unsigned short bf16_t;
typedef short bf16x8 __attribute__((ext_vector_type(8)));
typedef short s16x4 __attribute__((ext_vector_type(4)));
typedef float f32x2 __attribute__((ext_vector_type(2)));
typedef float f32x4 __attribute__((ext_vector_type(4)));
typedef float f32x16 __attribute__((ext_vector_type(16)));
typedef unsigned u32x2 __attribute__((ext_vector_type(2)));
typedef unsigned u32x4 __attribute__((ext_vector_type(4)));
typedef __bf16 bf16x2_t __attribute__((ext_vector_type(2)));
typedef short s16x2 __attribute__((ext_vector_type(2)));

constexpr int DM = 1024, NB = 32, SEQ = 2048, CTXL = 256, TL = NB * SEQ, TC = NB * CTXL, TALL = TL + TC;
constexpr int NH = 8, DQK = 192, QW = NH * DQK, NKEY = CTXL + SEQ;
constexpr int NWIN = 3584;
constexpr int INW = 3520;
constexpr float EPS = 1e-6f;
constexpr float C2 = 0.07216878364870323f * 1.4426950408889634f;
constexpr int NWAVES = 8, NTHREADS = 512;

constexpr size_t MiB = 1u << 20;
constexpr size_t WS_MOD = 1 * MiB;
constexpr size_t WS_USCALE = 1 * MiB;
constexpr size_t WS_XSCALE = 1 * MiB + 128 * 1024;
constexpr size_t WS_ROPE = 2 * MiB;
constexpr size_t WS_SSQCQ = 3 * MiB;
constexpr size_t WS_SSQY = 4 * MiB;
constexpr size_t WS_WIN = 8 * MiB;
constexpr size_t WS_WQ = 15 * MiB;
constexpr size_t WS_WUV = 16 * MiB;
constexpr size_t WS_WPOOL = 16 * MiB + 512 * 1024;
constexpr size_t WS_KEYS = 17 * MiB;
constexpr size_t WS_WOUT = 18 * MiB;
constexpr size_t WS_WPQ = 20 * MiB;
constexpr size_t WS_PU = 24 * MiB;
constexpr size_t WS_PV = 56 * MiB;
constexpr size_t WS_HN = 88 * MiB;
constexpr size_t WS_CQ = 232 * MiB;
constexpr size_t WS_KVRAW = 264 * MiB;
constexpr size_t WS_KF = 318 * MiB;
constexpr size_t WS_XP = 345 * MiB;
constexpr size_t WS_GT = 473 * MiB;
constexpr size_t WS_Q = 729 * MiB;
constexpr size_t WS_S = WS_Q + 128 * MiB;
constexpr size_t WS_HF8 = WS_Q + 128 * MiB;
constexpr size_t WS_MODP = 922 * MiB;
constexpr size_t WS_XM_LO = 926 * MiB;
constexpr size_t WS_XM_HI = 296 * MiB;
constexpr size_t WS_END = 1022 * MiB;
__device__ __forceinline__ size_t xm_off(size_t row) { return row < 49152 ? WS_XM_LO + row * 2048 : WS_XM_HI + (row - 49152) * 2048; }

constexpr int RING_BYTES = 131072;
constexpr int VEC_OFF = RING_BYTES;
constexpr int MISC_OFF = 163840 - 1024;
constexpr int LDS_BYTES = 163840;

__device__ __forceinline__ unsigned cvtpk(float lo, float hi) { f32x2 v = {lo, hi}; bf16x2_t b = __builtin_convertvector(v, bf16x2_t); return __builtin_bit_cast(unsigned, b); }
__device__ __forceinline__ float bf_lo(unsigned w) { return __uint_as_float(w << 16); }
__device__ __forceinline__ float bf_hi(unsigned w) { return __uint_as_float(w & 0xffff0000u); }
__device__ __forceinline__ float wave_sum(float v) {
#pragma unroll
    for (int o = 1; o < 64; o <<= 1) v += __shfl_xor(v, o);
    return v;
}
__device__ __forceinline__ float wave_max(float v) {
#pragma unroll
    for (int o = 1; o < 64; o <<= 1) v = fmaxf(v, __shfl_xor(v, o));
    return v;
}
__device__ __forceinline__ unsigned pack_i8(float a, float b, float c, float d) {
    const int q0 = (int)__builtin_rintf(a), q1 = (int)__builtin_rintf(b), q2 = (int)__builtin_rintf(c), q3 = (int)__builtin_rintf(d);
    return (unsigned)(q0 & 255) | ((unsigned)(q1 & 255) << 8) | ((unsigned)(q2 & 255) << 16) | ((unsigned)q3 << 24); }
__device__ __forceinline__ float dot2(unsigned a, unsigned b, float c) { return __builtin_amdgcn_fdot2_f32_bf16(__builtin_bit_cast(bf16x2_t, a), __builtin_bit_cast(bf16x2_t, b), c, false); }
__device__ __forceinline__ float fast_sigmoid(float x) { return __builtin_amdgcn_rcpf(1.0f + __builtin_amdgcn_exp2f(-1.4426950408889634f * x)); }
__host__ __device__ __forceinline__ int rope_src(int j) { const int p = j >> 1; return (p >> 4) * 32 + (j & 1) * 16 + (p & 15); }

namespace pg8 {
constexpr int BM = 256, BK = 64, HALF = 128, HTB = HALF * BK * 2, STAGE_BYTES = 8 * HTB, NXCD = 8, WGM = 8;
__host__ __device__ __forceinline__ int lds_byte(int r, int c) { const int st = (r >> 4) * 2 + (c >> 5), rr = r & 15, cc = c & 31, ob = rr * 64 + cc * 2; return st * 1024 + (ob ^ (((ob >> 9) & 1) << 5)); }
__host__ __device__ __forceinline__ void stage_rc(int b, int& R, int& C) { const int st = b / 1024, sb = b % 1024, swz = sb ^ (((sb >> 9) & 1) << 5); R = (st >> 1) * 16 + swz / 64; C = (st & 1) * 32 + (swz % 64) / 2; }
__host__ __device__ __forceinline__ int perm32(int rho) { const int n = rho >> 4, i = rho & 15; return 8 * (i >> 2) + 4 * n + (i & 3); }

struct Unit { int pm, pn; long aoff, boff; };
struct Gemm { const bf16_t* A; const bf16_t* Bt; int lda, ldb, K; };

__device__ __forceinline__ bool grouped_tile(long L, int nM, int nN, int& pm, int& pn) {
    const int nwg = nM * nN; if (L >= nwg) return false;
    int wgid = (int)L; { const int q = nwg / NXCD, r = nwg % NXCD, xcd = wgid % NXCD, off = wgid / NXCD; wgid = (xcd < r ? xcd * (q + 1) : r * (q + 1) + (xcd - r) * q) + off; }
    const int nig = WGM * nN, gid = wgid / nig, fm = gid * WGM, gsz = (nM - fm) < WGM ? (nM - fm) : WGM;
    pm = fm + ((wgid % nig) % gsz); pn = (wgid % nig) / gsz; return true;
}

template <class Epi, class Sched, bool ALIGN_EPI>
__device__ __forceinline__ void gemm_phase(LAS unsigned char* lds, const Gemm g, const Sched& S, const Epi& E) {
    int tid = threadIdx.x; asm volatile("" : "+v"(tid));
    const int wid = __builtin_amdgcn_readfirstlane(tid >> 6), lane = tid & 63, wr = wid >> 2, wc = wid & 3, fr = lane & 15, fq = lane >> 4;
    const int nt = g.K / BK;
    unsigned voffA[2], voffB[2];
#pragma unroll
    for (int i = 0; i < 2; ++i) { int R, C; stage_rc(tid * 16 + i * 8192, R, C); const int Rb = Epi::PERM ? ((R & ~31) + perm32(R & 31)) : R;
        voffA[i] = (unsigned)(R * g.lda + C) * 2u; voffB[i] = (unsigned)(Rb * g.ldb + C) * 2u; }
    const size_t kstep = (size_t)(BK * 2);
    const size_t hA = (size_t)HALF * g.lda * 2, hB = (size_t)HALF * g.ldb * 2;
    const unsigned ldsw = (unsigned)wid * 1024u;
    const int aoff = lds_byte(wr * 64 + fr, fq * 8), boff = lds_byte(wc * 32 + fr, fq * 8);
#define PG8_SA(b, h) (((b) * 2 + (h)) * HTB)
#define PG8_SB(b, h) ((4 + (b) * 2 + (h)) * HTB)
#define PG8_STAGE(bufoff, gbase, voff) do { _Pragma("unroll") for (int _i = 0; _i < 2; ++_i) \
        __builtin_amdgcn_global_load_lds((const unsigned*)((const char*)(gbase) + (voff)[_i]), (LAS unsigned*)(lds + (bufoff) + ldsw + _i * 8192), 16, 0, 0); } while (0)
#define PG8_LDA(dst, b, h) do { _Pragma("unroll") for (int m = 0; m < 4; ++m) _Pragma("unroll") for (int k = 0; k < 2; ++k) dst[m][k] = *(const LAS bf16x8*)(lds + PG8_SA(b, h) + aoff + m * 2048 + k * 1024); } while (0)
#define PG8_LDB(dst, b, h) do { _Pragma("unroll") for (int n = 0; n < 2; ++n) _Pragma("unroll") for (int k = 0; k < 2; ++k) dst[n][k] = *(const LAS bf16x8*)(lds + PG8_SB(b, h) + boff + n * 2048 + k * 1024); } while (0)
#define PG8_MMA(ai, bj, At, Bt) do { __builtin_amdgcn_s_setprio(1); _Pragma("unroll") for (int m = 0; m < 4; ++m) _Pragma("unroll") for (int n = 0; n < 2; ++n) _Pragma("unroll") for (int k = 0; k < 2; ++k) \
        acc[ai][bj][m][n] = __builtin_amdgcn_mfma_f32_16x16x32_bf16(Bt[n][k], At[m][k], acc[ai][bj][m][n], 0, 0, 0); __builtin_amdgcn_s_setprio(0); } while (0)
#define PG8_WAIT_V(n) asm volatile("s_waitcnt vmcnt(" #n ")" ::: "memory")
#define PG8_WAIT_L(n) asm volatile("s_waitcnt lgkmcnt(" #n ")" ::: "memory")
#define PG8_BAR __builtin_amdgcn_s_barrier()
#define PG8_SCHED __builtin_amdgcn_sched_barrier(0)
    Unit cur, nxt; int ui = 0;
    if (!S.next(0, cur)) return;
    f32x4 acc[2][2][4][2];
#pragma unroll
    for (int a = 0; a < 2; ++a)
#pragma unroll
        for (int b = 0; b < 2; ++b)
#pragma unroll
            for (int m = 0; m < 4; ++m)
#pragma unroll
                for (int n = 0; n < 2; ++n) acc[a][b][m][n] = (f32x4){0.f, 0.f, 0.f, 0.f};
    bf16x8 At[4][2], B0[2][2], B1[2][2];
    const char* cA = (const char*)g.A + cur.aoff; const char* cB = (const char*)g.Bt + cur.boff;
    PG8_STAGE(PG8_SB(0, 0), cB, voffB); PG8_STAGE(PG8_SB(0, 1), cB + hB, voffB); PG8_STAGE(PG8_SA(0, 0), cA, voffA); PG8_STAGE(PG8_SA(0, 1), cA + hA, voffA);
    if (wr == 1) PG8_BAR;
    PG8_WAIT_V(2); PG8_BAR;
    PG8_STAGE(PG8_SB(1, 0), cB + kstep, voffB); PG8_STAGE(PG8_SA(1, 0), cA + kstep, voffA); PG8_STAGE(PG8_SB(1, 1), cB + hB + kstep, voffB);
    PG8_WAIT_V(6); PG8_BAR;
    for (;;) {
        const bool has_next = S.next(ui + 1, nxt);
        const char* nA = has_next ? (const char*)g.A + nxt.aoff : cA; const char* nB = has_next ? (const char*)g.Bt + nxt.boff : cB;
#pragma nounroll
        for (int t = 0; t < nt; t += 2) {
            const bool last = (t == nt - 2);
            const char* a1 = cA + (size_t)(t + 1) * kstep;
            const char* a2 = last ? nA : cA + (size_t)(t + 2) * kstep; const char* b2 = last ? nB : cB + (size_t)(t + 2) * kstep;
            const char* a3 = a2 + kstep; const char* b3 = b2 + kstep;
            PG8_LDB(B0, 0, 0); PG8_LDB(B1, 0, 1); PG8_SCHED; PG8_LDA(At, 0, 0); PG8_STAGE(PG8_SA(1, 1), a1 + hA, voffA);
            PG8_WAIT_V(8); PG8_WAIT_L(0); PG8_BAR; PG8_MMA(0, 0, At, B0); PG8_MMA(0, 1, At, B1); PG8_BAR; PG8_SCHED;
            PG8_LDA(At, 0, 1); PG8_STAGE(PG8_SB(0, 0), b2, voffB); PG8_STAGE(PG8_SB(0, 1), b2 + hB, voffB); PG8_STAGE(PG8_SA(0, 0), a2, voffA);
            PG8_WAIT_V(8); PG8_WAIT_L(0); PG8_BAR; PG8_MMA(1, 0, At, B0); PG8_MMA(1, 1, At, B1); PG8_BAR; PG8_SCHED;
            PG8_LDB(B0, 1, 0); PG8_LDB(B1, 1, 1); PG8_SCHED; PG8_LDA(At, 1, 0); PG8_STAGE(PG8_SA(0, 1), a2 + hA, voffA);
            PG8_WAIT_V(8); PG8_WAIT_L(0); PG8_BAR; PG8_MMA(0, 0, At, B0); PG8_MMA(0, 1, At, B1); PG8_BAR; PG8_SCHED;
            PG8_LDA(At, 1, 1); PG8_STAGE(PG8_SB(1, 0), b3, voffB); PG8_STAGE(PG8_SB(1, 1), b3 + hB, voffB); PG8_STAGE(PG8_SA(1, 0), a3, voffA);
            PG8_WAIT_V(8); PG8_WAIT_L(0); PG8_BAR; PG8_MMA(1, 0, At, B0); PG8_MMA(1, 1, At, B1); PG8_BAR; PG8_SCHED;
        }
        if constexpr (ALIGN_EPI) { if (wr == 0) PG8_BAR; }
        E(acc, cur, wr, wc, fr, fq);
        if (!has_next) break;
#pragma unroll
        for (int a = 0; a < 2; ++a)
#pragma unroll
            for (int b = 0; b < 2; ++b)
#pragma unroll
                for (int m = 0; m < 4; ++m)
#pragma unroll
                    for (int n = 0; n < 2; ++n) acc[a][b][m][n] = (f32x4){0.f, 0.f, 0.f, 0.f};
        cur = nxt; cA = nA; cB = nB; ++ui;
        if constexpr (ALIGN_EPI) { if (wr == 1) PG8_BAR; }
    }
    PG8_WAIT_V(0);
    if constexpr (!ALIGN_EPI) { if (wr == 0) PG8_BAR; }
    PG8_BAR;
#undef PG8_SA
#undef PG8_SB
#undef PG8_STAGE
#undef PG8_LDA
#undef PG8_LDB
#undef PG8_MMA
#undef PG8_WAIT_V
#undef PG8_WAIT_L
#undef PG8_BAR
#undef PG8_SCHED
}
}
using pg8::Unit;

struct SchedIn {
    int G, c;
    __device__ __forceinline__ bool next(int i, Unit& u) const {
        const long L = (long)i * G + c; if (L >= 256 * 14 + 32) return false;
        int pm, pn;
        if (L < 256 * 14) pg8::grouped_tile(L, 256, 14, pm, pn); else { pm = 256 + (int)(L - 256 * 14); pn = 1; }
        u.pm = pm; u.pn = pn; u.aoff = (long)pm * 256 * DM * 2; u.boff = (long)pn * 256 * DM * 2; return true;
    }
};
struct SchedQ {
    int G, c;
    __device__ __forceinline__ bool next(int i, Unit& u) const {
        const long L = (long)i * G + c; int pm, pn; if (!pg8::grouped_tile(L, 256, 6, pm, pn)) return false;
        u.pm = pm; u.pn = pn; u.aoff = (long)pm * 256 * 256 * 2; u.boff = (long)pn * 256 * 256 * 2; return true;
    }
};
struct SchedRow {
    int pm, pn0, n; long a_base, a_pn, b_base, b_pn;
    __device__ __forceinline__ bool next(int i, Unit& u) const {
        if (i >= n) return false; u.pm = pm; u.pn = pn0 + i; u.aoff = a_base + (long)(pn0 + i) * a_pn; u.boff = b_base + (long)(pn0 + i) * b_pn; return true;
    }
};

#define EPI_ROWS_BEGIN _Pragma("unroll") for (int ai = 0; ai < 2; ++ai) _Pragma("unroll") for (int m = 0; m < 4; ++m) { const int row = row0 + ai * 128 + m * 16;
#define EPI_ROWS_END asm volatile("" ::: "memory"); }
__device__ __forceinline__ u32x4 pack8(f32x4 v0, f32x4 v1) { u32x4 w; w.x = cvtpk(v0[0], v0[1]); w.y = cvtpk(v0[2], v0[3]); w.z = cvtpk(v1[0], v1[1]); w.w = cvtpk(v1[2], v1[3]); return w; }

struct EpiIn {
    static constexpr bool PERM = true;
    bf16_t* CQ; float* SSQ; float* KVRAW; bf16_t* XP; bf16_t* GT;
    __device__ __forceinline__ void operator()(const f32x4 (&acc)[2][2][4][2], const Unit& u, int wr, int wc, int fr, int fq) const {
        const int row0 = u.pm * 256 + wr * 64 + fr, cb = wc * 32 + 8 * fq, pn = u.pn;
        if (pn == 0) {
            EPI_ROWS_BEGIN  float s = 0.f;
#pragma unroll
                for (int bj = 0; bj < 2; ++bj) { const f32x4 v0 = acc[ai][bj][m][0], v1 = acc[ai][bj][m][1];
                    s += (v0[0] * v0[0] + v0[1] * v0[1]) + (v0[2] * v0[2] + v0[3] * v0[3]) + (v1[0] * v1[0] + v1[1] * v1[1]) + (v1[2] * v1[2] + v1[3] * v1[3]);
                    *(u32x4*)(CQ + (size_t)row * 256 + bj * 128 + cb) = pack8(v0, v1); }
                s += __shfl_xor(s, 16); s += __shfl_xor(s, 32);
                if (fq == 0) SSQ[(size_t)row * 4 + wc] = s;  EPI_ROWS_END
        } else if (pn == 1) {
            EPI_ROWS_BEGIN
#pragma unroll
                for (int bj = 0; bj < 2; ++bj) { const int col = bj * 128 + cb;
                    if (col < 192) { float* p = KVRAW + (size_t)row * 192 + col; *(f32x4*)p = acc[ai][bj][m][0]; *(f32x4*)(p + 4) = acc[ai][bj][m][1]; } }  EPI_ROWS_END
        } else if (pn < 6) {
            EPI_ROWS_BEGIN
#pragma unroll
                for (int bj = 0; bj < 2; ++bj) *(u32x4*)(XP + (size_t)row * 1024 + (pn - 2) * 256 + bj * 128 + cb) = pack8(acc[ai][bj][m][0], acc[ai][bj][m][1]);  EPI_ROWS_END
        } else {
            EPI_ROWS_BEGIN
#pragma unroll
                for (int bj = 0; bj < 2; ++bj) { f32x4 v0 = acc[ai][bj][m][0], v1 = acc[ai][bj][m][1];
#pragma unroll
                    for (int e = 0; e < 4; ++e) { v0[e] = fast_sigmoid(v0[e]); v1[e] = fast_sigmoid(v1[e]); }
                    *(u32x4*)(GT + (size_t)row * 2048 + (pn - 6) * 256 + bj * 128 + cb) = pack8(v0, v1); }  EPI_ROWS_END
        }
    }
};

struct EpiQ {
    static constexpr bool PERM = true;
    bf16_t* Q; const float* SSQ; const float* TAB;
    __device__ __forceinline__ void operator()(const f32x4 (&acc)[2][2][4][2], const Unit& u, int wr, int wc, int fr, int fq) const {
        const int row0 = u.pm * 256 + wr * 64 + fr, cb = wc * 32 + 8 * fq;
        EPI_ROWS_BEGIN  const f32x4 sq = *(const f32x4*)(SSQ + (size_t)row * 4);
            const float rs = rsqrtf(((sq[0] + sq[1]) + (sq[2] + sq[3])) * (1.0f / 256.0f) + EPS) * C2;
            const int t = row & (SEQ - 1), vr = t >> 6, vc = t & 63;
#pragma unroll
            for (int bj = 0; bj < 2; ++bj) { const int col = u.pn * 256 + bj * 128 + cb, h = col / DQK, hc = col - h * DQK;
                f32x4 v0 = acc[ai][bj][m][0] * rs, v1 = acc[ai][bj][m][1] * rs;
                if (hc >= 128) { const int p0 = (hc - 128) >> 1, v = (p0 >> 4) ? vc : vr; const float* tp = TAB + (v * 16 + (p0 & 15)) * 2;
                    const f32x4 t0 = *(const f32x4*)tp, t1 = *(const f32x4*)(tp + 4);
                    f32x4 r0, r1;
                    r0[0] = v0[0] * t0[0] - v0[1] * t0[1]; r0[1] = v0[0] * t0[1] + v0[1] * t0[0]; r0[2] = v0[2] * t0[2] - v0[3] * t0[3]; r0[3] = v0[2] * t0[3] + v0[3] * t0[2];
                    r1[0] = v1[0] * t1[0] - v1[1] * t1[1]; r1[1] = v1[0] * t1[1] + v1[1] * t1[0]; r1[2] = v1[2] * t1[2] - v1[3] * t1[3]; r1[3] = v1[2] * t1[3] + v1[3] * t1[2];
                    v0 = r0; v1 = r1; }
                *(u32x4*)(Q + (size_t)row * QW + col) = pack8(v0, v1); }  EPI_ROWS_END
    }
};

struct EpiU {
    static constexpr bool PERM = true;
    bf16_t* MG; const bf16_t* GT;
    __device__ __forceinline__ void operator()(const f32x4 (&acc)[2][2][4][2], const Unit& u, int wr, int wc, int fr, int fq) const {
        const int row0 = u.pm * 256 + wr * 64 + fr, cb = wc * 32 + 8 * fq;
        EPI_ROWS_BEGIN
#pragma unroll
            for (int bj = 0; bj < 2; ++bj) { const int col = u.pn * 256 + bj * 128 + cb; const u32x4 gw = *(const u32x4*)(GT + (size_t)row * 2048 + col);
                f32x4 v0 = acc[ai][bj][m][0], v1 = acc[ai][bj][m][1];
                v0[0] *= bf_lo(gw.x); v0[1] *= bf_hi(gw.x); v0[2] *= bf_lo(gw.y); v0[3] *= bf_hi(gw.y); v1[0] *= bf_lo(gw.z); v1[1] *= bf_hi(gw.z); v1[2] *= bf_lo(gw.w); v1[3] *= bf_hi(gw.w);
                *(u32x4*)(MG + (size_t)row * 1024 + col) = pack8(v0, v1); }  EPI_ROWS_END
    }
};
struct EpiP {
    static constexpr bool PERM = true;
    bf16_t* MG; const bf16_t* GT; const LAS float* PS;
    __device__ __forceinline__ void operator()(const f32x4 (&acc)[2][2][4][2], const Unit& u, int wr, int wc, int fr, int fq) const {
        const int row0 = u.pm * 256 + wr * 64 + fr, cb = wc * 32 + 8 * fq;
        EPI_ROWS_BEGIN
#pragma unroll
            for (int bj = 0; bj < 2; ++bj) { const int col = u.pn * 256 + bj * 128 + cb; const u32x4 gw = *(const u32x4*)(GT + (size_t)row * 2048 + 1024 + col);
                const u32x4 mw = *(const u32x4*)(MG + (size_t)row * 1024 + col);
                const f32x4 p0 = *(const LAS f32x4*)(PS + col), p1 = *(const LAS f32x4*)(PS + col + 4);
                f32x4 v0 = acc[ai][bj][m][0] * p0, v1 = acc[ai][bj][m][1] * p1;
                v0[0] = bf_lo(mw.x) + v0[0] * bf_lo(gw.x); v0[1] = bf_hi(mw.x) + v0[1] * bf_hi(gw.x); v0[2] = bf_lo(mw.y) + v0[2] * bf_lo(gw.y); v0[3] = bf_hi(mw.y) + v0[3] * bf_hi(gw.y);
                v1[0] = bf_lo(mw.z) + v1[0] * bf_lo(gw.z); v1[1] = bf_hi(mw.z) + v1[1] * bf_hi(gw.z); v1[2] = bf_lo(mw.w) + v1[2] * bf_lo(gw.w); v1[3] = bf_hi(mw.w) + v1[3] * bf_hi(gw.w);
                *(u32x4*)(MG + (size_t)row * 1024 + col) = pack8(v0, v1); }  EPI_ROWS_END
    }
};
struct EpiO {
    static constexpr bool PERM = true;
    bf16_t* Y; float* SSQ;
    __device__ __forceinline__ void operator()(const f32x4 (&acc)[2][2][4][2], const Unit& u, int wr, int wc, int fr, int fq) const {
        const int row0 = u.pm * 256 + wr * 64 + fr, cb = wc * 32 + 8 * fq;
        EPI_ROWS_BEGIN  float s = 0.f;
#pragma unroll
            for (int bj = 0; bj < 2; ++bj) { const f32x4 v0 = acc[ai][bj][m][0], v1 = acc[ai][bj][m][1];
                s += (v0[0] * v0[0] + v0[1] * v0[1]) + (v0[2] * v0[2] + v0[3] * v0[3]) + (v1[0] * v1[0] + v1[1] * v1[1]) + (v1[2] * v1[2] + v1[3] * v1[3]);
                *(u32x4*)(Y + (size_t)row * 1024 + u.pn * 256 + bj * 128 + cb) = pack8(v0, v1); }
            s += __shfl_xor(s, 16); s += __shfl_xor(s, 32);
            if (fq == 0) SSQ[(size_t)row * 16 + u.pn * 4 + wc] = s;  EPI_ROWS_END
    }
};
struct EpiStore {
    static constexpr bool PERM = true;
    bf16_t* O; int ld;
    __device__ __forceinline__ void operator()(const f32x4 (&acc)[2][2][4][2], const Unit& u, int wr, int wc, int fr, int fq) const {
        const int row0 = u.pm * 256 + wr * 64 + fr, cb = wc * 32 + 8 * fq;
        EPI_ROWS_BEGIN
#pragma unroll
            for (int bj = 0; bj < 2; ++bj) *(u32x4*)(O + (size_t)row * ld + u.pn * 256 + bj * 128 + cb) = pack8(acc[ai][bj][m][0], acc[ai][bj][m][1]);  EPI_ROWS_END
    }
};
struct EpiS4 {
    static constexpr bool PERM = true;
    float* S; int rot;
    __device__ __forceinline__ void operator()(const f32x4 (&acc)[2][2][4][2], const Unit& u, int wr, int wc, int fr, int fq) const {
        const int row0 = wr * 64 + fr, cb = wc * 32 + 8 * fq;
        EPI_ROWS_BEGIN
#pragma unroll
            for (int bj = 0; bj < 2; ++bj) {
#if S_I16
                const f32x4 v0 = acc[ai][bj][m][0] * 0.0625f, v1 = acc[ai][bj][m][1] * 0.0625f; u32x4 w;
                w.x = __builtin_bit_cast(unsigned, __builtin_amdgcn_cvt_pknorm_i16(v0[0], v0[1])); w.y = __builtin_bit_cast(unsigned, __builtin_amdgcn_cvt_pknorm_i16(v0[2], v0[3]));
                w.z = __builtin_bit_cast(unsigned, __builtin_amdgcn_cvt_pknorm_i16(v1[0], v1[1])); w.w = __builtin_bit_cast(unsigned, __builtin_amdgcn_cvt_pknorm_i16(v1[2], v1[3]));
                *(u32x4*)((short*)S + (size_t)((row + rot) & 255) * 2048 + (u.pn & 7) * 256 + bj * 128 + cb) = w;
#else
                float* p = S + (size_t)((row + rot) & 255) * 1024 + (u.pn & 3) * 256 + bj * 128 + cb; *(f32x4*)p = acc[ai][bj][m][0]; *(f32x4*)(p + 4) = acc[ai][bj][m][1];
#endif
            }
        EPI_ROWS_END
    }
};
struct EpiS {
    static constexpr bool PERM = true;
    float* S;
    __device__ __forceinline__ void operator()(const f32x4 (&acc)[2][2][4][2], const Unit& u, int wr, int wc, int fr, int fq) const {
        const int row0 = wr * 64 + fr, cb = wc * 32 + 8 * fq;
        EPI_ROWS_BEGIN
#pragma unroll
            for (int bj = 0; bj < 2; ++bj) { float* p = S + (size_t)row * 256 + bj * 128 + cb; *(f32x4*)p = acc[ai][bj][m][0]; *(f32x4*)(p + 4) = acc[ai][bj][m][1]; }  EPI_ROWS_END
    }
};

namespace att {
constexpr int KSTR = 400, SHM_K = 64 * KSTR, SHM_V = 16384;
constexpr int OFF_V = 0, OFF_K = 2 * SHM_V, OFF_WS = OFF_K + 2 * SHM_K, OFF_QL = OFF_WS + NWAVES * 256, NQL = 0, ATT_LDS = OFF_QL + NWAVES * NQL * 1024;
#define SBAR() __builtin_amdgcn_sched_barrier(0)
__device__ __forceinline__ int crow(int r, int hi) { return (r & 3) + 8 * (r >> 2) + 4 * hi; }
__device__ __forceinline__ int v_st(int k, int c) { const int kk = (k & ~0xC) | ((k & 4) << 1) | ((k & 8) >> 1); return ((kk >> 3) * 4 + (c >> 5)) * 512 + ((kk & 7) * 32 + (c & 31)) * 2; }
__device__ __forceinline__ int v_rd_base(int lane) { return ((lane & 3) << 3) | (((lane >> 2) & 3) << 6) | (((lane >> 4) & 1) << 5) | (((lane >> 5) & 1) << 8); }
constexpr int v_rd_off(int d0, int ks, int half) { return d0 * 512 + ks * 4096 + half * 2048; }
template <int OFF> __device__ __forceinline__ s16x4 tr_read(int vb) { s16x4 r; asm volatile("ds_read_b64_tr_b16 %0, %1 offset:%2" : "=&v"(r) : "v"(vb), "i"(OFF) : "memory"); return r; }
template <int D0> __device__ __forceinline__ void pv_one(f32x16& od, int vb, bf16x8 pa0, bf16x8 pa1, bf16x8 pa2, bf16x8 pa3) {
    const s16x4 l0 = tr_read<v_rd_off(D0, 0, 0)>(vb), h0 = tr_read<v_rd_off(D0, 0, 1)>(vb), l1 = tr_read<v_rd_off(D0, 1, 0)>(vb), h1 = tr_read<v_rd_off(D0, 1, 1)>(vb);
    const s16x4 l2 = tr_read<v_rd_off(D0, 2, 0)>(vb), h2 = tr_read<v_rd_off(D0, 2, 1)>(vb), l3 = tr_read<v_rd_off(D0, 3, 0)>(vb), h3 = tr_read<v_rd_off(D0, 3, 1)>(vb);
    asm volatile("s_waitcnt lgkmcnt(0)" ::: "memory"); SBAR();
#define PK(L, H) (bf16x8){L[0], L[1], L[2], L[3], H[0], H[1], H[2], H[3]}
    od = __builtin_amdgcn_mfma_f32_32x32x16_bf16(pa0, PK(l0, h0), od, 0, 0, 0);
    od = __builtin_amdgcn_mfma_f32_32x32x16_bf16(pa1, PK(l1, h1), od, 0, 0, 0);
    od = __builtin_amdgcn_mfma_f32_32x32x16_bf16(pa2, PK(l2, h2), od, 0, 0, 0);
    od = __builtin_amdgcn_mfma_f32_32x32x16_bf16(pa3, PK(l3, h3), od, 0, 0, 0);
#undef PK
}
__device__ __forceinline__ void pv_d0(f32x16* o, int vb, bf16x8 pa0, bf16x8 pa1, bf16x8 pa2, bf16x8 pa3) {
    pv_one<0>(o[0], vb, pa0, pa1, pa2, pa3); pv_one<1>(o[1], vb, pa0, pa1, pa2, pa3); pv_one<2>(o[2], vb, pa0, pa1, pa2, pa3); pv_one<3>(o[3], vb, pa0, pa1, pa2, pa3);
}
constexpr float THR = 8.0f;
__device__ __forceinline__ void partialSM(f32x16& p0, f32x16& p1, float& m_reg, float& mn, float& alpha) {
    float pmax = p0[0];
#pragma unroll
    for (int r = 1; r < 16; ++r) pmax = fmaxf(pmax, p0[r]);
#pragma unroll
    for (int r = 0; r < 16; ++r) pmax = fmaxf(pmax, p1[r]);
    { auto rr = __builtin_amdgcn_permlane32_swap(__float_as_uint(pmax), __float_as_uint(pmax), false, false); pmax = fmaxf(__uint_as_float(rr[0]), __uint_as_float(rr[1])); }
    if (__builtin_expect(__all(pmax - m_reg <= THR), 1)) { mn = m_reg; alpha = 1.f; }
    else { mn = fmaxf(m_reg, pmax); alpha = __builtin_amdgcn_exp2f(m_reg - mn); m_reg = mn; }
#pragma unroll
    for (int r = 0; r < 16; ++r) { p0[r] -= mn; p1[r] -= mn; }
#pragma unroll
    for (int r = 0; r < 16; ++r) p0[r] = __builtin_amdgcn_exp2f(p0[r]);
}
__device__ __forceinline__ void finishSM(f32x16& p0, f32x16& p1, float alpha, float& l_reg, bf16x8& pa0, bf16x8& pa1, bf16x8& pa2, bf16x8& pa3) {
#pragma unroll
    for (int r = 0; r < 16; ++r) p1[r] = __builtin_amdgcn_exp2f(p1[r]);
    float ps = 0;
#pragma unroll
    for (int r = 0; r < 16; ++r) ps += p0[r];
#pragma unroll
    for (int r = 0; r < 16; ++r) ps += p1[r];
    { auto rr = __builtin_amdgcn_permlane32_swap(__float_as_uint(ps), __float_as_uint(ps), false, false); ps = __uint_as_float(rr[0]) + __uint_as_float(rr[1]); }
    l_reg = l_reg * alpha + ps;
#define PK4(P, BASE, OUT) do { unsigned a0 = cvtpk(P[BASE + 0], P[BASE + 1]), a1 = cvtpk(P[BASE + 2], P[BASE + 3]);   \
    unsigned b0 = cvtpk(P[BASE + 4], P[BASE + 5]), b1 = cvtpk(P[BASE + 6], P[BASE + 7]);                              \
    auto r0 = __builtin_amdgcn_permlane32_swap(a0, b0, false, false); auto r1 = __builtin_amdgcn_permlane32_swap(a1, b1, false, false); \
    u32x4 w = {r0[0], r1[0], r0[1], r1[1]}; OUT = *reinterpret_cast<bf16x8*>(&w); } while (0)
    PK4(p0, 0, pa0); PK4(p0, 8, pa1); PK4(p1, 0, pa2); PK4(p1, 8, pa3);
#undef PK4
}
__device__ __forceinline__ void qkt(f32x16& p0, f32x16& p1, const char* Ks, const bf16x8* qr, const char* ql, int r32, int hi) {
    p0 = f32x16{}; p1 = f32x16{};
#pragma unroll
    for (int d0 = 0; d0 < 12; ++d0) { const int cbb = (d0 * 16 + hi * 8) * 2;
        const bf16x8 b0 = *reinterpret_cast<const bf16x8*>(Ks + r32 * KSTR + cbb);
        const bf16x8 b1 = *reinterpret_cast<const bf16x8*>(Ks + (32 + r32) * KSTR + cbb);
        const bf16x8 qf = (d0 < 12 - NQL) ? qr[d0] : *reinterpret_cast<const bf16x8*>(ql + (d0 - (12 - NQL)) * 1024);
        p0 = __builtin_amdgcn_mfma_f32_32x32x16_bf16(b0, qf, p0, 0, 0, 0);
        p1 = __builtin_amdgcn_mfma_f32_32x32x16_bf16(b1, qf, p1, 0, 0, 0);
        if ((d0 & 3) == 3) SBAR(); }
}
__device__ __forceinline__ void attn_unit(const bf16_t* __restrict__ Qg, const bf16_t* __restrict__ Kb, bf16_t* __restrict__ Og, int token0, int h, char* lds) {
    const int tid = threadIdx.x, wid = tid >> 6, lane = tid & 63, r32 = lane & 31, hi = lane >> 5;
    char* V_lds = lds + OFF_V; char* K_lds = lds + OFF_K;
    float* ws = (float*)(lds + OFF_WS) + wid * 64; float* li_l = ws; float* al_l = ws + 32;
    float m_reg = -1e30f, l_reg = 0; f32x16 o[4] = {}; bf16x8 qr[12 - NQL];
    const bf16_t* Qw = Qg + (size_t)(token0 + wid * 32 + r32) * QW + h * DQK + hi * 8;
    char* ql = lds + OFF_QL + wid * (NQL * 1024) + lane * 16;
#pragma unroll
    for (int d0 = 0; d0 < 12 - NQL; ++d0) qr[d0] = *reinterpret_cast<const bf16x8*>(Qw + d0 * 16);
#pragma unroll
    for (int d0 = 12 - NQL; d0 < 12; ++d0) *reinterpret_cast<bf16x8*>(ql + (d0 - (12 - NQL)) * 1024) = *reinterpret_cast<const bf16x8*>(Qw + d0 * 16);
    const int vb0 = (int)(uintptr_t)V_lds + v_rd_base(lane);
    bf16x8 sA[3];
#define SLOAD(S_, t_) do { int td_ = tid; asm volatile("" : "+v"(td_)); const bf16_t* tb_ = Kb + (size_t)(t_) * 64 * DQK + (td_ >> 3) * DQK + (td_ & 7) * 8; _Pragma("unroll") for (int i = 0; i < 3; ++i) S_[i] = *reinterpret_cast<const bf16x8*>(tb_ + i * 64); } while (0)
#define SWRITE(b_, S_) do { int td_ = tid; asm volatile("" : "+v"(td_)); const int kst = (td_ >> 3) * KSTR + (td_ & 7) * 16, vst = v_st(td_ >> 3, (td_ & 7) * 8); \
    _Pragma("unroll") for (int i = 0; i < 3; ++i) { *(bf16x8*)(K_lds + (b_) * SHM_K + kst + i * 128) = S_[i]; if (i < 2) *(bf16x8*)(V_lds + (b_) * SHM_V + vst + i * 1024) = S_[i]; } } while (0)
#define SWAIT() asm volatile("s_waitcnt vmcnt(0)" ::: "memory")
#define RESC(a) do { if (__any((a) < 1.f)) { if (hi == 0) al_l[r32] = (a); asm volatile("s_waitcnt lgkmcnt(0)" ::: "memory"); \
    _Pragma("unroll") for (int d = 0; d < 4; ++d) _Pragma("unroll") for (int r = 0; r < 16; ++r) o[d][r] *= al_l[crow(r, hi)]; } } while (0)
    f32x16 pA0, pA1, pB0, pB1; float mnA, mnB, alA, alB; bf16x8 pa0, pa1, pa2, pa3; constexpr int NT = NKEY / 64;
    SLOAD(sA, 0); asm volatile("s_waitcnt vmcnt(0)" ::: "memory"); SWRITE(0, sA); __syncthreads();
    qkt(pA0, pA1, K_lds, qr, ql, r32, hi); partialSM(pA0, pA1, m_reg, mnA, alA);
    SLOAD(sA, 1);
    SWAIT(); SWRITE(1, sA); __syncthreads();
    for (int j = 1; j + 1 < NT; j += 2) {
        SBAR(); qkt(pB0, pB1, K_lds + SHM_K, qr, ql, r32, hi);
        finishSM(pA0, pA1, alA, l_reg, pa0, pa1, pa2, pa3); SBAR();
        SLOAD(sA, j + 1); SBAR();
        pv_d0(o, vb0, pa0, pa1, pa2, pa3); partialSM(pB0, pB1, m_reg, mnB, alB);
        __syncthreads(); SWAIT(); SWRITE(0, sA);
        RESC(alB); __syncthreads();
        SBAR(); qkt(pA0, pA1, K_lds, qr, ql, r32, hi);
        finishSM(pB0, pB1, alB, l_reg, pa0, pa1, pa2, pa3); SBAR();
        SLOAD(sA, j + 2); SBAR();
        pv_d0(o, vb0 + SHM_V, pa0, pa1, pa2, pa3); partialSM(pA0, pA1, m_reg, mnA, alA);
        __syncthreads(); SWAIT(); SWRITE(1, sA);
        RESC(alA); __syncthreads();
    }
    SBAR(); qkt(pB0, pB1, K_lds + SHM_K, qr, ql, r32, hi);
    finishSM(pA0, pA1, alA, l_reg, pa0, pa1, pa2, pa3); SBAR();
    pv_d0(o, vb0, pa0, pa1, pa2, pa3); partialSM(pB0, pB1, m_reg, mnB, alB);
    __syncthreads(); RESC(alB);
    finishSM(pB0, pB1, alB, l_reg, pa0, pa1, pa2, pa3); SBAR();
    pv_d0(o, vb0 + SHM_V, pa0, pa1, pa2, pa3);
    if (hi == 0) li_l[r32] = l_reg; asm volatile("s_waitcnt lgkmcnt(0)" ::: "memory");
    float rli[16];
#pragma unroll
    for (int r = 0; r < 16; ++r) rli[r] = __builtin_amdgcn_rcpf(li_l[crow(r, hi)]);
    __syncthreads();
    int le = lane; asm volatile("" : "+v"(le));
    const int r32e = le & 31, hie = le >> 5;
    bf16_t* stg = (bf16_t*)(lds + wid * 8192) + (hie * 4) * 128 + r32e;
#pragma unroll
    for (int r = 0; r < 16; ++r) { const int orow = (r & 3) + 8 * (r >> 2);
#pragma unroll
        for (int d0 = 0; d0 < 4; ++d0) stg[orow * 128 + d0 * 32] = (bf16_t)(cvtpk(o[d0][r] * rli[r], 0.f) & 0xffffu); }
    asm volatile("s_waitcnt lgkmcnt(0)" ::: "memory");
    const bf16_t* stg2 = (const bf16_t*)(lds + wid * 8192) + (le >> 4) * 128 + (le & 15) * 8;
    bf16_t* Ow = Og + (size_t)(token0 + wid * 32 + (le >> 4)) * 1024 + h * 128 + (le & 15) * 8;
#pragma unroll
    for (int i = 0; i < 8; ++i) { const u32x4 v = *(const u32x4*)(stg2 + i * 4 * 128); *(u32x4*)(Ow + (size_t)i * 4 * 1024) = v; }
    __syncthreads();
#undef SLOAD
#undef SWRITE
#undef SWAIT
#undef RESC
}
#undef SBAR
}


#define XB_TMO      128
#define XB_XCNT(j)  (256  + 64 * (j))
#define XB_XSUB(j)  (1280 + 64 * (j))
#define XB_XGEN(j)  (2304 + 64 * (j))
#define XB_TOP      3328
#define XB_TOPGEN   3392
#define XCD_BAR_WORDS 3456
#define XB_SPIN_CAP (1u << 18)
__device__ __forceinline__ unsigned xb_ld(unsigned* p)              { return __hip_atomic_load(p, __ATOMIC_RELAXED, __HIP_MEMORY_SCOPE_AGENT); }
__device__ __forceinline__ unsigned xb_add(unsigned* p, unsigned v) { return __hip_atomic_fetch_add(p, v, __ATOMIC_RELAXED, __HIP_MEMORY_SCOPE_AGENT); }
__device__ __forceinline__ unsigned xb_xcc_id() { return (unsigned)__builtin_amdgcn_s_getreg((3 << 11) | 20) & 0xFu; }
#define XB_SPIN(cond, bar) do { unsigned _sp = 0; while (cond) { __builtin_amdgcn_s_sleep(1); \
    if ((++_sp & 255u) == 0u) { if (xb_ld(&(bar)[XB_TMO])) break; if (_sp > XB_SPIN_CAP) { atomicAdd(&(bar)[XB_TMO], 1u); break; } } } } while (0)
struct XcdBarrier { unsigned* bar; unsigned x; volatile LAS unsigned* st; };
__device__ __forceinline__ XcdBarrier xcd_barrier_post(unsigned* bar, volatile LAS unsigned* st) {
    XcdBarrier b; b.bar = bar; b.x = xb_xcc_id(); b.st = st;
    if (threadIdx.x == 0) (void)xb_add(&bar[XB_XCNT(b.x)], 1u);
    return b;
}
__device__ __forceinline__ void xcd_barrier_complete(unsigned* bar, unsigned x, unsigned& nloc, unsigned& nx) {
    const unsigned G = gridDim.x * gridDim.y * gridDim.z;
    unsigned sum, cnt, mine, sp = 0u;
    for (;;) {
        sum = 0u; cnt = 0u; mine = 0u;
#pragma unroll
        for (unsigned j = 0; j < 16; ++j) { const unsigned c = xb_ld(&bar[XB_XCNT(j)]); sum += c; cnt += (c > 0u) ? 1u : 0u; mine = (j == x) ? c : mine; }
        if (sum == G) break;
        __builtin_amdgcn_s_sleep(1);
        if ((++sp & 255u) == 0u) { if (xb_ld(&bar[XB_TMO])) break; if (sp > XB_SPIN_CAP) { atomicAdd(&bar[XB_TMO], 1u); break; } }
    }
    nloc = mine > 0u ? mine : 1u; nx = cnt > 0u ? cnt : 1u;
}
__device__ __forceinline__ void xcd_barrier(const XcdBarrier& b) {
    asm volatile("s_waitcnt vmcnt(0)" ::: "memory");
    __syncthreads();
    if (threadIdx.x == 0) {
        unsigned* bar = b.bar;
        __builtin_amdgcn_s_waitcnt(0);
        unsigned nloc = b.st[0], nx = b.st[1];
        if (nloc == 0u) { xcd_barrier_complete(bar, b.x, nloc, nx); b.st[0] = nloc; b.st[1] = nx; }
        const unsigned old = xb_add(&bar[XB_XSUB(b.x)], 1u);
        const unsigned gen = old / nloc;
        if (old + 1u == (gen + 1u) * nloc) {
            __builtin_amdgcn_fence(__ATOMIC_RELEASE, "agent");
            asm volatile("s_waitcnt vmcnt(0)" ::: "memory");
            const unsigned og = xb_add(&bar[XB_TOP], 1u);
            const unsigned tg = og / nx;
            if (og + 1u == (tg + 1u) * nx) xb_add(&bar[XB_TOPGEN], 1u);
            else XB_SPIN(xb_ld(&bar[XB_TOPGEN]) == tg, bar);
            __builtin_amdgcn_fence(__ATOMIC_ACQUIRE, "agent");
            xb_add(&bar[XB_XGEN(b.x)], 1u);
            asm volatile("s_waitcnt vmcnt(0)" ::: "memory");
        } else {
            XB_SPIN(xb_ld(&bar[XB_XGEN(b.x)]) == gen, bar);
            __builtin_amdgcn_fence(__ATOMIC_ACQUIRE, "agent");
            asm volatile("s_waitcnt vmcnt(0)" ::: "memory");
        }
    }
    __syncthreads();
}


__device__ __forceinline__ float modv(const float* MODP, const float* b_ada, int r, int col) {
    const float* p = MODP + (size_t)r * 6144 + col; constexpr size_t KS = (size_t)33 * 6144;
    return ((p[0] + p[KS]) + (p[2 * KS] + p[3 * KS])) + b_ada[col];
}

struct Args { const float* in[22]; float* out; unsigned char* ws; int ph_lo, ph_hi; };

template <class RowMap>
__device__ __forceinline__ void transpose_item(const float* __restrict__ W, int K, int N, bf16_t* __restrict__ WT, LAS float* scr, int item, int lane, const RowMap& rowmap) {
    const int nblk = N / 32, kb = item / nblk, nb = item % nblk, k0 = 64 * kb, n0 = 32 * nb;
#pragma unroll 8
    for (int i = 0; i < 32; ++i) { const int kk = 2 * i + (lane >> 5); scr[kk * 33 + (lane & 31)] = W[(size_t)(k0 + kk) * N + n0 + (lane & 31)]; }
    asm volatile("s_waitcnt lgkmcnt(0)" ::: "memory");
    const int c = lane & 7;
#pragma unroll
    for (int j = 0; j < 4; ++j) { const int n = (lane >> 3) + 8 * j; const LAS float* s = scr + (8 * c) * 33 + n;
        u32x4 o; o.x = cvtpk(s[0 * 33], s[1 * 33]); o.y = cvtpk(s[2 * 33], s[3 * 33]); o.z = cvtpk(s[4 * 33], s[5 * 33]); o.w = cvtpk(s[6 * 33], s[7 * 33]);
        *(u32x4*)(WT + (size_t)rowmap(n0 + n) * K + k0 + 8 * c) = o; }
    asm volatile("s_waitcnt lgkmcnt(0)" ::: "memory");
}
struct MapIn { __device__ __forceinline__ int operator()(int n) const {
    if (n < 128) return 256 + n;
    if (n < 192) { const int s = n - 128, axis = s >> 5, e = (s >> 4) & 1, f = s & 15; return 384 + 2 * (axis * 16 + f) + e; }
    if (n < 448) return n - 192;
    if (n < 1472) return 512 + (n - 448);
    return 1536 + (n - 1472); } };
struct MapId { __device__ __forceinline__ int operator()(int n) const { return n; } };

__device__ __forceinline__ unsigned f2key(float f) { const unsigned u = __float_as_uint(f); return (u & 0x80000000u) ? ~u : (u | 0x80000000u); }
__device__ __forceinline__ float key2f(unsigned k) { const unsigned u = (k & 0x80000000u) ? (k & 0x7fffffffu) : ~k; return __uint_as_float(u); }

template <int CTRL> __device__ __forceinline__ unsigned dpp_u(unsigned v) { return (unsigned)__builtin_amdgcn_update_dpp(0, (int)v, CTRL, 0xF, 0xF, true); }
template <int CTRL> __device__ __forceinline__ float dpp_f(float v) { return __uint_as_float((unsigned)__builtin_amdgcn_update_dpp(0, (int)__float_as_uint(v), CTRL, 0xF, 0xF, true)); }
#define ROW_MAXU(m) do { m = max(m, dpp_u<0x128>(m)); m = max(m, dpp_u<0x124>(m)); m = max(m, dpp_u<0x122>(m)); m = max(m, dpp_u<0x121>(m)); } while (0)
#define CE_DESC(a, b) do { const unsigned hi_ = max(a, b), lo_ = min(a, b); a = hi_; b = lo_; } while (0)
template <int NC, bool I16 = false>
__device__ __forceinline__ void top16_of_128(const f32x4 (&sa)[NC], const f32x4 (&sb)[NC], int i16, unsigned (&mine)[NC]) {
    unsigned k[NC][8];
#pragma unroll
    for (int c = 0; c < NC; ++c) {
#pragma unroll
        for (int e = 0; e < 4; ++e) {
            if (I16) {
                const unsigned wa = __float_as_uint(sa[c][e >> 1]), wb = __float_as_uint(sb[c][e >> 1]);
                const unsigned ha = ((e & 1) ? (wa >> 16) : (wa & 0xffffu)) ^ 0x8000u, hb = ((e & 1) ? (wb >> 16) : (wb & 0xffffu)) ^ 0x8000u;
                k[c][e] = (ha << 16) | (unsigned)(127 - (4 * i16 + e)); k[c][4 + e] = (hb << 16) | (unsigned)(127 - (64 + 4 * i16 + e));
            } else { k[c][e] = (f2key(sa[c][e]) & ~0x7Fu) | (unsigned)(127 - (4 * i16 + e)); k[c][4 + e] = (f2key(sb[c][e]) & ~0x7Fu) | (unsigned)(127 - (64 + 4 * i16 + e)); } }
        CE_DESC(k[c][0], k[c][1]); CE_DESC(k[c][2], k[c][3]); CE_DESC(k[c][4], k[c][5]); CE_DESC(k[c][6], k[c][7]);
        CE_DESC(k[c][0], k[c][2]); CE_DESC(k[c][1], k[c][3]); CE_DESC(k[c][4], k[c][6]); CE_DESC(k[c][5], k[c][7]);
        CE_DESC(k[c][1], k[c][2]); CE_DESC(k[c][5], k[c][6]);
        CE_DESC(k[c][0], k[c][4]); CE_DESC(k[c][1], k[c][5]); CE_DESC(k[c][2], k[c][6]); CE_DESC(k[c][3], k[c][7]);
        CE_DESC(k[c][2], k[c][4]); CE_DESC(k[c][3], k[c][5]);
        CE_DESC(k[c][1], k[c][2]); CE_DESC(k[c][3], k[c][4]); CE_DESC(k[c][5], k[c][6]);
        mine[c] = 0u; }
#pragma unroll
    for (int it = 0; it < 16; ++it) {
        unsigned m[NC];
#pragma unroll
        for (int c = 0; c < NC; ++c) m[c] = max(k[c][0], dpp_u<0x128>(k[c][0]));
#pragma unroll
        for (int c = 0; c < NC; ++c) m[c] = max(m[c], dpp_u<0x124>(m[c]));
#pragma unroll
        for (int c = 0; c < NC; ++c) m[c] = max(m[c], dpp_u<0x122>(m[c]));
#pragma unroll
        for (int c = 0; c < NC; ++c) m[c] = max(m[c], dpp_u<0x121>(m[c]));
#pragma unroll
        for (int c = 0; c < NC; ++c) { const bool tk = (k[c][0] == m[c]);
#pragma unroll
            for (int e = 0; e < 7; ++e) k[c][e] = tk ? k[c][e + 1] : k[c][e];
            k[c][7] = tk ? 0u : k[c][7];
            mine[c] = (i16 == it) ? m[c] : mine[c]; }
    }
}
__device__ __forceinline__ void topk_head(const f32x4 sc, int lane, int ca, int cb, int& expert, float& gate) {
    const int j = lane & 31;
    unsigned k0 = (f2key(sc[0]) & ~0x7Fu) | (unsigned)(127 - (4 * j + 0)), k1 = (f2key(sc[1]) & ~0x7Fu) | (unsigned)(127 - (4 * j + 1));
    unsigned k2 = (f2key(sc[2]) & ~0x7Fu) | (unsigned)(127 - (4 * j + 2)), k3 = (f2key(sc[3]) & ~0x7Fu) | (unsigned)(127 - (4 * j + 3));
    unsigned mine = 0u;
#pragma unroll 1
    for (int it = 0; it < 16; ++it) {
        unsigned mx = max(max(k0, k1), max(k2, k3));
#pragma unroll
        for (int o = 1; o < 32; o <<= 1) mx = max(mx, (unsigned)__shfl_xor((int)mx, o));
        if (j == it) mine = mx;
        k0 = (k0 == mx) ? 0u : k0; k1 = (k1 == mx) ? 0u : k1; k2 = (k2 == mx) ? 0u : k2; k3 = (k3 == mx) ? 0u : k3;
    }
    const float val = key2f(mine & ~0x7Fu); const int kid = 127 - (int)(mine & 0x7Fu);
    const float s0 = __shfl(val, ca), s1 = __shfl(val, 32 + cb);
    const int i0 = __shfl(kid, ca), i1 = __shfl(kid, 32 + cb);
    const int myexp = i0 * 128 + i1;
    unsigned ck = (lane < 50) ? ((f2key(s0 + s1) & ~0x3Fu) | (unsigned)(63 - lane)) : 0u;
    unsigned best = 0u;
#pragma unroll 1
    for (int it = 0; it < 16; ++it) {
        unsigned mx = ck;
#pragma unroll
        for (int o = 1; o < 64; o <<= 1) mx = max(mx, (unsigned)__shfl_xor((int)mx, o));
        if (lane == it) best = mx;
        ck = (ck == mx) ? 0u : ck;
    }
    const float bv = key2f(best & ~0x3Fu); const int bc = 63 - (int)(best & 0x3Fu);
    expert = __shfl(myexp, bc);
    const float top = __shfl(bv, 0);
    float ex = (lane < 16) ? __builtin_amdgcn_exp2f((bv - top) * 1.4426950408889634f) : 0.f;
    float sum = ex;
#pragma unroll
    for (int o = 1; o < 16; o <<= 1) sum += __shfl_xor(sum, o);
    gate = ex / sum;
}


template <bool ISV>
__device__ __forceinline__ void gather_wave(int p, int first, int stride, int T, int ln, const unsigned char* tabu, int bp_base, const unsigned* HW, const bf16_t* HF, float* PART, bf16_t* PEERO, float* SSQP) {
    constexpr bool isv = ISV; const int lg = ln >> 3, lc = ln & 7; const unsigned lc16 = (unsigned)lc * 16u;
#define TOKEN(k_) ((size_t)first + (size_t)(((k_) < T ? (k_) : T - 1)) * stride)
#define PERM8(W, H_, o_) do { _Pragma("unroll") for (int j_ = 0; j_ < 8; ++j_) W[j_] = (unsigned)__builtin_amdgcn_ds_bpermute(bp_base + 32 * j_, (int)(H_)); } while (0)
#define LOAD8(B, W) do { _Pragma("unroll") for (int j_ = 0; j_ < 8; ++j_) B[j_] = *(const u32x4*)(tab + (size_t)(W[j_] & 0x3FFFu) * 128); } while (0)
#define SBX() __builtin_amdgcn_sched_barrier(0)
            if (T > 0) {
                u32x4 bA[16], bB[16]; unsigned wA[16], wB[16];
#define PERM16(W, HA_, HB_) do { _Pragma("unroll") for (int j_ = 0; j_ < 16; ++j_) W[j_] = (unsigned)__builtin_amdgcn_ds_bpermute(bp_base + 32 * (j_ & 7), (int)((j_ < 8) ? (HA_) : (HB_))); } while (0)
#define LOAD16(B, W) do { _Pragma("unroll") for (int j_ = 0; j_ < 16; ++j_) B[j_] = *(const u32x4*)(tabu + (((W[j_] & 0x3FFFu) << 7) | lc16)); } while (0)
#define HDR(k_, HA_, HB_) do { const size_t t_ = TOKEN(k_); HA_ = HW[t_ * 128 + ln]; HB_ = HW[t_ * 128 + 64 + ln]; } while (0)
#if PEER_I8
#define XLD(k_, X0, X1) do { if (!isv) { X0 = *(const u32x4*)((const unsigned char*)HF + TOKEN(k_) * DM + p * 128 + lc * 16); } } while (0)
#else
#define XLD(k_, X0, X1) do { if (!isv) { const bf16_t* xp_ = HF + TOKEN(k_) * DM + p * 128 + lc * 16; X0 = *(const u32x4*)xp_; X1 = *(const u32x4*)(xp_ + 8); } } while (0)
#endif
#define CONSUME(B, W, X0, X1, k_) do { const size_t tk = TOKEN(k_); float RA = 0.f, RB = 0.f; int IA = 0, IB = 0; f32x2 acc[8]; \
        const unsigned xw[8] = {X0.x, X0.y, X0.z, X0.w, X1.x, X1.y, X1.z, X1.w};     \
        _Pragma("unroll") for (int i = 0; i < 8; ++i) acc[i] = (f32x2){0.f, 0.f}; \
        _Pragma("unroll") for (int j = 0; j < 16; ++j) { \
            if (!isv && PEER_I8) { int e_ = 0;     \
                _Pragma("unroll") for (int q = 0; q < 4; ++q) e_ = __builtin_amdgcn_sdot4((int)B[j][q], (int)xw[q], e_, false); \
                unsigned du = (unsigned)e_; du += dpp_u<0xB1>(du); du += dpp_u<0x4E>(du); du += dpp_u<0x141>(du); \
                if (j < 8) IA = (lc == (j & 7)) ? (int)du : IA; else IB = (lc == (j & 7)) ? (int)du : IB; } \
            else if (!isv) { float e0 = 0.f, e1 = 0.f; \
                _Pragma("unroll") for (int q = 0; q < 4; ++q) { const bf16x2_t lo = __builtin_amdgcn_cvt_scalef32_pk_bf16_fp8(B[j][q], 1.0f, false), hi = __builtin_amdgcn_cvt_scalef32_pk_bf16_fp8(B[j][q], 1.0f, true); \
                    e0 = __builtin_amdgcn_fdot2_f32_bf16(lo, __builtin_bit_cast(bf16x2_t, xw[2 * q]), e0, false); e1 = __builtin_amdgcn_fdot2_f32_bf16(hi, __builtin_bit_cast(bf16x2_t, xw[2 * q + 1]), e1, false); } \
                float d = e0 + e1; d += dpp_f<0xB1>(d); d += dpp_f<0x4E>(d); d += dpp_f<0x141>(d); \
                if (j < 8) RA = (lc == (j & 7)) ? d : RA; else RB = (lc == (j & 7)) ? d : RB; } \
            else { const float a1_ = __uint_as_float(W[j] & 0xffff0000u); const f32x2 a_ = (f32x2){a1_, a1_}; \
                _Pragma("unroll") for (int q = 0; q < 4; ++q) { const f32x2 lo = __builtin_amdgcn_cvt_pk_f32_fp8((int)B[j][q], false), hi = __builtin_amdgcn_cvt_pk_f32_fp8((int)B[j][q], true); \
                    acc[2 * q] = __builtin_elementwise_fma(a_, lo, acc[2 * q]); acc[2 * q + 1] = __builtin_elementwise_fma(a_, hi, acc[2 * q + 1]); } } } \
        if (!isv) { if (PEER_I8) { RA = (float)IA; RB = (float)IB; } bf16_t* po = (bf16_t*)PART + ((size_t)p * TL + tk) * 128 + 8 * lc + lg; po[0] = (bf16_t)(cvtpk(RA, 0.f) & 0xffffu); po[64] = (bf16_t)(cvtpk(RB, 0.f) & 0xffffu); }     \
        else { float ss = 0.f; float ac[16]; \
            _Pragma("unroll") for (int i = 0; i < 16; ++i) { float t = acc[i >> 1][i & 1]; t += dpp_f<0x128>(t); \
                { auto r_ = __builtin_amdgcn_permlane16_swap(__float_as_uint(t), __float_as_uint(t), false, false); t = __uint_as_float(r_[0]) + __uint_as_float(r_[1]); } \
                { auto r_ = __builtin_amdgcn_permlane32_swap(__float_as_uint(t), __float_as_uint(t), false, false); t = __uint_as_float(r_[0]) + __uint_as_float(r_[1]); } \
                ac[i] = t; ss += t * t; } \
            ss += dpp_f<0xB1>(ss); ss += dpp_f<0x4E>(ss); ss += dpp_f<0x141>(ss); \
            if (lg == 0) { u32x4 o0, o1; o0.x = cvtpk(ac[0], ac[1]); o0.y = cvtpk(ac[2], ac[3]); o0.z = cvtpk(ac[4], ac[5]); o0.w = cvtpk(ac[6], ac[7]); \
                o1.x = cvtpk(ac[8], ac[9]); o1.y = cvtpk(ac[10], ac[11]); o1.z = cvtpk(ac[12], ac[13]); o1.w = cvtpk(ac[14], ac[15]); \
                bf16_t* po = PEERO + tk * DM + p * 128 + lc * 16; *(u32x4*)po = o0; *(u32x4*)(po + 8) = o1; } \
            if (ln == 0) SSQP[(size_t)p * TL + tk] = ss; } } while (0)
                unsigned hA, hB, gA, gB; u32x4 xa0 = (u32x4){0u, 0u, 0u, 0u}, xa1 = xa0, xb0 = xa0, xb1 = xa0;
                HDR(0, hA, hB); HDR(1, gA, gB); XLD(0, xa0, xa1);
                PERM16(wA, hA, hB); LOAD16(bA, wA);
#pragma unroll 1
                for (int k = 0; k < T; k += 2) {
                    PERM16(wB, gA, gB); LOAD16(bB, wB); XLD(k + 1, xb0, xb1); HDR(k + 2, hA, hB); SBX();
                    CONSUME(bA, wA, xa0, xa1, k); SBX();
                    PERM16(wA, hA, hB); LOAD16(bA, wA); XLD(k + 2, xa0, xa1); HDR(k + 3, gA, gB); SBX();
                    CONSUME(bB, wB, xb0, xb1, k + 1); SBX();
                }
#undef PERM16
#undef LOAD16
#undef HDR
#undef XLD
#undef CONSUME
            }
#undef TOKEN
#undef PERM8
#undef LOAD8
#undef SBX
}
#ifndef SKIP_TOPK
#define SKIP_TOPK 0
#endif
#ifndef PROBE_PT
#define PROBE_PT 0
#endif
#ifndef PROBE_DIV
#define PROBE_DIV 1000
#endif
#ifndef PROBE_BASE
#define PROBE_BASE 190000
#endif
#ifndef PROBE_MODE
#define PROBE_MODE 0
#endif
#define PROBE(k) do { if (PROBE_PT == (k) && threadIdx.x == 0) { const unsigned tk_ = (unsigned)(__builtin_amdgcn_s_memrealtime() - probe_t0); \
        if (PROBE_MODE == 0) { if (blockIdx.x == 0) probe_val = ((float)tk_ - (float)PROBE_BASE) * (1.0f / PROBE_DIV); } \
        else atomicMax((unsigned*)args.ws + 8192, PROBE_MODE == 1 ? tk_ : 0xFFFFFFFFu - tk_); } } while (0)
#define DECL_PTRS \
    unsigned char* ws = args.ws; \
    const float* x = args.in[0]; const float* cvec = args.in[1]; const float* ctx = args.in[2]; const float* c_ctx = args.in[3]; \
    const float* w_ada = args.in[4]; const float* b_ada = args.in[5]; const float* g_mix_pre = args.in[6]; const float* g_mix_post = args.in[7]; \
    const float* g_ffn_pre = args.in[8]; const float* g_ffn_post = args.in[9]; const float* w_in = args.in[10]; const float* g_q_lora = args.in[11]; \
    const float* w_uq = args.in[12]; const float* g_kv_lora = args.in[13]; const float* w_ukv = args.in[14]; const float* w_pool = args.in[15]; \
    const float* pool_scale = args.in[16]; const float* w_out = args.in[17]; const float* peer_wq = args.in[18]; const float* peer_keys = args.in[19]; \
    const float* peer_u = args.in[20]; const float* peer_v = args.in[21]; \
    float* out = args.out; \
    float* MOD = (float*)(ws + WS_MODP); float* TAB = (float*)(ws + WS_ROPE); float* SSQCQ = (float*)(ws + WS_SSQCQ); float* SSQY = (float*)(ws + WS_SSQY); \
    bf16_t* WIN = (bf16_t*)(ws + WS_WIN); bf16_t* WQ = (bf16_t*)(ws + WS_WQ); bf16_t* WUV = (bf16_t*)(ws + WS_WUV); bf16_t* WPOOL = (bf16_t*)(ws + WS_WPOOL); \
    bf16_t* KEYS = (bf16_t*)(ws + WS_KEYS); bf16_t* WOUT = (bf16_t*)(ws + WS_WOUT); bf16_t* WPQ = (bf16_t*)(ws + WS_WPQ); \
    bf16_t* PU = (bf16_t*)(ws + WS_PU); bf16_t* PV = (bf16_t*)(ws + WS_PV); \
    bf16_t* HN = (bf16_t*)(ws + WS_HN); bf16_t* OLAT = HN; bf16_t* MG = HN; bf16_t* HF = HN; \
    bf16_t* CQ = (bf16_t*)(ws + WS_CQ); int* EIDX = (int*)(ws + WS_CQ); \
    float* KVRAW = (float*)(ws + WS_KVRAW); float* EW = (float*)(ws + WS_KVRAW); \
    bf16_t* KF = (bf16_t*)(ws + WS_KF); bf16_t* XP = (bf16_t*)(ws + WS_XP); bf16_t* GT = (bf16_t*)(ws + WS_GT); bf16_t* QP = GT; \
    bf16_t* QB = (bf16_t*)(ws + WS_Q); bf16_t* POOLED = QB; bf16_t* YB = QB; float* SB = (float*)(ws + WS_S);
__global__ void __launch_bounds__(NTHREADS, 2) mk_fwd(Args args) {
    extern __shared__ __attribute__((aligned(16))) unsigned char lds[];
    const int tid = threadIdx.x, lane = tid & 63, wave = __builtin_amdgcn_readfirstlane(tid >> 6);
    const int G = gridDim.x, bx = blockIdx.x, vcu = (G % 8 == 0) ? (bx % 8) * (G / 8) + bx / 8 : bx;
    const int gw = vcu * NWAVES + wave, NGW = G * NWAVES;
    LAS unsigned char* ring = (LAS unsigned char*)lds;
    LAS float* VEC = (LAS float*)(lds + VEC_OFF);
    const int lo = args.ph_lo, hi_ = args.ph_hi;
    volatile LAS unsigned* MISC = (volatile LAS unsigned*)(lds + MISC_OFF);
    if (tid < 16) MISC[tid] = 0u;
    __syncthreads();
    XcdBarrier xbar = xcd_barrier_post((unsigned*)args.ws + 1024, MISC + 8);
    unsigned long long probe_t0 = 0; float probe_val = 0.f; if (PROBE_PT) probe_t0 = __builtin_amdgcn_s_memrealtime();
#ifndef TAIL_MASK
#define TAIL_MASK 255
#endif
#define TM(k) if constexpr ((TAIL_MASK >> (k)) & 1)
#ifndef PH_MASK
#define PH_MASK 1023
#endif
#define IN(k) (((PH_MASK >> (k)) & 1) && lo <= (k) && (k) < hi_)
#define SEAM(k) do { if (IN(k) && IN((k) + 1)) { if ((k) == 0) cg::this_grid().sync(); else xcd_barrier(xbar); } } while (0)


#ifndef DBG_AT
#define DBG_AT 0
#endif
#define DBG_COPY(k, SRC, LD) if (DBG_AT == (k)) { DECL_PTRS for (size_t i = (size_t)gw * 64 + lane; i < (size_t)TL * 1024 / 8; i += (size_t)NGW * 64) { const size_t row = i >> 7, c8 = i & 127; \
        const u32x4 w = *(const u32x4*)((const bf16_t*)(SRC) + row * (LD) + c8 * 8); float* o = out + row * 1024 + c8 * 8; \
        *(f32x4*)o = (f32x4){bf_lo(w.x), bf_hi(w.x), bf_lo(w.y), bf_hi(w.y)}; *(f32x4*)(o + 4) = (f32x4){bf_lo(w.z), bf_hi(w.z), bf_lo(w.w), bf_hi(w.w)}; } }

#ifndef DBG_TAIL
#define DBG_TAIL 0
#endif
#define DBG_TCOPY(k, SRC) if (DBG_TAIL == (k)) { asm volatile("s_waitcnt vmcnt(0)" ::: "memory"); __syncthreads(); for (int i = tid; i < 256 * 128; i += NTHREADS) { const size_t row = (size_t)tok0 + (i >> 7); const int c8 = i & 127; \
        const u32x4 w = *(const u32x4*)((const bf16_t*)(SRC) + row * 1024 + c8 * 8); float* o = out + row * 1024 + c8 * 8; \
        *(f32x4*)o = (f32x4){bf_lo(w.x), bf_hi(w.x), bf_lo(w.y), bf_hi(w.y)}; *(f32x4*)(o + 4) = (f32x4){bf_lo(w.z), bf_hi(w.z), bf_lo(w.w), bf_hi(w.w)}; } continue; }
    if (IN(0)) {
        DECL_PTRS
        LAS float* scr = (LAS float*)(lds + wave * 16384);
        for (int it = gw; it < 192 * 2 * 4; it += NGW) {
            const int ks = it / 384, it2 = it - ks * 384, ct = it2 % 192, rg = it2 / 192, half = lane >> 5, col = ct * 32 + (lane & 31), r0 = rg * 17;
            float acc[17];
#pragma unroll
            for (int j = 0; j < 17; ++j) acc[j] = 0.f;
            for (int kc = ks * 4; kc < ks * 4 + 4; ++kc) {
#pragma unroll
                for (int j = 0; j < 17; ++j) { const int r = min(r0 + j, 32); const float v = (r < 32) ? cvec[(size_t)r * DM + kc * 64 + lane] : c_ctx[kc * 64 + lane];
                    scr[j * 64 + lane] = v / (1.0f + __expf(-v)); }
                asm volatile("s_waitcnt lgkmcnt(0)" ::: "memory");
#pragma unroll 16
                for (int i = 0; i < 32; ++i) { const int kk = 2 * i + half; const float w = w_ada[(size_t)(kc * 64 + kk) * 6144 + col];
#pragma unroll
                    for (int j = 0; j < 17; ++j) acc[j] += scr[j * 64 + kk] * w; }
                asm volatile("s_waitcnt lgkmcnt(0)" ::: "memory");
            }
#pragma unroll
            for (int j = 0; j < 17; ++j) { acc[j] += __shfl_xor(acc[j], 32); if (half == 0 && r0 + j < 33) MOD[((size_t)ks * 33 + r0 + j) * 6144 + col] = acc[j]; }
        }
        for (int i = gw * 64 + lane; i < 64 * 16; i += NGW * 64) { const int v = i >> 4, f = i & 15; const float inv = powf(10000.0f, -(float)f / 16.0f), ang = (float)v * inv;
            TAB[i * 2] = cosf(ang); TAB[i * 2 + 1] = sinf(ang); }
        for (int it = gw; it < 16 * 110; it += NGW) transpose_item(w_in, DM, INW, WIN, scr, it, lane, MapIn());
        for (int it = gw; it < 16 * 32; it += NGW) transpose_item(w_out, DM, DM, WOUT, scr, it, lane, MapId());
#if PEER_FOLD
        for (int it = NGW - 1 - gw; it < 16 * 16 * 4; it += NGW) {
            const int kq = it & 3, hp = it >> 6, k0 = ((it >> 2) & 15) * 64, pside = hp & 1; const float* wr = peer_wq + (size_t)(k0 + lane) * 2048 + hp * 128; f32x4 av[32];
#pragma unroll
            for (int c = 0; c < 32; ++c) av[c] = *(const f32x4*)(wr + 4 * c);
            for (int key = kq * 32; key < kq * 32 + 32; ++key) { const float* kr = peer_keys + ((size_t)pside * 128 + key) * 128; float s0 = 0.f, s1 = 0.f, s2 = 0.f, s3 = 0.f;
#pragma unroll
                for (int c = 0; c < 32; ++c) { const f32x4 kv = *(const f32x4*)(kr + 4 * c); s0 += av[c][0] * kv[0]; s1 += av[c][1] * kv[1]; s2 += av[c][2] * kv[2]; s3 += av[c][3] * kv[3]; }
                WPQ[(size_t)(hp * 128 + key) * DM + k0 + lane] = (bf16_t)(cvtpk((s0 + s1) + (s2 + s3), 0.f) & 0xffffu); }
        }
#else
        for (int it = gw; it < 16 * 64; it += NGW) transpose_item(peer_wq, DM, 2048, WPQ, scr, it, lane, MapId());
#endif
        for (int i = gw * 64 + lane; i < 64 * 1024 / 8; i += NGW * 64) *(u32x4*)(WIN + (size_t)448 * 1024 + (size_t)i * 8) = (u32x4){0u, 0u, 0u, 0u};
        for (int it = gw; it < QW * 4; it += NGW) {
            const int n = it >> 2, r = (it & 3) * 64 + lane, h = n / DQK, cc = n - h * DQK; float v;
            if (cc < 128) { const float* a = w_uq + (size_t)r * QW + h * DQK; const float* b = w_ukv + (size_t)cc * 2048 + h * 256; float s0 = 0.f, s1 = 0.f, s2 = 0.f, s3 = 0.f;
#pragma unroll 8
                for (int d = 0; d < 128; d += 4) { const f32x4 av = *(const f32x4*)(a + d), bv = *(const f32x4*)(b + d); s0 += av[0] * bv[0]; s1 += av[1] * bv[1]; s2 += av[2] * bv[2]; s3 += av[3] * bv[3]; }
                v = (s0 + s1) + (s2 + s3); }
            else v = w_uq[(size_t)r * QW + h * DQK + 128 + rope_src(cc - 128)];
            WQ[(size_t)n * 256 + r] = (bf16_t)(cvtpk(v * g_q_lora[r], 0.f) & 0xffffu);
        }
        for (int i = gw * 64 + lane; i < 1024 * 256; i += NGW * 64) { const int n = i >> 8, k = i & 255, h = n >> 7, d = n & 127, hh = k >> 7, c = k & 127;
            const float v = (hh == (h & 1)) ? w_ukv[(size_t)c * 2048 + h * 256 + 128 + d] : 0.f; WUV[i] = (bf16_t)(cvtpk(v, 0.f) & 0xffffu); }
        for (int i = gw * 64 + lane; i < 1024 * 256; i += NGW * 64) { const int n = i >> 8, k = i & 255, g = n >> 8, d = n & 255;
            WPOOL[i] = (bf16_t)(cvtpk(w_pool[((size_t)g * 256 + k) * 256 + d], 0.f) & 0xffffu); }
        for (int i = gw * 64 + lane; i < 256 * 256; i += NGW * 64) { const int n = i >> 8, k = i & 255, p = n >> 7, key = n & 127, pp = k >> 7, c = k & 127;
            const float v = (p == pp) ? peer_keys[((size_t)p * 128 + key) * 128 + c] : 0.f; KEYS[i] = (bf16_t)(cvtpk(v, 0.f) & 0xffffu); }
#if PEER_FP8
#pragma unroll 4
        for (size_t i = (size_t)gw * 64 + lane; i < (size_t)2 * 16384 * 1024 / 16; i += (size_t)NGW * 64) {
            const bool isu = i < (size_t)16384 * 1024 / 16; const size_t j = isu ? i : i - (size_t)16384 * 1024 / 16;
            const float* s = (isu ? peer_u : peer_v) + j * 16; u32x4 w;
#if PEER_I8
            if (isu) {
                f32x4 a4[4]; float am = 0.f;
#pragma unroll
                for (int q = 0; q < 4; ++q) { a4[q] = *(const f32x4*)(s + 4 * q); am = fmaxf(fmaxf(am, fmaxf(fabsf(a4[q][0]), fabsf(a4[q][1]))), fmaxf(fabsf(a4[q][2]), fabsf(a4[q][3]))); }
                am = wave_max(am); const float inv = am > 0.f ? 127.0f / am : 0.f;
#pragma unroll
                for (int q = 0; q < 4; ++q) w[q] = pack_i8(a4[q][0] * inv, a4[q][1] * inv, a4[q][2] * inv, a4[q][3] * inv);
                if (lane == 0) ((float*)(ws + WS_USCALE))[j >> 6] = am * (1.0f / 127.0f);
            } else
#endif
#pragma unroll
            for (int q = 0; q < 4; ++q) { const f32x4 a = *(const f32x4*)(s + 4 * q) * 64.0f; int t = __builtin_amdgcn_cvt_pk_fp8_f32(a[0], a[1], 0, false); t = __builtin_amdgcn_cvt_pk_fp8_f32(a[2], a[3], t, true); w[q] = (unsigned)t; }
#if PEER_XCD
            { const size_t e_ = j >> 6, c_ = (j & 63) * 16;
              *(u32x4*)((unsigned char*)(isu ? PU : PV) + (c_ >> 7) * ((size_t)16384 * 128) + e_ * 128 + (c_ & 127)) = w; }
#else
            *(u32x4*)((unsigned char*)(isu ? PU : PV) + j * 16) = w;
#endif
        }
#else
        for (size_t i = (size_t)gw * 64 + lane; i < (size_t)2 * 16384 * 1024 / 8; i += (size_t)NGW * 64) {
            const bool isu = i < (size_t)16384 * 1024 / 8; const size_t j = isu ? i : i - (size_t)16384 * 1024 / 8;
            const float* s = (isu ? peer_u : peer_v) + j * 8; const f32x4 a = *(const f32x4*)s, b = *(const f32x4*)(s + 4);
            *(u32x4*)((isu ? PU : PV) + j * 8) = pack8(a, b); }
#endif
    }
    if (PROBE_PT == 20 && threadIdx.x == 0) ((unsigned*)args.ws + 9000)[bx] = xb_xcc_id() + 1u;
    SEAM(0); PROBE(1);
    if (PROBE_PT == 20 && blockIdx.x == 0 && threadIdx.x == 0) { int bad = 0; for (int b_ = 0; b_ < G; ++b_) { const unsigned a_ = __hip_atomic_load((unsigned*)args.ws + 9000 + b_, __ATOMIC_RELAXED, __HIP_MEMORY_SCOPE_AGENT), c_ = __hip_atomic_load((unsigned*)args.ws + 9000 + (b_ & 7), __ATOMIC_RELAXED, __HIP_MEMORY_SCOPE_AGENT); bad += (a_ != c_); } probe_val = 10.f + (float)bad; }

    if (IN(1)) {
        DECL_PTRS
        for (int blk = vcu; blk < 256; blk += G) {
            const int b = blk >> 3;
            __syncthreads();
            for (int k = tid; k < DM; k += NTHREADS) { const float g = g_mix_pre[k];
                VEC[k] = g * (1.0f + modv(MOD, b_ada, b, 1024 + k)); VEC[1024 + k] = modv(MOD, b_ada, b, k);
                VEC[2048 + k] = g * (1.0f + modv(MOD, b_ada, 32, 1024 + k)); VEC[3072 + k] = modv(MOD, b_ada, 32, k); }
            __syncthreads();
#define P1_ROWPTR(rr_) (((rr_) >= 256) ? ctx + (size_t)(blk * 32 + (rr_) - 256) * DM : x + (size_t)(blk * 256 + (rr_)) * DM)
            f32x4 nv[4];
#pragma unroll
            for (int j = 0; j < 4; ++j) nv[j] = *(const f32x4*)(P1_ROWPTR(wave) + 4 * lane + 256 * j);
            for (int rr = wave; rr < 288; rr += NWAVES) {
                const bool isc = rr >= 256; const int row = isc ? TL + blk * 32 + (rr - 256) : blk * 256 + rr;
                const LAS float* Gv = VEC + (isc ? 2048 : 0); const LAS float* Sv = Gv + 1024;
                f32x4 v[4]; float s = 0.f;
#pragma unroll
                for (int j = 0; j < 4; ++j) { v[j] = nv[j]; s += (v[j][0] * v[j][0] + v[j][1] * v[j][1]) + (v[j][2] * v[j][2] + v[j][3] * v[j][3]); }
                if (rr + NWAVES < 288) {
#pragma unroll
                    for (int j = 0; j < 4; ++j) nv[j] = *(const f32x4*)(P1_ROWPTR(rr + NWAVES) + 4 * lane + 256 * j); }
                const float rs = rsqrtf(wave_sum(s) * (1.0f / DM) + EPS);
#pragma unroll
                for (int j = 0; j < 4; ++j) { const f32x4 gg = *(const LAS f32x4*)(Gv + 4 * lane + 256 * j), sh = *(const LAS f32x4*)(Sv + 4 * lane + 256 * j);
                    const f32x4 o = v[j] * rs * gg + sh; u32x2 w; w.x = cvtpk(o[0], o[1]); w.y = cvtpk(o[2], o[3]);
                    *(u32x2*)(HN + (size_t)row * DM + 4 * lane + 256 * j) = w; }
            }
#undef P1_ROWPTR
        }
    }
    SEAM(1); PROBE(2);

    if (IN(2)) {
        DECL_PTRS
        pg8::Gemm g{HN, WIN, DM, DM, DM}; SchedIn S{G, bx}; EpiIn E{CQ, SSQCQ, KVRAW, XP, GT};
        pg8::gemm_phase<EpiIn, SchedIn, true>(ring, g, S, E);
    }
    SEAM(2); PROBE(3);

    if (IN(3) && DBG_AT == 3) { DBG_COPY(3, GT, 2048) }
    if (IN(3) && !(DBG_AT && DBG_AT <= 3)) {
        DECL_PTRS
        for (int row0 = gw * 4; row0 < TALL; row0 += NGW * 4) {
            f32x4 vv[4];
#pragma unroll
            for (int i = 0; i < 4; ++i) { vv[i] = (f32x4){0.f, 0.f, 0.f, 0.f}; if (lane < 48) vv[i] = *(const f32x4*)(KVRAW + (size_t)(row0 + i) * 192 + 4 * lane); }
#pragma unroll
            for (int i = 0; i < 4; ++i) { const int row = row0 + i; const f32x4 v = vv[i];
                const bool isc = row >= TL; int b, key, t = 0;
                if (isc) { const int j = row - TL; b = j >> 8; key = j & 255; } else { b = row >> 11; t = row & 2047; key = 256 + t; }
                float s = (lane < 32) ? (v[0] * v[0] + v[1] * v[1]) + (v[2] * v[2] + v[3] * v[3]) : 0.f;
                const float rs = rsqrtf(wave_sum(s) * (1.0f / 128.0f) + EPS);
                f32x4 o;
                if (lane < 32) { const f32x4 gk = *(const f32x4*)(g_kv_lora + 4 * lane); o = v * rs * gk; }
                else if (!isc && lane < 48) { const int p0 = 2 * (lane - 32), vq = (p0 >> 4) ? (t & 63) : (t >> 6); const f32x4 tc = *(const f32x4*)(TAB + (vq * 16 + (p0 & 15)) * 2);
                    o[0] = v[0] * tc[0] - v[1] * tc[1]; o[1] = v[0] * tc[1] + v[1] * tc[0]; o[2] = v[2] * tc[2] - v[3] * tc[3]; o[3] = v[2] * tc[3] + v[3] * tc[2]; }
                else o = v;
                if (lane < 48) { u32x2 w; w.x = cvtpk(o[0], o[1]); w.y = cvtpk(o[2], o[3]); *(u32x2*)(KF + ((size_t)b * NKEY + key) * DQK + 4 * lane) = w; } }
        }
        pg8::Gemm g{CQ, WQ, 256, 256, 256}; SchedQ S{G, bx}; EpiQ E{QB, SSQCQ, TAB};
        pg8::gemm_phase<EpiQ, SchedQ, true>(ring, g, S, E);
    }
    SEAM(3); PROBE(4);

    if (IN(4) && !(DBG_AT && DBG_AT <= 4)) {
        DECL_PTRS
        const int ipb = (2048 + G - 1) / G;
        for (int i = 0; i < ipb; ++i) { const int uid = vcu * ipb + i; if (uid >= 2048) break;
            const int b = uid >> 6, rem = uid & 63, h = rem >> 3, qb = rem & 7;
            att::attn_unit(QB, KF + (size_t)b * NKEY * DQK, OLAT, b * SEQ + qb * 256, h, (char*)lds); }
    }
    SEAM(4); PROBE(5);


    if (PROBE_PT == 10 && IN(5) && blockIdx.x == 0 && wave == 0) {
        DECL_PTRS
        float worst = 0.f;
        for (int tc = 0; tc < 2; ++tc) {
            const int q = tc ? 150 : 37, h = tc ? 6 : 3;
            const bf16_t* qp = QB + (size_t)q * QW + h * DQK;
            float sc[36]; float mx = -1e30f;
            for (int kk = 0; kk < 36; ++kk) { const bf16_t* kp = KF + (size_t)(kk * 64 + lane) * DQK; float a = 0.f;
                for (int d = 0; d < DQK; ++d) a += __uint_as_float((unsigned)qp[d] << 16) * __uint_as_float((unsigned)kp[d] << 16);
                sc[kk] = a; mx = fmaxf(mx, a); }
            for (int o = 1; o < 64; o <<= 1) mx = fmaxf(mx, __shfl_xor(mx, o));
            float l = 0.f;
            for (int kk = 0; kk < 36; ++kk) { sc[kk] = exp2f(sc[kk] - mx); l += sc[kk]; }
            l = wave_sum(l);
            float omax = 0.f, dmax = 0.f;
            for (int c = 0; c < 128; ++c) { float a = 0.f;
                for (int kk = 0; kk < 36; ++kk) a += sc[kk] * __uint_as_float((unsigned)KF[(size_t)(kk * 64 + lane) * DQK + c] << 16);
                a = wave_sum(a) / l; const float got = __uint_as_float((unsigned)OLAT[(size_t)q * 1024 + h * 128 + c] << 16);
                omax = fmaxf(omax, fabsf(a)); dmax = fmaxf(dmax, fabsf(a - got)); }
            worst = fmaxf(worst, dmax / omax);
        }
        if (lane == 0) probe_val = 1000.f * worst;
    }
    if (PROBE_PT == 10 && IN(5) && blockIdx.x == 0) __syncthreads();
    if (IN(5) && DBG_AT == 5) { DBG_COPY(5, OLAT, 1024) }
    if (IN(5) && !(DBG_AT && DBG_AT <= 5)) {
        DECL_PTRS
        for (int pm = vcu; pm < 256; pm += G) {
            const int b = pm >> 3, tok0 = pm * 256;
            __syncthreads();
            TM(0) {
                int td = tid; asm volatile("" : "+v"(td));
                const int ln = td & 63, s0 = (pm & 7) * 256; LAS unsigned char* slab = (LAS unsigned char*)lds;
                const unsigned char* xg = (const unsigned char*)(XP + (size_t)b * SEQ * DM); unsigned* pb = (unsigned*)POOLED + (size_t)b * SEQ * 512 + 2 * ln;
#pragma unroll 1
                for (int g = 0; g < 4; ++g) { const int hw = 1 << g;
                    __syncthreads();
#pragma unroll
                    for (int i = td; i < 272 * 32; i += NTHREADS) { const int r = i >> 5, c16 = i & 31; const int jc = min(max(s0 - 8 + r, 0), SEQ - 1);
                        *(LAS u32x4*)(slab + r * 512 + c16 * 16) = *(const u32x4*)(xg + (size_t)jc * 2048 + g * 512 + c16 * 16); }
                    __syncthreads();
#pragma unroll 4
                    for (int it = 0; it < 32; ++it) { const int sl = it * 8 + wave, sq = s0 + sl; f32x4 sum = (f32x4){0.f, 0.f, 0.f, 0.f}, cen = sum;
                        for (int t = 0; t < 2 * hw; ++t) { const int jj = sq - hw + t; const float f = ((unsigned)jj < (unsigned)SEQ) ? 1.0f : 0.0f;
                            const u32x2 w = *(const LAS u32x2*)(slab + (sl + 8 - hw + t) * 512 + ln * 8); const f32x4 v = (f32x4){bf_lo(w.x), bf_hi(w.x), bf_lo(w.y), bf_hi(w.y)};
                            sum += v * f; if (t == hw) cen = v; }
                        const float rc = 1.0f / (float)(min(sq + hw, SEQ) - max(sq - hw, 0)); const f32x4 o = sum * rc - cen;
                        u32x2 ow; ow.x = cvtpk(o[0], o[1]); ow.y = cvtpk(o[2], o[3]); *(u32x2*)(pb + (size_t)sq * 512 + g * 128) = ow; } }
                __syncthreads();
            }
            for (int k = tid; k < DM; k += NTHREADS) {
                VEC[k] = modv(MOD, b_ada, b, 2048 + k) * g_mix_post[k];
                VEC[1024 + k] = g_ffn_pre[k] * (1.0f + modv(MOD, b_ada, b, 4096 + k));
                VEC[2048 + k] = modv(MOD, b_ada, b, 3072 + k);
                VEC[3072 + k] = modv(MOD, b_ada, b, 5120 + k) * g_ffn_post[k];
                VEC[4096 + k] = pool_scale[k]; }
            asm volatile("s_waitcnt vmcnt(0)" ::: "memory"); __syncthreads();
            DBG_TCOPY(1, POOLED)
            PROBE(14);
            TM(1) { pg8::Gemm g{OLAT, WUV, DM, 256, 256}; SchedRow S{pm, 0, 4, (long)tok0 * DM * 2, 512, 0, 256 * 256 * 2}; EpiU E{MG, GT}; pg8::gemm_phase<EpiU, SchedRow, true>(ring, g, S, E); }
            PROBE(15);
            DBG_TCOPY(4, MG)
            TM(2) { pg8::Gemm g{POOLED, WPOOL, DM, 256, 256}; SchedRow S{pm, 0, 4, (long)tok0 * DM * 2, 512, 0, 256 * 256 * 2}; EpiP E{MG, GT, VEC + 4096}; pg8::gemm_phase<EpiP, SchedRow, true>(ring, g, S, E); }
            PROBE(16);
            DBG_TCOPY(2, MG)
            TM(3) { pg8::Gemm g{MG, WOUT, DM, DM, DM}; SchedRow S{pm, 0, 4, (long)tok0 * DM * 2, 0, 0, 256 * DM * 2}; EpiO E{YB, SSQY}; pg8::gemm_phase<EpiO, SchedRow, true>(ring, g, S, E); }
            DBG_TCOPY(3, YB)
            PROBE(6);
            TM(4) {
                int ln = lane; asm volatile("" : "+v"(ln));
                const int c0 = 8 * ln, c1 = 512 + 8 * ln;
                f32x4 nq[4], nx[4]; u32x4 ny0, ny1;
#define E_LOAD(rr_) do { const size_t r_ = (size_t)tok0 + (rr_); _Pragma("unroll") for (int q = 0; q < 4; ++q) { nq[q] = *(const f32x4*)(SSQY + r_ * 16 + 4 * q); nx[q] = *(const f32x4*)(x + r_ * DM + ((q < 2 ? c0 : c1) + (q & 1) * 4)); } \
        ny0 = *(const u32x4*)(YB + r_ * DM + c0); ny1 = *(const u32x4*)(YB + r_ * DM + c1); } while (0)
                E_LOAD(wave * 32);
                for (int rr = wave * 32; rr < wave * 32 + 32; ++rr) {
                    const size_t row = (size_t)tok0 + rr;
                    const f32x4 qs = (nq[0] + nq[1]) + (nq[2] + nq[3]); const float ry = rsqrtf(((qs[0] + qs[1]) + (qs[2] + qs[3])) * (1.0f / DM) + EPS);
                    const u32x4 y0 = ny0, y1 = ny1; f32x4 xv[4];
#pragma unroll
                    for (int q = 0; q < 4; ++q) xv[q] = nx[q];
                    if (rr + 1 < wave * 32 + 32) E_LOAD(rr + 1);
                    float xm[16]; float yv[16] = {bf_lo(y0.x), bf_hi(y0.x), bf_lo(y0.y), bf_hi(y0.y), bf_lo(y0.z), bf_hi(y0.z), bf_lo(y0.w), bf_hi(y0.w), bf_lo(y1.x), bf_hi(y1.x), bf_lo(y1.y), bf_hi(y1.y), bf_lo(y1.z), bf_hi(y1.z), bf_lo(y1.w), bf_hi(y1.w)};
                    float s_ = 0.f;
#pragma unroll
                    for (int q = 0; q < 4; ++q) { const int cc = (q < 2 ? c0 : c1) + (q & 1) * 4; const f32x4 a1 = *(const LAS f32x4*)(VEC + cc);
#pragma unroll
                        for (int e = 0; e < 4; ++e) { const float m_ = xv[q][e] + a1[e] * (yv[q * 4 + e] * ry); xm[q * 4 + e] = m_; s_ += m_ * m_; } }
                    { u32x4 m0, m1; m0.x = cvtpk(xm[0], xm[1]); m0.y = cvtpk(xm[2], xm[3]); m0.z = cvtpk(xm[4], xm[5]); m0.w = cvtpk(xm[6], xm[7]);
                      m1.x = cvtpk(xm[8], xm[9]); m1.y = cvtpk(xm[10], xm[11]); m1.z = cvtpk(xm[12], xm[13]); m1.w = cvtpk(xm[14], xm[15]);
                      bf16_t* xmr = (bf16_t*)(ws + xm_off(row)); *(u32x4*)(xmr + c0) = m0; *(u32x4*)(xmr + c1) = m1; }
                    const float rm = rsqrtf(wave_sum(s_) * (1.0f / DM) + EPS);
                    u32x4 h0, h1; float hv[16];
#pragma unroll
                    for (int q = 0; q < 4; ++q) { const int cc = (q < 2 ? c0 : c1) + (q & 1) * 4; const f32x4 a2 = *(const LAS f32x4*)(VEC + 1024 + cc), a3 = *(const LAS f32x4*)(VEC + 2048 + cc);
#pragma unroll
                        for (int e = 0; e < 4; ++e) hv[q * 4 + e] = xm[q * 4 + e] * rm * a2[e] + a3[e]; }
                    h0.x = cvtpk(hv[0], hv[1]); h0.y = cvtpk(hv[2], hv[3]); h0.z = cvtpk(hv[4], hv[5]); h0.w = cvtpk(hv[6], hv[7]);
                    h1.x = cvtpk(hv[8], hv[9]); h1.y = cvtpk(hv[10], hv[11]); h1.z = cvtpk(hv[12], hv[13]); h1.w = cvtpk(hv[14], hv[15]);
                    *(u32x4*)(HF + row * DM + c0) = h0; *(u32x4*)(HF + row * DM + c1) = h1;
#if PEER_I8
                    {
                        float am = 0.f;
#pragma unroll
                        for (int e = 0; e < 16; ++e) am = fmaxf(am, fabsf(hv[e]));
                        am = wave_max(am); const float inv = am > 0.f ? 127.0f / am : 0.f;
                        u32x2 q0, q1; q0.x = pack_i8(hv[0] * inv, hv[1] * inv, hv[2] * inv, hv[3] * inv); q0.y = pack_i8(hv[4] * inv, hv[5] * inv, hv[6] * inv, hv[7] * inv);
                        q1.x = pack_i8(hv[8] * inv, hv[9] * inv, hv[10] * inv, hv[11] * inv); q1.y = pack_i8(hv[12] * inv, hv[13] * inv, hv[14] * inv, hv[15] * inv);
                        unsigned char* h8 = ws + WS_HF8 + row * DM; *(u32x2*)(h8 + c0) = q0; *(u32x2*)(h8 + c1) = q1;
                        if (ln == 0) ((float*)(ws + WS_XSCALE))[row] = am * (1.0f / 127.0f);
                    }
#endif
                }
#undef E_LOAD
            }
            asm volatile("s_waitcnt vmcnt(0)" ::: "memory"); __syncthreads();
#if PEER_FOLD
            PROBE(7);
            float* Sblk = (float*)(ws + WS_GT) + (size_t)pm * 262144; const int srot = (pm * 8) & 255;
            TM(6) for (int hq = 0; hq < (S_I16 ? 1 : 2); ++hq) {
                { pg8::Gemm g{HF, WPQ, DM, DM, DM}; SchedRow S{pm, 4 * hq, S_I16 ? 8 : 4, (long)tok0 * DM * 2, 0, 0, 256 * DM * 2}; EpiS4 E{Sblk, srot}; pg8::gemm_phase<EpiS4, SchedRow, true>(ring, g, S, E); }
                if (hq == 0) PROBE(17);
              {
#if S_I16
#define S_ROWP(rl, hh_) ((const short*)Sblk + (size_t)(((rl) + srot) & 255) * 2048 + (hh_) * 256)
#else
#define S_ROWP(rl, hh_) (Sblk + (size_t)(((rl) + srot) & 255) * 1024 + (hh_) * 256)
#endif
#else
            TM(5) { pg8::Gemm g{HF, WPQ, DM, DM, DM}; SchedRow S{pm, 0, 8, (long)tok0 * DM * 2, 0, 0, 256 * DM * 2}; EpiStore E{QP, 2048}; pg8::gemm_phase<EpiStore, SchedRow, true>(ring, g, S, E); }
            PROBE(7);
            float* Sblk = SB + (size_t)pm * (65536 + 1088);
            TM(6) for (int h = 0; h < NH; ++h) {
                { pg8::Gemm g{QP, KEYS, 2048, 256, 256}; SchedRow S{pm, h, 1, (long)tok0 * 2048 * 2, 512, 0, 0}; EpiS E{Sblk}; pg8::gemm_phase<EpiS, SchedRow, true>(ring, g, S, E); }
              {
#define S_ROWP(rl) (Sblk + (size_t)(rl) * 256)
#endif
                int ln = lane; asm volatile("" : "+v"(ln));
                const int i16 = ln & 15, g4 = ln >> 4;
                int cA[4], cB[4];
#pragma unroll
                for (int e = 0; e < 4; ++e) { const int c = 16 * e + i16; const int a = (c >= 16) + (c >= 24) + (c >= 29) + (c >= 33) + (c >= 36) + (c >= 38) + (c >= 40) + (c >= 42);
                    const int offs = (a == 0) ? 0 : (a == 1) ? 16 : (a == 2) ? 24 : (a == 3) ? 29 : (a == 4) ? 33 : (a == 5) ? 36 : (a == 6) ? 38 : (a == 7) ? 40 : 42;
                    if (c >= 42) { cA[e] = min(8 + (c - 42), 15); cB[e] = 0; } else { cA[e] = a; cB[e] = c - offs; } }
#if PEER_FOLD
#if S_I16
#define S_LD1(A_, B_, sp_) do { const short* p_ = (sp_); const u32x2 wa_ = *(const u32x2*)p_, wb_ = *(const u32x2*)(p_ + 64); A_ = (f32x4){__uint_as_float(wa_.x), __uint_as_float(wa_.y), 0.f, 0.f}; B_ = (f32x4){__uint_as_float(wb_.x), __uint_as_float(wb_.y), 0.f, 0.f}; } while (0)
#else
#define S_LD1(A_, B_, sp_) do { const float* p_ = (sp_); A_ = *(const f32x4*)p_; B_ = *(const f32x4*)(p_ + 64); } while (0)
#endif
#define S_LOAD(it_, A, B) do { const int hh_ = (it_) >> 2, r_ = wave * 32 + ((it_) & 3) * 8; _Pragma("unroll") for (int c_ = 0; c_ < 4; ++c_) { \
        S_LD1(A[c_], B[c_], S_ROWP(r_ + 2 * c_ + (g4 >> 1), hh_) + (g4 & 1) * 128 + 4 * i16); } } while (0)
                f32x4 na[4], nb[4]; S_LOAD(0, na, nb);
                for (int itk = 0; itk < (S_I16 ? 32 : 16); ++itk) { const int h = 4 * hq + (itk >> 2), r8 = wave * 32 + (itk & 3) * 8;
                    f32x4 ca[4], cbv[4];
#pragma unroll
                    for (int c_ = 0; c_ < 4; ++c_) { ca[c_] = na[c_]; cbv[c_] = nb[c_]; }
                    if (itk + 1 < (S_I16 ? 32 : 16)) S_LOAD(itk + 1, na, nb);
                    unsigned mq[4]; top16_of_128<4, S_I16 != 0>(ca, cbv, i16, mq);
#pragma unroll 1
                  for (int half = 0; half < 2; ++half) { const int r4 = r8 + 4 * half; const unsigned mA = half ? mq[2] : mq[0], mB = half ? mq[3] : mq[1];
#else
                for (int r4 = wave * 32; r4 < wave * 32 + 32; r4 += 4) {
                    if (SKIP_TOPK) { const size_t oi_ = ((size_t)tok0 + r4 + g4) * 128 + h * 16 + i16; EIDX[oi_] = (h * 16 + i16) * 97; EW[oi_] = 0.0625f; continue; }
                    const float* sp0 = S_ROWP(r4 + (g4 >> 1)) + (g4 & 1) * 128 + 4 * i16; const float* sp1 = S_ROWP(r4 + 2 + (g4 >> 1)) + (g4 & 1) * 128 + 4 * i16;
                    const f32x4 a0 = *(const f32x4*)sp0, b0 = *(const f32x4*)(sp0 + 64), a1 = *(const f32x4*)sp1, b1 = *(const f32x4*)(sp1 + 64);
#endif
#if !PEER_FOLD
                    unsigned mq2[2]; { const f32x4 sa_[2] = {a0, a1}, sb_[2] = {b0, b1}; top16_of_128<2>(sa_, sb_, i16, mq2); } const unsigned mA = mq2[0], mB = mq2[1];
#endif
                    const int src0 = ((2 * (g4 & 1)) * 16 + i16) * 4, src1 = src0 + 64;
                    const unsigned A0 = (unsigned)__builtin_amdgcn_ds_bpermute(src0, (int)mA), A1 = (unsigned)__builtin_amdgcn_ds_bpermute(src1, (int)mA);
                    const unsigned B0 = (unsigned)__builtin_amdgcn_ds_bpermute(src0, (int)mB), B1 = (unsigned)__builtin_amdgcn_ds_bpermute(src1, (int)mB);
                    const unsigned M0 = (g4 < 2) ? A0 : B0, M1 = (g4 < 2) ? A1 : B1;
#if S_I16 && PEER_FOLD
                    const float v0 = (float)((int)(M0 >> 16) - 32768) * (16.0f / 32767.0f), v1 = (float)((int)(M1 >> 16) - 32768) * (16.0f / 32767.0f);
#else
                    const float v0 = key2f(M0 & ~0x7Fu), v1 = key2f(M1 & ~0x7Fu);
#endif
                    const int kid0 = 127 - (int)(M0 & 0x7Fu), kid1 = 127 - (int)(M1 & 0x7Fu);
                    unsigned ck[4];
#pragma unroll
                    for (int e = 0; e < 4; ++e) { const float s0 = __uint_as_float((unsigned)__builtin_amdgcn_ds_bpermute((g4 * 16 + cA[e]) * 4, (int)__float_as_uint(v0)));
                        const float s1 = __uint_as_float((unsigned)__builtin_amdgcn_ds_bpermute((g4 * 16 + cB[e]) * 4, (int)__float_as_uint(v1)));
                        const int c = 16 * e + i16; ck[e] = (c < 50) ? ((f2key(s0 + s1) & ~0x3Fu) | (unsigned)(63 - c)) : 0u; }
                    CE_DESC(ck[0], ck[1]); CE_DESC(ck[2], ck[3]); CE_DESC(ck[0], ck[2]); CE_DESC(ck[1], ck[3]); CE_DESC(ck[1], ck[2]);
                    unsigned best = 0u;
#pragma unroll
                    for (int it = 0; it < 16; ++it) { unsigned m = ck[0]; ROW_MAXU(m); const bool tk = (ck[0] == m);
                        ck[0] = tk ? ck[1] : ck[0]; ck[1] = tk ? ck[2] : ck[1]; ck[2] = tk ? ck[3] : ck[2]; ck[3] = tk ? 0u : ck[3];
                        best = (i16 == it) ? m : best; }
                    const float bv = key2f(best & ~0x3Fu); const int c = 63 - (int)(best & 0x3Fu);
                    const int a = (c >= 16) + (c >= 24) + (c >= 29) + (c >= 33) + (c >= 36) + (c >= 38) + (c >= 40) + (c >= 42);
                    const int offs = (a == 0) ? 0 : (a == 1) ? 16 : (a == 2) ? 24 : (a == 3) ? 29 : (a == 4) ? 33 : (a == 5) ? 36 : (a == 6) ? 38 : (a == 7) ? 40 : 42;
                    const int ba = (c >= 42) ? 8 + (c - 42) : a, bb = (c >= 42) ? 0 : c - offs;
                    const int e0 = __builtin_amdgcn_ds_bpermute((g4 * 16 + ba) * 4, kid0), e1 = __builtin_amdgcn_ds_bpermute((g4 * 16 + bb) * 4, kid1);
                    const float top = __uint_as_float((unsigned)__builtin_amdgcn_ds_bpermute((g4 * 16) * 4, (int)__float_as_uint(bv)));
                    const float ex = __builtin_amdgcn_exp2f((bv - top) * 1.4426950408889634f);
                    float sum = ex; sum += dpp_f<0x128>(sum); sum += dpp_f<0x124>(sum); sum += dpp_f<0x122>(sum); sum += dpp_f<0x121>(sum);
                    const size_t oi = ((size_t)tok0 + r4 + g4) * 128 + h * 16 + i16;
                    EIDX[oi] = e0 * 128 + e1; EW[oi] = ex / sum;
#if PEER_FOLD
                  }
#endif
                }
              }
#undef S_ROWP
#undef S_LOAD
#undef S_LD1
                asm volatile("s_waitcnt vmcnt(0)" ::: "memory"); __syncthreads();
#if PEER_FOLD
                if (hq == 0) PROBE(18);
#endif
            }
            PROBE(8);
#if PEER_XCD
#elif PEER_FP8
            TM(7) for (int rr = wave * 32; rr < wave * 32 + 32; ++rr) {
                int ln = lane; asm volatile("" : "+v"(ln));
                LAS unsigned char* slots = ring + wave * 16384;
                const size_t row = (size_t)tok0 + rr; const int c0 = 16 * ln;
                const int idA = EIDX[row * 128 + ln], idB = EIDX[row * 128 + 64 + ln]; const float wA = EW[row * 128 + ln], wB = EW[row * 128 + 64 + ln];
                float xs[16];
                { const u32x4 xa = *(const u32x4*)(HF + row * DM + c0), xb = *(const u32x4*)(HF + row * DM + c0 + 8);
                  xs[0] = bf_lo(xa.x); xs[1] = bf_hi(xa.x); xs[2] = bf_lo(xa.y); xs[3] = bf_hi(xa.y); xs[4] = bf_lo(xa.z); xs[5] = bf_hi(xa.z); xs[6] = bf_lo(xa.w); xs[7] = bf_hi(xa.w);
                  xs[8] = bf_lo(xb.x); xs[9] = bf_hi(xb.x); xs[10] = bf_lo(xb.y); xs[11] = bf_hi(xb.y); xs[12] = bf_lo(xb.z); xs[13] = bf_hi(xb.z); xs[14] = bf_lo(xb.w); xs[15] = bf_hi(xb.w); }
                const unsigned char* PU8 = (const unsigned char*)PU; const unsigned char* PV8 = (const unsigned char*)PV;
                asm volatile("s_waitcnt vmcnt(0) lgkmcnt(0)" ::: "memory");
#define G_ISSUE(rix, slot) do { const int e_ = (rix) & 127; const int id_ = __builtin_amdgcn_readlane((e_ < 64) ? idA : idB, e_ & 63); \
        const unsigned char* src_ = (((rix) < 128) ? PU8 : PV8) + (size_t)id_ * DM + c0; \
        __builtin_amdgcn_global_load_lds((const unsigned*)src_, (LAS unsigned*)(slots + (slot) * 1024), 16, 0, 0); } while (0)
#define G_WAITV(n) asm volatile("s_waitcnt vmcnt(" #n ")" ::: "memory")
#define G_TAKE(dst, slot) do { dst = *(const LAS u32x4*)(slots + (slot) * 1024 + ln * 16); asm volatile("s_waitcnt lgkmcnt(0)" ::: "memory"); } while (0)
#pragma unroll
                for (int j = 0; j < 16; ++j) G_ISSUE(j, j);
                float dA = 0.f, dB = 0.f, r_[8];
                for (int it = 0; it < 8; ++it) {
#pragma unroll
                    for (int j = 0; j < 16; ++j) {
                        u32x4 u; G_WAITV(15); G_TAKE(u, j); G_ISSUE(16 * it + j + 16, j);
                        float d0 = 0.f, d1 = 0.f;
#pragma unroll
                        for (int k = 0; k < 4; ++k) { const f32x2 lo = __builtin_amdgcn_cvt_pk_f32_fp8((int)u[k], false), hi = __builtin_amdgcn_cvt_pk_f32_fp8((int)u[k], true);
                            d0 += lo[0] * xs[4 * k]; d1 += lo[1] * xs[4 * k + 1]; d0 += hi[0] * xs[4 * k + 2]; d1 += hi[1] * xs[4 * k + 3]; }
                        r_[j & 7] = d0 + d1;
                        if ((j & 7) == 7) { float r4[4], r2[2], r1;
#pragma unroll
                            for (int i = 0; i < 4; ++i) { const bool b_ = ln & 1; const float keep = b_ ? r_[2 * i + 1] : r_[2 * i], send = b_ ? r_[2 * i] : r_[2 * i + 1]; r4[i] = keep + __shfl_xor(send, 1); }
#pragma unroll
                            for (int i = 0; i < 2; ++i) { const bool b_ = ln & 2; const float keep = b_ ? r4[2 * i + 1] : r4[2 * i], send = b_ ? r4[2 * i] : r4[2 * i + 1]; r2[i] = keep + __shfl_xor(send, 2); }
                            { const bool b_ = ln & 4; const float keep = b_ ? r2[1] : r2[0], send = b_ ? r2[0] : r2[1]; r1 = keep + __shfl_xor(send, 4); }
                            r1 += __shfl_xor(r1, 8); r1 += __shfl_xor(r1, 16); r1 += __shfl_xor(r1, 32);
                            const int q = 2 * it + (j >> 3);
                            if ((ln >> 3) == (q & 7)) { if (q < 8) dA = r1; else dB = r1; } }
                    }
                }
                dA *= (1.0f / 64.0f); dB *= (1.0f / 64.0f);
                const float aA = 0.5f * dA * (1.0f + erff(dA * 0.70710678118654752f)) * wA * (1.0f / 64.0f), aB = 0.5f * dB * (1.0f + erff(dB * 0.70710678118654752f)) * wB * (1.0f / 64.0f);
                float acc[16];
#pragma unroll
                for (int i = 0; i < 16; ++i) acc[i] = 0.f;
#define G_VSTEP(WAITN, e_expr, REFILL) do { u32x4 v; G_WAITV(WAITN); G_TAKE(v, j); REFILL; const int e_ = (e_expr); \
        const float a_ = __uint_as_float(__builtin_amdgcn_readlane(__float_as_uint((e_ < 64) ? aA : aB), e_ & 63)); \
        _Pragma("unroll") for (int k = 0; k < 4; ++k) { const f32x2 lo = __builtin_amdgcn_cvt_pk_f32_fp8((int)v[k], false), hi = __builtin_amdgcn_cvt_pk_f32_fp8((int)v[k], true); \
            acc[4 * k] += a_ * lo[0]; acc[4 * k + 1] += a_ * lo[1]; acc[4 * k + 2] += a_ * hi[0]; acc[4 * k + 3] += a_ * hi[1]; } } while (0)
                for (int it = 0; it < 7; ++it) {
#pragma unroll
                    for (int j = 0; j < 16; ++j) G_VSTEP(15, 16 * it + j, G_ISSUE(128 + 16 * it + j + 16, j));
                }
                {
#define G_LAST(jj, n) do { const int j = jj; G_VSTEP(n, 112 + j, (void)0); } while (0)
                    G_LAST(0, 15); G_LAST(1, 14); G_LAST(2, 13); G_LAST(3, 12); G_LAST(4, 11); G_LAST(5, 10); G_LAST(6, 9); G_LAST(7, 8);
                    G_LAST(8, 7); G_LAST(9, 6); G_LAST(10, 5); G_LAST(11, 4); G_LAST(12, 3); G_LAST(13, 2); G_LAST(14, 1); G_LAST(15, 0);
#undef G_LAST
                }
#undef G_VSTEP
#undef G_ISSUE
#undef G_WAITV
#undef G_TAKE
                float s = 0.f;
#pragma unroll
                for (int i = 0; i < 16; ++i) s += acc[i] * acc[i];
                const float rp = rsqrtf(wave_sum(s) * (1.0f / DM) + EPS);
#pragma unroll
                for (int q = 0; q < 4; ++q) { const int cc = c0 + 4 * q; const f32x4 a4 = *(const LAS f32x4*)(VEC + 3072 + cc); f32x4 xm = *(const f32x4*)(out + row * DM + cc);
#pragma unroll
                    for (int e = 0; e < 4; ++e) xm[e] += a4[e] * (acc[q * 4 + e] * rp);
                    *(f32x4*)(out + row * DM + cc) = xm; }
            }
#else
            TM(7) for (int rr = wave * 32; rr < wave * 32 + 32; ++rr) {
                int ln = lane; asm volatile("" : "+v"(ln));
                const size_t row = (size_t)tok0 + rr; const int c0 = 8 * ln, c1 = 512 + 8 * ln;
                const int idA = EIDX[row * 128 + ln], idB = EIDX[row * 128 + 64 + ln]; const float wA = EW[row * 128 + ln], wB = EW[row * 128 + 64 + ln];
                const u32x4 xa = *(const u32x4*)(HF + row * DM + c0), xb = *(const u32x4*)(HF + row * DM + c1);
                float dA = 0.f, dB = 0.f;
#pragma unroll 2
                for (int q = 0; q < 16; ++q) {
                    float r[8];
#pragma unroll
                    for (int i = 0; i < 8; ++i) { const int id = __builtin_amdgcn_readlane((q < 8) ? idA : idB, (q & 7) * 8 + i); const u32x4* up = (const u32x4*)(PU + (size_t)id * DM) + ln;
                        const u32x4 u0 = up[0], u1 = up[64]; float d = dot2(u0.x, xa.x, 0.f); d = dot2(u0.y, xa.y, d); d = dot2(u0.z, xa.z, d); d = dot2(u0.w, xa.w, d);
                        d = dot2(u1.x, xb.x, d); d = dot2(u1.y, xb.y, d); d = dot2(u1.z, xb.z, d); d = dot2(u1.w, xb.w, d); r[i] = d; }
                    float r4[4], r2[2], r1;
#pragma unroll
                    for (int i = 0; i < 4; ++i) { const bool b0 = ln & 1; const float keep = b0 ? r[2 * i + 1] : r[2 * i], send = b0 ? r[2 * i] : r[2 * i + 1]; r4[i] = keep + __shfl_xor(send, 1); }
#pragma unroll
                    for (int i = 0; i < 2; ++i) { const bool b1 = ln & 2; const float keep = b1 ? r4[2 * i + 1] : r4[2 * i], send = b1 ? r4[2 * i] : r4[2 * i + 1]; r2[i] = keep + __shfl_xor(send, 2); }
                    { const bool b2 = ln & 4; const float keep = b2 ? r2[1] : r2[0], send = b2 ? r2[0] : r2[1]; r1 = keep + __shfl_xor(send, 4); }
                    r1 += __shfl_xor(r1, 8); r1 += __shfl_xor(r1, 16); r1 += __shfl_xor(r1, 32);
                    if ((ln >> 3) == (q & 7)) { if (q < 8) dA = r1; else dB = r1; }
                }
                const float aA = 0.5f * dA * (1.0f + erff(dA * 0.70710678118654752f)) * wA, aB = 0.5f * dB * (1.0f + erff(dB * 0.70710678118654752f)) * wB;
                float acc[16];
#pragma unroll
                for (int i = 0; i < 16; ++i) acc[i] = 0.f;
#pragma unroll 2
                for (int q = 0; q < 16; ++q) {
#pragma unroll
                    for (int i = 0; i < 8; ++i) { const int sl = (q & 7) * 8 + i; const int id = __builtin_amdgcn_readlane((q < 8) ? idA : idB, sl);
                        const float a = __uint_as_float(__builtin_amdgcn_readlane(__float_as_uint((q < 8) ? aA : aB), sl));
                        const u32x4* vp = (const u32x4*)(PV + (size_t)id * DM) + ln; const u32x4 v0 = vp[0], v1 = vp[64];
                        acc[0] += a * bf_lo(v0.x); acc[1] += a * bf_hi(v0.x); acc[2] += a * bf_lo(v0.y); acc[3] += a * bf_hi(v0.y); acc[4] += a * bf_lo(v0.z); acc[5] += a * bf_hi(v0.z); acc[6] += a * bf_lo(v0.w); acc[7] += a * bf_hi(v0.w);
                        acc[8] += a * bf_lo(v1.x); acc[9] += a * bf_hi(v1.x); acc[10] += a * bf_lo(v1.y); acc[11] += a * bf_hi(v1.y); acc[12] += a * bf_lo(v1.z); acc[13] += a * bf_hi(v1.z); acc[14] += a * bf_lo(v1.w); acc[15] += a * bf_hi(v1.w); }
                }
                float s = 0.f;
#pragma unroll
                for (int i = 0; i < 16; ++i) s += acc[i] * acc[i];
                const float rp = rsqrtf(wave_sum(s) * (1.0f / DM) + EPS);
#pragma unroll
                for (int q = 0; q < 4; ++q) { const int cc = (q < 2 ? c0 : c1) + (q & 1) * 4; const f32x4 a4 = *(const LAS f32x4*)(VEC + 3072 + cc); f32x4 xm = *(const f32x4*)(out + row * DM + cc);
#pragma unroll
                    for (int e = 0; e < 4; ++e) xm[e] += a4[e] * (acc[q * 4 + e] * rp);
                    *(f32x4*)(out + row * DM + cc) = xm; }
            }
#endif
        }
    }

#if PEER_XCD
    constexpr int NPH = 10;
    SEAM(5); PROBE(10);
    if (IN(6) || IN(8)) {
        DECL_PTRS
        float* PART = (float*)(ws + WS_GT); unsigned* PK = (unsigned*)(ws + WS_XP); float* SSQP = (float*)(ws + WS_XP + 32 * MiB); bf16_t* PEERO = (bf16_t*)(ws + WS_Q);
        const unsigned char* PU8 = (const unsigned char*)PU; const unsigned char* PV8 = (const unsigned char*)PV;
#pragma unroll 1
        for (int vph = 0; vph < 2; ++vph) {
            if (!(vph == 0 ? IN(6) : IN(8))) continue;
            const bool isv = vph == 1;
            int ln = lane; asm volatile("" : "+v"(ln));
            const int p = bx & 7, r = bx >> 3, nbp = (G - p + 7) >> 3;
            const int first = r * 8 + wave, stride = nbp * 8;
            const int T = (first < TL) ? (TL - 1 - first) / stride + 1 : 0;
            const int lg = ln >> 3, lc = ln & 7;
            const unsigned char* tab = (isv ? PV8 : PU8) + (size_t)p * ((size_t)16384 * 128);
            const int bp_base = lg * 4;
            const unsigned* HW = isv ? (const unsigned*)PK : (const unsigned*)EIDX;
            if (isv) gather_wave<true>(p, first, stride, T, ln, tab, bp_base, HW, HF, PART, PEERO, SSQP); else gather_wave<false>(p, first, stride, T, ln, tab, bp_base, HW, PEER_I8 ? (const bf16_t*)(ws + WS_HF8) : HF, PART, PEERO, SSQP);
            if (!isv) {
                SEAM(6); PROBE(11);
                if (IN(7)) for (int t0 = gw * 4; t0 < TL; t0 += NGW * 4) {
                    float dd[8]; float ew[8]; int ei[8]; float us[8];
#pragma unroll
                    for (int u_ = 0; u_ < 8; ++u_) { const size_t t = (size_t)t0 + (u_ >> 1); const int e = (u_ & 1) * 64 + lane; float d = 0.f;
#pragma unroll
                        for (int pp = 0; pp < 8; ++pp) d += __uint_as_float((unsigned)((const bf16_t*)PART)[((size_t)pp * TL + t) * 128 + e] << 16);
                        dd[u_] = PEER_I8 ? d * ((const float*)(ws + WS_XSCALE))[t] : d * (1.0f / 64.0f); ew[u_] = EW[t * 128 + e]; ei[u_] = EIDX[t * 128 + e]; }
#if PEER_I8
#pragma unroll
                    for (int u_ = 0; u_ < 8; ++u_) us[u_] = ((const float*)(ws + WS_USCALE))[ei[u_]];
#endif
#pragma unroll
                    for (int u_ = 0; u_ < 8; ++u_) { const size_t t = (size_t)t0 + (u_ >> 1); const int e = (u_ & 1) * 64 + lane; const float d = PEER_I8 ? dd[u_] * us[u_] : dd[u_];
                        const float a = 0.5f * d * (1.0f + erff(d * 0.70710678118654752f)) * ew[u_] * (1.0f / 64.0f);
                        PK[t * 128 + e] = (cvtpk(0.f, a) & 0xffff0000u) | (unsigned)ei[u_]; }
                }
                SEAM(7); PROBE(12);
            }
        }
    }
    SEAM(8); PROBE(13);
    if (IN(9)) {
        DECL_PTRS
        const float* SSQP = (const float*)(ws + WS_XP + 32 * MiB); const bf16_t* PEERO = (const bf16_t*)(ws + WS_Q);
        for (int blk = vcu; blk < 256; blk += G) {
            const int b = blk >> 3;
            __syncthreads();
            for (int k = tid; k < DM; k += NTHREADS) VEC[k] = modv(MOD, b_ada, b, 5120 + k) * g_ffn_post[k];
            __syncthreads();
            const int c0 = 8 * lane, c1 = 512 + 8 * lane;
            float nss[8]; u32x4 ny0, ny1, nm0, nm1;
#define F_LOAD(rr_) do { const size_t r_ = (size_t)blk * 256 + (rr_); _Pragma("unroll") for (int pp = 0; pp < 8; ++pp) nss[pp] = SSQP[(size_t)pp * TL + r_]; \
        ny0 = *(const u32x4*)(PEERO + r_ * DM + c0); ny1 = *(const u32x4*)(PEERO + r_ * DM + c1); \
        { const bf16_t* xmr_ = (const bf16_t*)(ws + xm_off(r_)); nm0 = *(const u32x4*)(xmr_ + c0); nm1 = *(const u32x4*)(xmr_ + c1); } } while (0)
            F_LOAD(wave);
            for (int rr = wave; rr < 256; rr += NWAVES) {
                const size_t row = (size_t)blk * 256 + rr; float ss = 0.f;
#pragma unroll
                for (int pp = 0; pp < 8; ++pp) ss += nss[pp];
                const u32x4 y0 = ny0, y1 = ny1, m0 = nm0, m1 = nm1;
                const f32x4 xmv[4] = {(f32x4){bf_lo(m0.x), bf_hi(m0.x), bf_lo(m0.y), bf_hi(m0.y)}, (f32x4){bf_lo(m0.z), bf_hi(m0.z), bf_lo(m0.w), bf_hi(m0.w)},
                                      (f32x4){bf_lo(m1.x), bf_hi(m1.x), bf_lo(m1.y), bf_hi(m1.y)}, (f32x4){bf_lo(m1.z), bf_hi(m1.z), bf_lo(m1.w), bf_hi(m1.w)}};
                if (rr + NWAVES < 256) F_LOAD(rr + NWAVES);
                const float rp = rsqrtf(ss * (1.0f / DM) + EPS);
                const float pv[16] = {bf_lo(y0.x), bf_hi(y0.x), bf_lo(y0.y), bf_hi(y0.y), bf_lo(y0.z), bf_hi(y0.z), bf_lo(y0.w), bf_hi(y0.w), bf_lo(y1.x), bf_hi(y1.x), bf_lo(y1.y), bf_hi(y1.y), bf_lo(y1.z), bf_hi(y1.z), bf_lo(y1.w), bf_hi(y1.w)};
#pragma unroll
                for (int q = 0; q < 4; ++q) { const int cc = (q < 2 ? c0 : c1) + (q & 1) * 4; const f32x4 a4 = *(const LAS f32x4*)(VEC + cc); f32x4 xm = xmv[q];
#pragma unroll
                    for (int e = 0; e < 4; ++e) xm[e] += a4[e] * (pv[q * 4 + e] * rp);
                    *(f32x4*)(out + row * DM + cc) = xm; }
            }
#undef F_LOAD
        }
    }
#else
    constexpr int NPH = 6;
#endif
    PROBE(9);
    if (PROBE_PT && PROBE_MODE) { xcd_barrier(xbar); if (blockIdx.x == 0 && threadIdx.x == 0) { const unsigned m_ = __hip_atomic_load((unsigned*)args.ws + 8192, __ATOMIC_RELAXED, __HIP_MEMORY_SCOPE_AGENT);
        probe_val = (float)(PROBE_MODE == 1 ? m_ : 0xFFFFFFFFu - m_) * (1.0f / PROBE_DIV); } }
    if (PROBE_PT && blockIdx.x == 0) { __syncthreads(); if (threadIdx.x == 0) args.out[0] = probe_val; }
#undef IN
#undef SEAM
}

extern "C" void kernel_launch(void* const* d_in, const int* in_sizes, int n_in, void* d_out, int out_size, void* d_ws, size_t ws_size, hipStream_t stream) {
    static int grid = 0;
    if (grid == 0) {
        if (n_in != 22 || out_size != TL * DM || ws_size < WS_END) { fprintf(stderr, "kernel_launch: unexpected shapes: n_in %d out %d ws %zu (need %zu)\n", n_in, out_size, ws_size, (size_t)WS_END); grid = -1; return; }
        int dev = 0, cus = 0, per_cu = 0;
        hipGetDevice(&dev); hipDeviceGetAttribute(&cus, hipDeviceAttributeMultiprocessorCount, dev);
        hipFuncSetAttribute((const void*)mk_fwd, hipFuncAttributeMaxDynamicSharedMemorySize, LDS_BYTES);
        hipOccupancyMaxActiveBlocksPerMultiprocessor(&per_cu, (const void*)mk_fwd, NTHREADS, LDS_BYTES);
        (void)hipGetLastError();
        if (per_cu < 1) { fprintf(stderr, "kernel_launch: occupancy query says %d blocks per CU\n", per_cu); }
        grid = cus;
    }
    if (grid < 0) return;
    if (hipMemsetAsync(d_ws, 0, 65536, stream) != hipSuccess) { fprintf(stderr, "kernel_launch: memset of the barrier words failed\n"); return; }
    Args a{};
    for (int i = 0; i < 22; ++i) a.in[i] = (const float*)d_in[i];
    a.out = (float*)d_out; a.ws = (unsigned char*)d_ws;
    if (MK_N_LAUNCHES == 1) {
        a.ph_lo = 0; a.ph_hi = PEER_XCD ? 10 : 6; void* kargs[] = {&a};
        hipError_t e = hipLaunchCooperativeKernel((const void*)mk_fwd, dim3(grid), dim3(NTHREADS), kargs, LDS_BYTES, stream);
        if (e != hipSuccess) fprintf(stderr, "cooperative launch failed: %s (grid %d)\n", hipGetErrorString(e), grid);
    } else {
        for (int p = 0; p < (PEER_XCD ? 10 : 6); ++p) { a.ph_lo = p; a.ph_hi = p + 1; hipLaunchKernelGGL(mk_fwd, dim3(grid), dim3(NTHREADS), LDS_BYTES, stream, a); }
    }
}
```

```cpp
#include <hip/hip_runtime.h>
#include <hip/hip_cooperative_groups.h>
#include <cstdint>
#include <cstdio>
namespace cg = cooperative_groups;

#ifndef PEER_I8
#define PEER_I8 1
#endif
#ifndef PEER_FOLD
#define PEER_FOLD 1
#endif
#ifndef S_I16
#define S_I16 1
#endif
#ifndef PEER_XCD
#define PEER_XCD 1
#endif
#ifndef PEER_FP8
#define PEER_FP8 1
#endif
#ifndef MK_N_LAUNCHES
#define MK_N_LAUNCHES 1
#endif

#define LAS __attribute__((address_space(3)))
typedef unsigned short bf16_t;
typedef short bf16x8 __attribute__((ext_vector_type(8)));
typedef short s16x4 __attribute__((ext_vector_type(4)));
typedef float f32x2 __attribute__((ext_vector_type(2)));
typedef float f32x4 __attribute__((ext_vector_type(4)));
typedef float f32x16 __attribute__((ext_vector_type(16)));
typedef unsigned u32x2 __attribute__((ext_vector_type(2)));
typedef unsigned u32x4 __attribute__((ext_vector_type(4)));
typedef __bf16 bf16x2_t __attribute__((ext_vector_type(2)));
typedef short s16x2 __attribute__((ext_vector_type(2)));

constexpr int DM = 1024, NB = 32, SEQ = 2048, CTXL = 256, TL = NB * SEQ, TC = NB * CTXL, TALL = TL + TC;
constexpr int NH = 8, DQK = 192, QW = NH * DQK, NKEY = CTXL + SEQ;
constexpr int NWIN = 3584;
constexpr int INW = 3520;
constexpr float EPS = 1e-6f;
constexpr float C2 = 0.07216878364870323f * 1.4426950408889634f;
constexpr int NWAVES = 8, NTHREADS = 512;

constexpr size_t MiB = 1u << 20;
constexpr size_t WS_MOD = 1 * MiB;
constexpr size_t WS_USCALE = 1 * MiB;
constexpr size_t WS_XSCALE = 1 * MiB + 128 * 1024;
constexpr size_t WS_ROPE = 2 * MiB;
constexpr size_t WS_SSQCQ = 3 * MiB;
constexpr size_t WS_SSQY = 4 * MiB;
constexpr size_t WS_WIN = 8 * MiB;
constexpr size_t WS_WQ = 15 * MiB;
constexpr size_t WS_WUV = 16 * MiB;
constexpr size_t WS_WPOOL = 16 * MiB + 512 * 1024;
constexpr size_t WS_KEYS = 17 * MiB;
constexpr size_t WS_WOUT = 18 * MiB;
constexpr size_t WS_WPQ = 20 * MiB;
constexpr size_t WS_PU = 24 * MiB;
constexpr size_t WS_PV = 56 * MiB;
constexpr size_t WS_HN = 88 * MiB;
constexpr size_t WS_CQ = 232 * MiB;
constexpr size_t WS_KVRAW = 264 * MiB;
constexpr size_t WS_KF = 318 * MiB;
constexpr size_t WS_XP = 345 * MiB;
constexpr size_t WS_GT = 473 * MiB;
constexpr size_t WS_Q = 729 * MiB;
constexpr size_t WS_S = WS_Q + 128 * MiB;
constexpr size_t WS_HF8 = WS_Q + 128 * MiB;
constexpr size_t WS_MODP = 922 * MiB;
constexpr size_t WS_XM_LO = 926 * MiB;
constexpr size_t WS_XM_HI = 296 * MiB;
constexpr size_t WS_END = 1022 * MiB;
__device__ __forceinline__ size_t xm_off(size_t row) { return row < 49152 ? WS_XM_LO + row * 2048 : WS_XM_HI + (row - 49152) * 2048; }

constexpr int RING_BYTES = 131072;
constexpr int VEC_OFF = RING_BYTES;
constexpr int MISC_OFF = 163840 - 1024;
constexpr int LDS_BYTES = 163840;

__device__ __forceinline__ unsigned cvtpk(float lo, float hi) { f32x2 v = {lo, hi}; bf16x2_t b = __builtin_convertvector(v, bf16x2_t); return __builtin_bit_cast(unsigned, b); }
__device__ __forceinline__ float bf_lo(unsigned w) { return __uint_as_float(w << 16); }
__device__ __forceinline__ float bf_hi(unsigned w) { return __uint_as_float(w & 0xffff0000u); }
__device__ __forceinline__ float wave_sum(float v) {
#pragma unroll
    for (int o = 1; o < 64; o <<= 1) v += __shfl_xor(v, o);
    return v;
}
__device__ __forceinline__ float wave_max(float v) {
#pragma unroll
    for (int o = 1; o < 64; o <<= 1) v = fmaxf(v, __shfl_xor(v, o));
    return v;
}
__device__ __forceinline__ unsigned pack_i8(float a, float b, float c, float d) {
    const int q0 = (int)__builtin_rintf(a), q1 = (int)__builtin_rintf(b), q2 = (int)__builtin_rintf(c), q3 = (int)__builtin_rintf(d);
    return (unsigned)(q0 & 255) | ((unsigned)(q1 & 255) << 8) | ((unsigned)(q2 & 255) << 16) | ((unsigned)q3 << 24); }
__device__ __forceinline__ float dot2(unsigned a, unsigned b, float c) { return __builtin_amdgcn_fdot2_f32_bf16(__builtin_bit_cast(bf16x2_t, a), __builtin_bit_cast(bf16x2_t, b), c, false); }
__device__ __forceinline__ float fast_sigmoid(float x) { return __builtin_amdgcn_rcpf(1.0f + __builtin_amdgcn_exp2f(-1.4426950408889634f * x)); }
__host__ __device__ __forceinline__ int rope_src(int j) { const int p = j >> 1; return (p >> 4) * 32 + (j & 1) * 16 + (p & 15); }

namespace pg8 {
constexpr int BM = 256, BK = 64, HALF = 128, HTB = HALF * BK * 2, STAGE_BYTES = 8 * HTB, NXCD = 8, WGM = 8;
__host__ __device__ __forceinline__ int lds_byte(int r, int c) { const int st = (r >> 4) * 2 + (c >> 5), rr = r & 15, cc = c & 31, ob = rr * 64 + cc * 2; return st * 1024 + (ob ^ (((ob >> 9) & 1) << 5)); }
__host__ __device__ __forceinline__ void stage_rc(int b, int& R, int& C) { const int st = b / 1024, sb = b % 1024, swz = sb ^ (((sb >> 9) & 1) << 5); R = (st >> 1) * 16 + swz / 64; C = (st & 1) * 32 + (swz % 64) / 2; }
__host__ __device__ __forceinline__ int perm32(int rho) { const int n = rho >> 4, i = rho & 15; return 8 * (i >> 2) + 4 * n + (i & 3); }

struct Unit { int pm, pn; long aoff, boff; };
struct Gemm { const bf16_t* A; const bf16_t* Bt; int lda, ldb, K; };

__device__ __forceinline__ bool grouped_tile(long L, int nM, int nN, int& pm, int& pn) {
    const int nwg = nM * nN; if (L >= nwg) return false;
    int wgid = (int)L; { const int q = nwg / NXCD, r = nwg % NXCD, xcd = wgid % NXCD, off = wgid / NXCD; wgid = (xcd < r ? xcd * (q + 1) : r * (q + 1) + (xcd - r) * q) + off; }
    const int nig = WGM * nN, gid = wgid / nig, fm = gid * WGM, gsz = (nM - fm) < WGM ? (nM - fm) : WGM;
    pm = fm + ((wgid % nig) % gsz); pn = (wgid % nig) / gsz; return true;
}

template <class Epi, class Sched, bool ALIGN_EPI>
__device__ __forceinline__ void gemm_phase(LAS unsigned char* lds, const Gemm g, const Sched& S, const Epi& E) {
    int tid = threadIdx.x; asm volatile("" : "+v"(tid));
    const int wid = __builtin_amdgcn_readfirstlane(tid >> 6), lane = tid & 63, wr = wid >> 2, wc = wid & 3, fr = lane & 15, fq = lane >> 4;
    const int nt = g.K / BK;
    unsigned voffA[2], voffB[2];
#pragma unroll
    for (int i = 0; i < 2; ++i) { int R, C; stage_rc(tid * 16 + i * 8192, R, C); const int Rb = Epi::PERM ? ((R & ~31) + perm32(R & 31)) : R;
        voffA[i] = (unsigned)(R * g.lda + C) * 2u; voffB[i] = (unsigned)(Rb * g.ldb + C) * 2u; }
    const size_t kstep = (size_t)(BK * 2);
    const size_t hA = (size_t)HALF * g.lda * 2, hB = (size_t)HALF * g.ldb * 2;
    const unsigned ldsw = (unsigned)wid * 1024u;
    const int aoff = lds_byte(wr * 64 + fr, fq * 8), boff = lds_byte(wc * 32 + fr, fq * 8);
#define PG8_SA(b, h) (((b) * 2 + (h)) * HTB)
#define PG8_SB(b, h) ((4 + (b) * 2 + (h)) * HTB)
#define PG8_STAGE(bufoff, gbase, voff) do { _Pragma("unroll") for (int _i = 0; _i < 2; ++_i) \
        __builtin_amdgcn_global_load_lds((const unsigned*)((const char*)(gbase) + (voff)[_i]), (LAS unsigned*)(lds + (bufoff) + ldsw + _i * 8192), 16, 0, 0); } while (0)
#define PG8_LDA(dst, b, h) do { _Pragma("unroll") for (int m = 0; m < 4; ++m) _Pragma("unroll") for (int k = 0; k < 2; ++k) dst[m][k] = *(const LAS bf16x8*)(lds + PG8_SA(b, h) + aoff + m * 2048 + k * 1024); } while (0)
#define PG8_LDB(dst, b, h) do { _Pragma("unroll") for (int n = 0; n < 2; ++n) _Pragma("unroll") for (int k = 0; k < 2; ++k) dst[n][k] = *(const LAS bf16x8*)(lds + PG8_SB(b, h) + boff + n * 2048 + k * 1024); } while (0)
#define PG8_MMA(ai, bj, At, Bt) do { __builtin_amdgcn_s_setprio(1); _Pragma("unroll") for (int m = 0; m < 4; ++m) _Pragma("unroll") for (int n = 0; n < 2; ++n) _Pragma("unroll") for (int k = 0; k < 2; ++k) \
        acc[ai][bj][m][n] = __builtin_amdgcn_mfma_f32_16x16x32_bf16(Bt[n][k], At[m][k], acc[ai][bj][m][n], 0, 0, 0); __builtin_amdgcn_s_setprio(0); } while (0)
#define PG8_WAIT_V(n) asm volatile("s_waitcnt vmcnt(" #n ")" ::: "memory")
#define PG8_WAIT_L(n) asm volatile("s_waitcnt lgkmcnt(" #n ")" ::: "memory")
#define PG8_BAR __builtin_amdgcn_s_barrier()
#define PG8_SCHED __builtin_amdgcn_sched_barrier(0)
    Unit cur, nxt; int ui = 0;
    if (!S.next(0, cur)) return;
    f32x4 acc[2][2][4][2];
#pragma unroll
    for (int a = 0; a < 2; ++a)
#pragma unroll
        for (int b = 0; b < 2; ++b)
#pragma unroll
            for (int m = 0; m < 4; ++m)
#pragma unroll
                for (int n = 0; n < 2; ++n) acc[a][b][m][n] = (f32x4){0.f, 0.f, 0.f, 0.f};
    bf16x8 At[4][2], B0[2][2], B1[2][2];
    const char* cA = (const char*)g.A + cur.aoff; const char* cB = (const char*)g.Bt + cur.boff;
    PG8_STAGE(PG8_SB(0, 0), cB, voffB); PG8_STAGE(PG8_SB(0, 1), cB + hB, voffB); PG8_STAGE(PG8_SA(0, 0), cA, voffA); PG8_STAGE(PG8_SA(0, 1), cA + hA, voffA);
    if (wr == 1) PG8_BAR;
    PG8_WAIT_V(2); PG8_BAR;
    PG8_STAGE(PG8_SB(1, 0), cB + kstep, voffB); PG8_STAGE(PG8_SA(1, 0), cA + kstep, voffA); PG8_STAGE(PG8_SB(1, 1), cB + hB + kstep, voffB);
    PG8_WAIT_V(6); PG8_BAR;
    for (;;) {
        const bool has_next = S.next(ui + 1, nxt);
        const char* nA = has_next ? (const char*)g.A + nxt.aoff : cA; const char* nB = has_next ? (const char*)g.Bt + nxt.boff : cB;
#pragma nounroll
        for (int t = 0; t < nt; t += 2) {
            const bool last = (t == nt - 2);
            const char* a1 = cA + (size_t)(t + 1) * kstep;
            const char* a2 = last ? nA : cA + (size_t)(t + 2) * kstep; const char* b2 = last ? nB : cB + (size_t)(t + 2) * kstep;
            const char* a3 = a2 + kstep; const char* b3 = b2 + kstep;
            PG8_LDB(B0, 0, 0); PG8_LDB(B1, 0, 1); PG8_SCHED; PG8_LDA(At, 0, 0); PG8_STAGE(PG8_SA(1, 1), a1 + hA, voffA);
            PG8_WAIT_V(8); PG8_WAIT_L(0); PG8_BAR; PG8_MMA(0, 0, At, B0); PG8_MMA(0, 1, At, B1); PG8_BAR; PG8_SCHED;
            PG8_LDA(At, 0, 1); PG8_STAGE(PG8_SB(0, 0), b2, voffB); PG8_STAGE(PG8_SB(0, 1), b2 + hB, voffB); PG8_STAGE(PG8_SA(0, 0), a2, voffA);
            PG8_WAIT_V(8); PG8_WAIT_L(0); PG8_BAR; PG8_MMA(1, 0, At, B0); PG8_MMA(1, 1, At, B1); PG8_BAR; PG8_SCHED;
            PG8_LDB(B0, 1, 0); PG8_LDB(B1, 1, 1); PG8_SCHED; PG8_LDA(At, 1, 0); PG8_STAGE(PG8_SA(0, 1), a2 + hA, voffA);
            PG8_WAIT_V(8); PG8_WAIT_L(0); PG8_BAR; PG8_MMA(0, 0, At, B0); PG8_MMA(0, 1, At, B1); PG8_BAR; PG8_SCHED;
            PG8_LDA(At, 1, 1); PG8_STAGE(PG8_SB(1, 0), b3, voffB); PG8_STAGE(PG8_SB(1, 1), b3 + hB, voffB); PG8_STAGE(PG8_SA(1, 0), a3, voffA);
            PG8_WAIT_V(8); PG8_WAIT_L(0); PG8_BAR; PG8_MMA(1, 0, At, B0); PG8_MMA(1, 1, At, B1); PG8_BAR; PG8_SCHED;
        }
        if constexpr (ALIGN_EPI) { if (wr == 0) PG8_BAR; }
        E(acc, cur, wr, wc, fr, fq);
        if (!has_next) break;
#pragma unroll
        for (int a = 0; a < 2; ++a)
#pragma unroll
            for (int b = 0; b < 2; ++b)
#pragma unroll
                for (int m = 0; m < 4; ++m)
#pragma unroll
                    for (int n = 0; n < 2; ++n) acc[a][b][m][n] = (f32x4){0.f, 0.f, 0.f, 0.f};
        cur = nxt; cA = nA; cB = nB; ++ui;
        if constexpr (ALIGN_EPI) { if (wr == 1) PG8_BAR; }
    }
    PG8_WAIT_V(0);
    if constexpr (!ALIGN_EPI) { if (wr == 0) PG8_BAR; }
    PG8_BAR;
#undef PG8_SA
#undef PG8_SB
#undef PG8_STAGE
#undef PG8_LDA
#undef PG8_LDB
#undef PG8_MMA
#undef PG8_WAIT_V
#undef PG8_WAIT_L
#undef PG8_BAR
#undef PG8_SCHED
}
}
using pg8::Unit;

struct SchedIn {
    int G, c;
    __device__ __forceinline__ bool next(int i, Unit& u) const {
        const long L = (long)i * G + c; if (L >= 256 * 14 + 32) return false;
        int pm, pn;
        if (L < 256 * 14) pg8::grouped_tile(L, 256, 14, pm, pn); else { pm = 256 + (int)(L - 256 * 14); pn = 1; }
        u.pm = pm; u.pn = pn; u.aoff = (long)pm * 256 * DM * 2; u.boff = (long)pn * 256 * DM * 2; return true;
    }
};
struct SchedQ {
    int G, c;
    __device__ __forceinline__ bool next(int i, Unit& u) const {
        const long L = (long)i * G + c; int pm, pn; if (!pg8::grouped_tile(L, 256, 6, pm, pn)) return false;
        u.pm = pm; u.pn = pn; u.aoff = (long)pm * 256 * 256 * 2; u.boff = (long)pn * 256 * 256 * 2; return true;
    }
};
struct SchedRow {
    int pm, pn0, n; long a_base, a_pn, b_base, b_pn;
    __device__ __forceinline__ bool next(int i, Unit& u) const {
        if (i >= n) return false; u.pm = pm; u.pn = pn0 + i; u.aoff = a_base + (long)(pn0 + i) * a_pn; u.boff = b_base + (long)(pn0 + i) * b_pn; return true;
    }
};

#define EPI_ROWS_BEGIN _Pragma("unroll") for (int ai = 0; ai < 2; ++ai) _Pragma("unroll") for (int m = 0; m < 4; ++m) { const int row = row0 + ai * 128 + m * 16;
#define EPI_ROWS_END asm volatile("" ::: "memory"); }
__device__ __forceinline__ u32x4 pack8(f32x4 v0, f32x4 v1) { u32x4 w; w.x = cvtpk(v0[0], v0[1]); w.y = cvtpk(v0[2], v0[3]); w.z = cvtpk(v1[0], v1[1]); w.w = cvtpk(v1[2], v1[3]); return w; }

struct EpiIn {
    static constexpr bool PERM = true;
    bf16_t* CQ; float* SSQ; float* KVRAW; bf16_t* XP; bf16_t* GT;
    __device__ __forceinline__ void operator()(const f32x4 (&acc)[2][2][4][2], const Unit& u, int wr, int wc, int fr, int fq) const {
        const int row0 = u.pm * 256 + wr * 64 + fr, cb = wc * 32 + 8 * fq, pn = u.pn;
        if (pn == 0) {
            EPI_ROWS_BEGIN  float s = 0.f;
#pragma unroll
                for (int bj = 0; bj < 2; ++bj) { const f32x4 v0 = acc[ai][bj][m][0], v1 = acc[ai][bj][m][1];
                    s += (v0[0] * v0[0] + v0[1] * v0[1]) + (v0[2] * v0[2] + v0[3] * v0[3]) + (v1[0] * v1[0] + v1[1] * v1[1]) + (v1[2] * v1[2] + v1[3] * v1[3]);
                    *(u32x4*)(CQ + (size_t)row * 256 + bj * 128 + cb) = pack8(v0, v1); }
                s += __shfl_xor(s, 16); s += __shfl_xor(s, 32);
                if (fq == 0) SSQ[(size_t)row * 4 + wc] = s;  EPI_ROWS_END
        } else if (pn == 1) {
            EPI_ROWS_BEGIN
#pragma unroll
                for (int bj = 0; bj < 2; ++bj) { const int col = bj * 128 + cb;
                    if (col < 192) { float* p = KVRAW + (size_t)row * 192 + col; *(f32x4*)p = acc[ai][bj][m][0]; *(f32x4*)(p + 4) = acc[ai][bj][m][1]; } }  EPI_ROWS_END
        } else if (pn < 6) {
            EPI_ROWS_BEGIN
#pragma unroll
                for (int bj = 0; bj < 2; ++bj) *(u32x4*)(XP + (size_t)row * 1024 + (pn - 2) * 256 + bj * 128 + cb) = pack8(acc[ai][bj][m][0], acc[ai][bj][m][1]);  EPI_ROWS_END
        } else {
            EPI_ROWS_BEGIN
#pragma unroll
                for (int bj = 0; bj < 2; ++bj) { f32x4 v0 = acc[ai][bj][m][0], v1 = acc[ai][bj][m][1];
#pragma unroll
                    for (int e = 0; e < 4; ++e) { v0[e] = fast_sigmoid(v0[e]); v1[e] = fast_sigmoid(v1[e]); }
                    *(u32x4*)(GT + (size_t)row * 2048 + (pn - 6) * 256 + bj * 128 + cb) = pack8(v0, v1); }  EPI_ROWS_END
        }
    }
};

struct EpiQ {
    static constexpr bool PERM = true;
    bf16_t* Q; const float* SSQ; const float* TAB;
    __device__ __forceinline__ void operator()(const f32x4 (&acc)[2][2][4][2], const Unit& u, int wr, int wc, int fr, int fq) const {
        const int row0 = u.pm * 256 + wr * 64 + fr, cb = wc * 32 + 8 * fq;
        EPI_ROWS_BEGIN  const f32x4 sq = *(const f32x4*)(SSQ + (size_t)row * 4);
            const float rs = rsqrtf(((sq[0] + sq[1]) + (sq[2] + sq[3])) * (1.0f / 256.0f) + EPS) * C2;
            const int t = row & (SEQ - 1), vr = t >> 6, vc = t & 63;
#pragma unroll
            for (int bj = 0; bj < 2; ++bj) { const int col = u.pn * 256 + bj * 128 + cb, h = col / DQK, hc = col - h * DQK;
                f32x4 v0 = acc[ai][bj][m][0] * rs, v1 = acc[ai][bj][m][1] * rs;
                if (hc >= 128) { const int p0 = (hc - 128) >> 1, v = (p0 >> 4) ? vc : vr; const float* tp = TAB + (v * 16 + (p0 & 15)) * 2;
                    const f32x4 t0 = *(const f32x4*)tp, t1 = *(const f32x4*)(tp + 4);
                    f32x4 r0, r1;
                    r0[0] = v0[0] * t0[0] - v0[1] * t0[1]; r0[1] = v0[0] * t0[1] + v0[1] * t0[0]; r0[2] = v0[2] * t0[2] - v0[3] * t0[3]; r0[3] = v0[2] * t0[3] + v0[3] * t0[2];
                    r1[0] = v1[0] * t1[0] - v1[1] * t1[1]; r1[1] = v1[0] * t1[1] + v1[1] * t1[0]; r1[2] = v1[2] * t1[2] - v1[3] * t1[3]; r1[3] = v1[2] * t1[3] + v1[3] * t1[2];
                    v0 = r0; v1 = r1; }
                *(u32x4*)(Q + (size_t)row * QW + col) = pack8(v0, v1); }  EPI_ROWS_END
    }
};

struct EpiU {
    static constexpr bool PERM = true;
    bf16_t* MG; const bf16_t* GT;
    __device__ __forceinline__ void operator()(const f32x4 (&acc)[2][2][4][2], const Unit& u, int wr, int wc, int fr, int fq) const {
        const int row0 = u.pm * 256 + wr * 64 + fr, cb = wc * 32 + 8 * fq;
        EPI_ROWS_BEGIN
#pragma unroll
            for (int bj = 0; bj < 2; ++bj) { const int col = u.pn * 256 + bj * 128 + cb; const u32x4 gw = *(const u32x4*)(GT + (size_t)row * 2048 + col);
                f32x4 v0 = acc[ai][bj][m][0], v1 = acc[ai][bj][m][1];
                v0[0] *= bf_lo(gw.x); v0[1] *= bf_hi(gw.x); v0[2] *= bf_lo(gw.y); v0[3] *= bf_hi(gw.y); v1[0] *= bf_lo(gw.z); v1[1] *= bf_hi(gw.z); v1[2] *= bf_lo(gw.w); v1[3] *= bf_hi(gw.w);
                *(u32x4*)(MG + (size_t)row * 1024 + col) = pack8(v0, v1); }  EPI_ROWS_END
    }
};
struct EpiP {
    static constexpr bool PERM = true;
    bf16_t* MG; const bf16_t* GT; const LAS float* PS;
    __device__ __forceinline__ void operator()(const f32x4 (&acc)[2][2][4][2], const Unit& u, int wr, int wc, int fr, int fq) const {
        const int row0 = u.pm * 256 + wr * 64 + fr, cb = wc * 32 + 8 * fq;
        EPI_ROWS_BEGIN
#pragma unroll
            for (int bj = 0; bj < 2; ++bj) { const int col = u.pn * 256 + bj * 128 + cb; const u32x4 gw = *(const u32x4*)(GT + (size_t)row * 2048 + 1024 + col);
                const u32x4 mw = *(const u32x4*)(MG + (size_t)row * 1024 + col);
                const f32x4 p0 = *(const LAS f32x4*)(PS + col), p1 = *(const LAS f32x4*)(PS + col + 4);
                f32x4 v0 = acc[ai][bj][m][0] * p0, v1 = acc[ai][bj][m][1] * p1;
                v0[0] = bf_lo(mw.x) + v0[0] * bf_lo(gw.x); v0[1] = bf_hi(mw.x) + v0[1] * bf_hi(gw.x); v0[2] = bf_lo(mw.y) + v0[2] * bf_lo(gw.y); v0[3] = bf_hi(mw.y) + v0[3] * bf_hi(gw.y);
                v1[0] = bf_lo(mw.z) + v1[0] * bf_lo(gw.z); v1[1] = bf_hi(mw.z) + v1[1] * bf_hi(gw.z); v1[2] = bf_lo(mw.w) + v1[2] * bf_lo(gw.w); v1[3] = bf_hi(mw.w) + v1[3] * bf_hi(gw.w);
                *(u32x4*)(MG + (size_t)row * 1024 + col) = pack8(v0, v1); }  EPI_ROWS_END
    }
};
struct EpiO {
    static constexpr bool PERM = true;
    bf16_t* Y; float* SSQ;
    __device__ __forceinline__ void operator()(const f32x4 (&acc)[2][2][4][2], const Unit& u, int wr, int wc, int fr, int fq) const {
        const int row0 = u.pm * 256 + wr * 64 + fr, cb = wc * 32 + 8 * fq;
        EPI_ROWS_BEGIN  float s = 0.f;
#pragma unroll
            for (int bj = 0; bj < 2; ++bj) { const f32x4 v0 = acc[ai][bj][m][0], v1 = acc[ai][bj][m][1];
                s += (v0[0] * v0[0] + v0[1] * v0[1]) + (v0[2] * v0[2] + v0[3] * v0[3]) + (v1[0] * v1[0] + v1[1] * v1[1]) + (v1[2] * v1[2] + v1[3] * v1[3]);
                *(u32x4*)(Y + (size_t)row * 1024 + u.pn * 256 + bj * 128 + cb) = pack8(v0, v1); }
            s += __shfl_xor(s, 16); s += __shfl_xor(s, 32);
            if (fq == 0) SSQ[(size_t)row * 16 + u.pn * 4 + wc] = s;  EPI_ROWS_END
    }
};
struct EpiStore {
    static constexpr bool PERM = true;
    bf16_t* O; int ld;
    __device__ __forceinline__ void operator()(const f32x4 (&acc)[2][2][4][2], const Unit& u, int wr, int wc, int fr, int fq) const {
        const int row0 = u.pm * 256 + wr * 64 + fr, cb = wc * 32 + 8 * fq;
        EPI_ROWS_BEGIN
#pragma unroll
            for (int bj = 0; bj < 2; ++bj) *(u32x4*)(O + (size_t)row * ld + u.pn * 256 + bj * 128 + cb) = pack8(acc[ai][bj][m][0], acc[ai][bj][m][1]);  EPI_ROWS_END
    }
};
struct EpiS4 {
    static constexpr bool PERM = true;
    float* S; int rot;
    __device__ __forceinline__ void operator()(const f32x4 (&acc)[2][2][4][2], const Unit& u, int wr, int wc, int fr, int fq) const {
        const int row0 = wr * 64 + fr, cb = wc * 32 + 8 * fq;
        EPI_ROWS_BEGIN
#pragma unroll
            for (int bj = 0; bj < 2; ++bj) {
#if S_I16
                const f32x4 v0 = acc[ai][bj][m][0] * 0.0625f, v1 = acc[ai][bj][m][1] * 0.0625f; u32x4 w;
                w.x = __builtin_bit_cast(unsigned, __builtin_amdgcn_cvt_pknorm_i16(v0[0], v0[1])); w.y = __builtin_bit_cast(unsigned, __builtin_amdgcn_cvt_pknorm_i16(v0[2], v0[3]));
                w.z = __builtin_bit_cast(unsigned, __builtin_amdgcn_cvt_pknorm_i16(v1[0], v1[1])); w.w = __builtin_bit_cast(unsigned, __builtin_amdgcn_cvt_pknorm_i16(v1[2], v1[3]));
                *(u32x4*)((short*)S + (size_t)((row + rot) & 255) * 2048 + (u.pn & 7) * 256 + bj * 128 + cb) = w;
#else
                float* p = S + (size_t)((row + rot) & 255) * 1024 + (u.pn & 3) * 256 + bj * 128 + cb; *(f32x4*)p = acc[ai][bj][m][0]; *(f32x4*)(p + 4) = acc[ai][bj][m][1];
#endif
            }
        EPI_ROWS_END
    }
};
struct EpiS {
    static constexpr bool PERM = true;
    float* S;
    __device__ __forceinline__ void operator()(const f32x4 (&acc)[2][2][4][2], const Unit& u, int wr, int wc, int fr, int fq) const {
        const int row0 = wr * 64 + fr, cb = wc * 32 + 8 * fq;
        EPI_ROWS_BEGIN
#pragma unroll
            for (int bj = 0; bj < 2; ++bj) { float* p = S + (size_t)row * 256 + bj * 128 + cb; *(f32x4*)p = acc[ai][bj][m][0]; *(f32x4*)(p + 4) = acc[ai][bj][m][1]; }  EPI_ROWS_END
    }
};

namespace att {
constexpr int KSTR = 400, SHM_K = 64 * KSTR, SHM_V = 16384;
constexpr int OFF_V = 0, OFF_K = 2 * SHM_V, OFF_WS = OFF_K + 2 * SHM_K, OFF_QL = OFF_WS + NWAVES * 256, NQL = 0, ATT_LDS = OFF_QL + NWAVES * NQL * 1024;
#define SBAR() __builtin_amdgcn_sched_barrier(0)
__device__ __forceinline__ int crow(int r, int hi) { return (r & 3) + 8 * (r >> 2) + 4 * hi; }
__device__ __forceinline__ int v_st(int k, int c) { const int kk = (k & ~0xC) | ((k & 4) << 1) | ((k & 8) >> 1); return ((kk >> 3) * 4 + (c >> 5)) * 512 + ((kk & 7) * 32 + (c & 31)) * 2; }
__device__ __forceinline__ int v_rd_base(int lane) { return ((lane & 3) << 3) | (((lane >> 2) & 3) << 6) | (((lane >> 4) & 1) << 5) | (((lane >> 5) & 1) << 8); }
constexpr int v_rd_off(int d0, int ks, int half) { return d0 * 512 + ks * 4096 + half * 2048; }
template <int OFF> __device__ __forceinline__ s16x4 tr_read(int vb) { s16x4 r; asm volatile("ds_read_b64_tr_b16 %0, %1 offset:%2" : "=&v"(r) : "v"(vb), "i"(OFF) : "memory"); return r; }
template <int D0> __device__ __forceinline__ void pv_one(f32x16& od, int vb, bf16x8 pa0, bf16x8 pa1, bf16x8 pa2, bf16x8 pa3) {
    const s16x4 l0 = tr_read<v_rd_off(D0, 0, 0)>(vb), h0 = tr_read<v_rd_off(D0, 0, 1)>(vb), l1 = tr_read<v_rd_off(D0, 1, 0)>(vb), h1 = tr_read<v_rd_off(D0, 1, 1)>(vb);
    const s16x4 l2 = tr_read<v_rd_off(D0, 2, 0)>(vb), h2 = tr_read<v_rd_off(D0, 2, 1)>(vb), l3 = tr_read<v_rd_off(D0, 3, 0)>(vb), h3 = tr_read<v_rd_off(D0, 3, 1)>(vb);
    asm volatile("s_waitcnt lgkmcnt(0)" ::: "memory"); SBAR();
#define PK(L, H) (bf16x8){L[0], L[1], L[2], L[3], H[0], H[1], H[2], H[3]}
    od = __builtin_amdgcn_mfma_f32_32x32x16_bf16(pa0, PK(l0, h0), od, 0, 0, 0);
    od = __builtin_amdgcn_mfma_f32_32x32x16_bf16(pa1, PK(l1, h1), od, 0, 0, 0);
    od = __builtin_amdgcn_mfma_f32_32x32x16_bf16(pa2, PK(l2, h2), od, 0, 0, 0);
    od = __builtin_amdgcn_mfma_f32_32x32x16_bf16(pa3, PK(l3, h3), od, 0, 0, 0);
#undef PK
}
__device__ __forceinline__ void pv_d0(f32x16* o, int vb, bf16x8 pa0, bf16x8 pa1, bf16x8 pa2, bf16x8 pa3) {
    pv_one<0>(o[0], vb, pa0, pa1, pa2, pa3); pv_one<1>(o[1], vb, pa0, pa1, pa2, pa3); pv_one<2>(o[2], vb, pa0, pa1, pa2, pa3); pv_one<3>(o[3], vb, pa0, pa1, pa2, pa3);
}
constexpr float THR = 8.0f;
__device__ __forceinline__ void partialSM(f32x16& p0, f32x16& p1, float& m_reg, float& mn, float& alpha) {
    float pmax = p0[0];
#pragma unroll
    for (int r = 1; r < 16; ++r) pmax = fmaxf(pmax, p0[r]);
#pragma unroll
    for (int r = 0; r < 16; ++r) pmax = fmaxf(pmax, p1[r]);
    { auto rr = __builtin_amdgcn_permlane32_swap(__float_as_uint(pmax), __float_as_uint(pmax), false, false); pmax = fmaxf(__uint_as_float(rr[0]), __uint_as_float(rr[1])); }
    if (__builtin_expect(__all(pmax - m_reg <= THR), 1)) { mn = m_reg; alpha = 1.f; }
    else { mn = fmaxf(m_reg, pmax); alpha = __builtin_amdgcn_exp2f(m_reg - mn); m_reg = mn; }
#pragma unroll
    for (int r = 0; r < 16; ++r) { p0[r] -= mn; p1[r] -= mn; }
#pragma unroll
    for (int r = 0; r < 16; ++r) p0[r] = __builtin_amdgcn_exp2f(p0[r]);
}
__device__ __forceinline__ void finishSM(f32x16& p0, f32x16& p1, float alpha, float& l_reg, bf16x8& pa0, bf16x8& pa1, bf16x8& pa2, bf16x8& pa3) {
#pragma unroll
    for (int r = 0; r < 16; ++r) p1[r] = __builtin_amdgcn_exp2f(p1[r]);
    float ps = 0;
#pragma unroll
    for (int r = 0; r < 16; ++r) ps += p0[r];
#pragma unroll
    for (int r = 0; r < 16; ++r) ps += p1[r];
    { auto rr = __builtin_amdgcn_permlane32_swap(__float_as_uint(ps), __float_as_uint(ps), false, false); ps = __uint_as_float(rr[0]) + __uint_as_float(rr[1]); }
    l_reg = l_reg * alpha + ps;
#define PK4(P, BASE, OUT) do { unsigned a0 = cvtpk(P[BASE + 0], P[BASE + 1]), a1 = cvtpk(P[BASE + 2], P[BASE + 3]);   \
    unsigned b0 = cvtpk(P[BASE + 4], P[BASE + 5]), b1 = cvtpk(P[BASE + 6], P[BASE + 7]);                              \
    auto r0 = __builtin_amdgcn_permlane32_swap(a0, b0, false, false); auto r1 = __builtin_amdgcn_permlane32_swap(a1, b1, false, false); \
    u32x4 w = {r0[0], r1[0], r0[1], r1[1]}; OUT = *reinterpret_cast<bf16x8*>(&w); } while (0)
    PK4(p0, 0, pa0); PK4(p0, 8, pa1); PK4(p1, 0, pa2); PK4(p1, 8, pa3);
#undef PK4
}
__device__ __forceinline__ void qkt(f32x16& p0, f32x16& p1, const char* Ks, const bf16x8* qr, const char* ql, int r32, int hi) {
    p0 = f32x16{}; p1 = f32x16{};
#pragma unroll
    for (int d0 = 0; d0 < 12; ++d0) { const int cbb = (d0 * 16 + hi * 8) * 2;
        const bf16x8 b0 = *reinterpret_cast<const bf16x8*>(Ks + r32 * KSTR + cbb);
        const bf16x8 b1 = *reinterpret_cast<const bf16x8*>(Ks + (32 + r32) * KSTR + cbb);
        const bf16x8 qf = (d0 < 12 - NQL) ? qr[d0] : *reinterpret_cast<const bf16x8*>(ql + (d0 - (12 - NQL)) * 1024);
        p0 = __builtin_amdgcn_mfma_f32_32x32x16_bf16(b0, qf, p0, 0, 0, 0);
        p1 = __builtin_amdgcn_mfma_f32_32x32x16_bf16(b1, qf, p1, 0, 0, 0);
        if ((d0 & 3) == 3) SBAR(); }
}
__device__ __forceinline__ void attn_unit(const bf16_t* __restrict__ Qg, const bf16_t* __restrict__ Kb, bf16_t* __restrict__ Og, int token0, int h, char* lds) {
    const int tid = threadIdx.x, wid = tid >> 6, lane = tid & 63, r32 = lane & 31, hi = lane >> 5;
    char* V_lds = lds + OFF_V; char* K_lds = lds + OFF_K;
    float* ws = (float*)(lds + OFF_WS) + wid * 64; float* li_l = ws; float* al_l = ws + 32;
    float m_reg = -1e30f, l_reg = 0; f32x16 o[4] = {}; bf16x8 qr[12 - NQL];
    const bf16_t* Qw = Qg + (size_t)(token0 + wid * 32 + r32) * QW + h * DQK + hi * 8;
    char* ql = lds + OFF_QL + wid * (NQL * 1024) + lane * 16;
#pragma unroll
    for (int d0 = 0; d0 < 12 - NQL; ++d0) qr[d0] = *reinterpret_cast<const bf16x8*>(Qw + d0 * 16);
#pragma unroll
    for (int d0 = 12 - NQL; d0 < 12; ++d0) *reinterpret_cast<bf16x8*>(ql + (d0 - (12 - NQL)) * 1024) = *reinterpret_cast<const bf16x8*>(Qw + d0 * 16);
    const int vb0 = (int)(uintptr_t)V_lds + v_rd_base(lane);
    bf16x8 sA[3];
#define SLOAD(S_, t_) do { int td_ = tid; asm volatile("" : "+v"(td_)); const bf16_t* tb_ = Kb + (size_t)(t_) * 64 * DQK + (td_ >> 3) * DQK + (td_ & 7) * 8; _Pragma("unroll") for (int i = 0; i < 3; ++i) S_[i] = *reinterpret_cast<const bf16x8*>(tb_ + i * 64); } while (0)
#define SWRITE(b_, S_) do { int td_ = tid; asm volatile("" : "+v"(td_)); const int kst = (td_ >> 3) * KSTR + (td_ & 7) * 16, vst = v_st(td_ >> 3, (td_ & 7) * 8); \
    _Pragma("unroll") for (int i = 0; i < 3; ++i) { *(bf16x8*)(K_lds + (b_) * SHM_K + kst + i * 128) = S_[i]; if (i < 2) *(bf16x8*)(V_lds + (b_) * SHM_V + vst + i * 1024) = S_[i]; } } while (0)
#define SWAIT() asm volatile("s_waitcnt vmcnt(0)" ::: "memory")
#define RESC(a) do { if (__any((a) < 1.f)) { if (hi == 0) al_l[r32] = (a); asm volatile("s_waitcnt lgkmcnt(0)" ::: "memory"); \
    _Pragma("unroll") for (int d = 0; d < 4; ++d) _Pragma("unroll") for (int r = 0; r < 16; ++r) o[d][r] *= al_l[crow(r, hi)]; } } while (0)
    f32x16 pA0, pA1, pB0, pB1; float mnA, mnB, alA, alB; bf16x8 pa0, pa1, pa2, pa3; constexpr int NT = NKEY / 64;
    SLOAD(sA, 0); asm volatile("s_waitcnt vmcnt(0)" ::: "memory"); SWRITE(0, sA); __syncthreads();
    qkt(pA0, pA1, K_lds, qr, ql, r32, hi); partialSM(pA0, pA1, m_reg, mnA, alA);
    SLOAD(sA, 1);
    SWAIT(); SWRITE(1, sA); __syncthreads();
    for (int j = 1; j + 1 < NT; j += 2) {
        SBAR(); qkt(pB0, pB1, K_lds + SHM_K, qr, ql, r32, hi);
        finishSM(pA0, pA1, alA, l_reg, pa0, pa1, pa2, pa3); SBAR();
        SLOAD(sA, j + 1); SBAR();
        pv_d0(o, vb0, pa0, pa1, pa2, pa3); partialSM(pB0, pB1, m_reg, mnB, alB);
        __syncthreads(); SWAIT(); SWRITE(0, sA);
        RESC(alB); __syncthreads();
        SBAR(); qkt(pA0, pA1, K_lds, qr, ql, r32, hi);
        finishSM(pB0, pB1, alB, l_reg, pa0, pa1, pa2, pa3); SBAR();
        SLOAD(sA, j + 2); SBAR();
        pv_d0(o, vb0 + SHM_V, pa0, pa1, pa2, pa3); partialSM(pA0, pA1, m_reg, mnA, alA);
        __syncthreads(); SWAIT(); SWRITE(1, sA);
        RESC(alA); __syncthreads();
    }
    SBAR(); qkt(pB0, pB1, K_lds + SHM_K, qr, ql, r32, hi);
    finishSM(pA0, pA1, alA, l_reg, pa0, pa1, pa2, pa3); SBAR();
    pv_d0(o, vb0, pa0, pa1, pa2, pa3); partialSM(pB0, pB1, m_reg, mnB, alB);
    __syncthreads(); RESC(alB);
    finishSM(pB0, pB1, alB, l_reg, pa0, pa1, pa2, pa3); SBAR();
    pv_d0(o, vb0 + SHM_V, pa0, pa1, pa2, pa3);
    if (hi == 0) li_l[r32] = l_reg; asm volatile("s_waitcnt lgkmcnt(0)" ::: "memory");
    float rli[16];
#pragma unroll
    for (int r = 0; r < 16; ++r) rli[r] = __builtin_amdgcn_rcpf(li_l[crow(r, hi)]);
    __syncthreads();
    int le = lane; asm volatile("" : "+v"(le));
    const int r32e = le & 31, hie = le >> 5;
    bf16_t* stg = (bf16_t*)(lds + wid * 8192) + (hie * 4) * 128 + r32e;
#pragma unroll
    for (int r = 0; r < 16; ++r) { const int orow = (r & 3) + 8 * (r >> 2);
#pragma unroll
        for (int d0 = 0; d0 < 4; ++d0) stg[orow * 128 + d0 * 32] = (bf16_t)(cvtpk(o[d0][r] * rli[r], 0.f) & 0xffffu); }
    asm volatile("s_waitcnt lgkmcnt(0)" ::: "memory");
    const bf16_t* stg2 = (const bf16_t*)(lds + wid * 8192) + (le >> 4) * 128 + (le & 15) * 8;
    bf16_t* Ow = Og + (size_t)(token0 + wid * 32 + (le >> 4)) * 1024 + h * 128 + (le & 15) * 8;
#pragma unroll
    for (int i = 0; i < 8; ++i) { const u32x4 v = *(const u32x4*)(stg2 + i * 4 * 128); *(u32x4*)(Ow + (size_t)i * 4 * 1024) = v; }
    __syncthreads();
#undef SLOAD
#undef SWRITE
#undef SWAIT
#undef RESC
}
#undef SBAR
}


#define XB_TMO      128
#define XB_XCNT(j)  (256  + 64 * (j))
#define XB_XSUB(j)  (1280 + 64 * (j))
#define XB_XGEN(j)  (2304 + 64 * (j))
#define XB_TOP      3328
#define XB_TOPGEN   3392
#define XCD_BAR_WORDS 3456
#define XB_SPIN_CAP (1u << 18)
__device__ __forceinline__ unsigned xb_ld(unsigned* p)              { return __hip_atomic_load(p, __ATOMIC_RELAXED, __HIP_MEMORY_SCOPE_AGENT); }
__device__ __forceinline__ unsigned xb_add(unsigned* p, unsigned v) { return __hip_atomic_fetch_add(p, v, __ATOMIC_RELAXED, __HIP_MEMORY_SCOPE_AGENT); }
__device__ __forceinline__ unsigned xb_xcc_id() { return (unsigned)__builtin_amdgcn_s_getreg((3 << 11) | 20) & 0xFu; }
#define XB_SPIN(cond, bar) do { unsigned _sp = 0; while (cond) { __builtin_amdgcn_s_sleep(1); \
    if ((++_sp & 255u) == 0u) { if (xb_ld(&(bar)[XB_TMO])) break; if (_sp > XB_SPIN_CAP) { atomicAdd(&(bar)[XB_TMO], 1u); break; } } } } while (0)
struct XcdBarrier { unsigned* bar; unsigned x; volatile LAS unsigned* st; };
__device__ __forceinline__ XcdBarrier xcd_barrier_post(unsigned* bar, volatile LAS unsigned* st) {
    XcdBarrier b; b.bar = bar; b.x = xb_xcc_id(); b.st = st;
    if (threadIdx.x == 0) (void)xb_add(&bar[XB_XCNT(b.x)], 1u);
    return b;
}
__device__ __forceinline__ void xcd_barrier_complete(unsigned* bar, unsigned x, unsigned& nloc, unsigned& nx) {
    const unsigned G = gridDim.x * gridDim.y * gridDim.z;
    unsigned sum, cnt, mine, sp = 0u;
    for (;;) {
        sum = 0u; cnt = 0u; mine = 0u;
#pragma unroll
        for (unsigned j = 0; j < 16; ++j) { const unsigned c = xb_ld(&bar[XB_XCNT(j)]); sum += c; cnt += (c > 0u) ? 1u : 0u; mine = (j == x) ? c : mine; }
        if (sum == G) break;
        __builtin_amdgcn_s_sleep(1);
        if ((++sp & 255u) == 0u) { if (xb_ld(&bar[XB_TMO])) break; if (sp > XB_SPIN_CAP) { atomicAdd(&bar[XB_TMO], 1u); break; } }
    }
    nloc = mine > 0u ? mine : 1u; nx = cnt > 0u ? cnt : 1u;
}
__device__ __forceinline__ void xcd_barrier(const XcdBarrier& b) {
    asm volatile("s_waitcnt vmcnt(0)" ::: "memory");
    __syncthreads();
    if (threadIdx.x == 0) {
        unsigned* bar = b.bar;
        __builtin_amdgcn_s_waitcnt(0);
        unsigned nloc = b.st[0], nx = b.st[1];
        if (nloc == 0u) { xcd_barrier_complete(bar, b.x, nloc, nx); b.st[0] = nloc; b.st[1] = nx; }
        const unsigned old = xb_add(&bar[XB_XSUB(b.x)], 1u);
        const unsigned gen = old / nloc;
        if (old + 1u == (gen + 1u) * nloc) {
            __builtin_amdgcn_fence(__ATOMIC_RELEASE, "agent");
            asm volatile("s_waitcnt vmcnt(0)" ::: "memory");
            const unsigned og = xb_add(&bar[XB_TOP], 1u);
            const unsigned tg = og / nx;
            if (og + 1u == (tg + 1u) * nx) xb_add(&bar[XB_TOPGEN], 1u);
            else XB_SPIN(xb_ld(&bar[XB_TOPGEN]) == tg, bar);
            __builtin_amdgcn_fence(__ATOMIC_ACQUIRE, "agent");
            xb_add(&bar[XB_XGEN(b.x)], 1u);
            asm volatile("s_waitcnt vmcnt(0)" ::: "memory");
        } else {
            XB_SPIN(xb_ld(&bar[XB_XGEN(b.x)]) == gen, bar);
            __builtin_amdgcn_fence(__ATOMIC_ACQUIRE, "agent");
            asm volatile("s_waitcnt vmcnt(0)" ::: "memory");
        }
    }
    __syncthreads();
}


__device__ __forceinline__ float modv(const float* MODP, const float* b_ada, int r, int col) {
    const float* p = MODP + (size_t)r * 6144 + col; constexpr size_t KS = (size_t)33 * 6144;
    return ((p[0] + p[KS]) + (p[2 * KS] + p[3 * KS])) + b_ada[col];
}

struct Args { const float* in[22]; float* out; unsigned char* ws; int ph_lo, ph_hi; };

template <class RowMap>
__device__ __forceinline__ void transpose_item(const float* __restrict__ W, int K, int N, bf16_t* __restrict__ WT, LAS float* scr, int item, int lane, const RowMap& rowmap) {
    const int nblk = N / 32, kb = item / nblk, nb = item % nblk, k0 = 64 * kb, n0 = 32 * nb;
#pragma unroll 8
    for (int i = 0; i < 32; ++i) { const int kk = 2 * i + (lane >> 5); scr[kk * 33 + (lane & 31)] = W[(size_t)(k0 + kk) * N + n0 + (lane & 31)]; }
    asm volatile("s_waitcnt lgkmcnt(0)" ::: "memory");
    const int c = lane & 7;
#pragma unroll
    for (int j = 0; j < 4; ++j) { const int n = (lane >> 3) + 8 * j; const LAS float* s = scr + (8 * c) * 33 + n;
        u32x4 o; o.x = cvtpk(s[0 * 33], s[1 * 33]); o.y = cvtpk(s[2 * 33], s[3 * 33]); o.z = cvtpk(s[4 * 33], s[5 * 33]); o.w = cvtpk(s[6 * 33], s[7 * 33]);
        *(u32x4*)(WT + (size_t)rowmap(n0 + n) * K + k0 + 8 * c) = o; }
    asm volatile("s_waitcnt lgkmcnt(0)" ::: "memory");
}
struct MapIn { __device__ __forceinline__ int operator()(int n) const {
    if (n < 128) return 256 + n;
    if (n < 192) { const int s = n - 128, axis = s >> 5, e = (s >> 4) & 1, f = s & 15; return 384 + 2 * (axis * 16 + f) + e; }
    if (n < 448) return n - 192;
    if (n < 1472) return 512 + (n - 448);
    return 1536 + (n - 1472); } };
struct MapId { __device__ __forceinline__ int operator()(int n) const { return n; } };

__device__ __forceinline__ unsigned f2key(float f) { const unsigned u = __float_as_uint(f); return (u & 0x80000000u) ? ~u : (u | 0x80000000u); }
__device__ __forceinline__ float key2f(unsigned k) { const unsigned u = (k & 0x80000000u) ? (k & 0x7fffffffu) : ~k; return __uint_as_float(u); }

template <int CTRL> __device__ __forceinline__ unsigned dpp_u(unsigned v) { return (unsigned)__builtin_amdgcn_update_dpp(0, (int)v, CTRL, 0xF, 0xF, true); }
template <int CTRL> __device__ __forceinline__ float dpp_f(float v) { return __uint_as_float((unsigned)__builtin_amdgcn_update_dpp(0, (int)__float_as_uint(v), CTRL, 0xF, 0xF, true)); }
#define ROW_MAXU(m) do { m = max(m, dpp_u<0x128>(m)); m = max(m, dpp_u<0x124>(m)); m = max(m, dpp_u<0x122>(m)); m = max(m, dpp_u<0x121>(m)); } while (0)
#define CE_DESC(a, b) do { const unsigned hi_ = max(a, b), lo_ = min(a, b); a = hi_; b = lo_; } while (0)
template <int NC, bool I16 = false>
__device__ __forceinline__ void top16_of_128(const f32x4 (&sa)[NC], const f32x4 (&sb)[NC], int i16, unsigned (&mine)[NC]) {
    unsigned k[NC][8];
#pragma unroll
    for (int c = 0; c < NC; ++c) {
#pragma unroll
        for (int e = 0; e < 4; ++e) {
            if (I16) {
                const unsigned wa = __float_as_uint(sa[c][e >> 1]), wb = __float_as_uint(sb[c][e >> 1]);
                const unsigned ha = ((e & 1) ? (wa >> 16) : (wa & 0xffffu)) ^ 0x8000u, hb = ((e & 1) ? (wb >> 16) : (wb & 0xffffu)) ^ 0x8000u;
                k[c][e] = (ha << 16) | (unsigned)(127 - (4 * i16 + e)); k[c][4 + e] = (hb << 16) | (unsigned)(127 - (64 + 4 * i16 + e));
            } else { k[c][e] = (f2key(sa[c][e]) & ~0x7Fu) | (unsigned)(127 - (4 * i16 + e)); k[c][4 + e] = (f2key(sb[c][e]) & ~0x7Fu) | (unsigned)(127 - (64 + 4 * i16 + e)); } }
        CE_DESC(k[c][0], k[c][1]); CE_DESC(k[c][2], k[c][3]); CE_DESC(k[c][4], k[c][5]); CE_DESC(k[c][6], k[c][7]);
        CE_DESC(k[c][0], k[c][2]); CE_DESC(k[c][1], k[c][3]); CE_DESC(k[c][4], k[c][6]); CE_DESC(k[c][5], k[c][7]);
        CE_DESC(k[c][1], k[c][2]); CE_DESC(k[c][5], k[c][6]);
        CE_DESC(k[c][0], k[c][4]); CE_DESC(k[c][1], k[c][5]); CE_DESC(k[c][2], k[c][6]); CE_DESC(k[c][3], k[c][7]);
        CE_DESC(k[c][2], k[c][4]); CE_DESC(k[c][3], k[c][5]);
        CE_DESC(k[c][1], k[c][2]); CE_DESC(k[c][3], k[c][4]); CE_DESC(k[c][5], k[c][6]);
        mine[c] = 0u; }
#pragma unroll
    for (int it = 0; it < 16; ++it) {
        unsigned m[NC];
#pragma unroll
        for (int c = 0; c < NC; ++c) m[c] = max(k[c][0], dpp_u<0x128>(k[c][0]));
#pragma unroll
        for (int c = 0; c < NC; ++c) m[c] = max(m[c], dpp_u<0x124>(m[c]));
#pragma unroll
        for (int c = 0; c < NC; ++c) m[c] = max(m[c], dpp_u<0x122>(m[c]));
#pragma unroll
        for (int c = 0; c < NC; ++c) m[c] = max(m[c], dpp_u<0x121>(m[c]));
#pragma unroll
        for (int c = 0; c < NC; ++c) { const bool tk = (k[c][0] == m[c]);
#pragma unroll
            for (int e = 0; e < 7; ++e) k[c][e] = tk ? k[c][e + 1] : k[c][e];
            k[c][7] = tk ? 0u : k[c][7];
            mine[c] = (i16 == it) ? m[c] : mine[c]; }
    }
}
__device__ __forceinline__ void topk_head(const f32x4 sc, int lane, int ca, int cb, int& expert, float& gate) {
    const int j = lane & 31;
    unsigned k0 = (f2key(sc[0]) & ~0x7Fu) | (unsigned)(127 - (4 * j + 0)), k1 = (f2key(sc[1]) & ~0x7Fu) | (unsigned)(127 - (4 * j + 1));
    unsigned k2 = (f2key(sc[2]) & ~0x7Fu) | (unsigned)(127 - (4 * j + 2)), k3 = (f2key(sc[3]) & ~0x7Fu) | (unsigned)(127 - (4 * j + 3));
    unsigned mine = 0u;
#pragma unroll 1
    for (int it = 0; it < 16; ++it) {
        unsigned mx = max(max(k0, k1), max(k2, k3));
#pragma unroll
        for (int o = 1; o < 32; o <<= 1) mx = max(mx, (unsigned)__shfl_xor((int)mx, o));
        if (j == it) mine = mx;
        k0 = (k0 == mx) ? 0u : k0; k1 = (k1 == mx) ? 0u : k1; k2 = (k2 == mx) ? 0u : k2; k3 = (k3 == mx) ? 0u : k3;
    }
    const float val = key2f(mine & ~0x7Fu); const int kid = 127 - (int)(mine & 0x7Fu);
    const float s0 = __shfl(val, ca), s1 = __shfl(val, 32 + cb);
    const int i0 = __shfl(kid, ca), i1 = __shfl(kid, 32 + cb);
    const int myexp = i0 * 128 + i1;
    unsigned ck = (lane < 50) ? ((f2key(s0 + s1) & ~0x3Fu) | (unsigned)(63 - lane)) : 0u;
    unsigned best = 0u;
#pragma unroll 1
    for (int it = 0; it < 16; ++it) {
        unsigned mx = ck;
#pragma unroll
        for (int o = 1; o < 64; o <<= 1) mx = max(mx, (unsigned)__shfl_xor((int)mx, o));
        if (lane == it) best = mx;
        ck = (ck == mx) ? 0u : ck;
    }
    const float bv = key2f(best & ~0x3Fu); const int bc = 63 - (int)(best & 0x3Fu);
    expert = __shfl(myexp, bc);
    const float top = __shfl(bv, 0);
    float ex = (lane < 16) ? __builtin_amdgcn_exp2f((bv - top) * 1.4426950408889634f) : 0.f;
    float sum = ex;
#pragma unroll
    for (int o = 1; o < 16; o <<= 1) sum += __shfl_xor(sum, o);
    gate = ex / sum;
}


template <bool ISV>
__device__ __forceinline__ void gather_wave(int p, int first, int stride, int T, int ln, const unsigned char* tabu, int bp_base, const unsigned* HW, const bf16_t* HF, float* PART, bf16_t* PEERO, float* SSQP) {
    constexpr bool isv = ISV; const int lg = ln >> 3, lc = ln & 7; const unsigned lc16 = (unsigned)lc * 16u;
#define TOKEN(k_) ((size_t)first + (size_t)(((k_) < T ? (k_) : T - 1)) * stride)
#define PERM8(W, H_, o_) do { _Pragma("unroll") for (int j_ = 0; j_ < 8; ++j_) W[j_] = (unsigned)__builtin_amdgcn_ds_bpermute(bp_base + 32 * j_, (int)(H_)); } while (0)
#define LOAD8(B, W) do { _Pragma("unroll") for (int j_ = 0; j_ < 8; ++j_) B[j_] = *(const u32x4*)(tab + (size_t)(W[j_] & 0x3FFFu) * 128); } while (0)
#define SBX() __builtin_amdgcn_sched_barrier(0)
            if (T > 0) {
                u32x4 bA[16], bB[16]; unsigned wA[16], wB[16];
#define PERM16(W, HA_, HB_) do { _Pragma("unroll") for (int j_ = 0; j_ < 16; ++j_) W[j_] = (unsigned)__builtin_amdgcn_ds_bpermute(bp_base + 32 * (j_ & 7), (int)((j_ < 8) ? (HA_) : (HB_))); } while (0)
#define LOAD16(B, W) do { _Pragma("unroll") for (int j_ = 0; j_ < 16; ++j_) B[j_] = *(const u32x4*)(tabu + (((W[j_] & 0x3FFFu) << 7) | lc16)); } while (0)
#define HDR(k_, HA_, HB_) do { const size_t t_ = TOKEN(k_); HA_ = HW[t_ * 128 + ln]; HB_ = HW[t_ * 128 + 64 + ln]; } while (0)
#if PEER_I8
#define XLD(k_, X0, X1) do { if (!isv) { X0 = *(const u32x4*)((const unsigned char*)HF + TOKEN(k_) * DM + p * 128 + lc * 16); } } while (0)
#else
#define XLD(k_, X0, X1) do { if (!isv) { const bf16_t* xp_ = HF + TOKEN(k_) * DM + p * 128 + lc * 16; X0 = *(const u32x4*)xp_; X1 = *(const u32x4*)(xp_ + 8); } } while (0)
#endif
#define CONSUME(B, W, X0, X1, k_) do { const size_t tk = TOKEN(k_); float RA = 0.f, RB = 0.f; int IA = 0, IB = 0; f32x2 acc[8]; \
        const unsigned xw[8] = {X0.x, X0.y, X0.z, X0.w, X1.x, X1.y, X1.z, X1.w};     \
        _Pragma("unroll") for (int i = 0; i < 8; ++i) acc[i] = (f32x2){0.f, 0.f}; \
        _Pragma("unroll") for (int j = 0; j < 16; ++j) { \
            if (!isv && PEER_I8) { int e_ = 0;     \
                _Pragma("unroll") for (int q = 0; q < 4; ++q) e_ = __builtin_amdgcn_sdot4((int)B[j][q], (int)xw[q], e_, false); \
                unsigned du = (unsigned)e_; du += dpp_u<0xB1>(du); du += dpp_u<0x4E>(du); du += dpp_u<0x141>(du); \
                if (j < 8) IA = (lc == (j & 7)) ? (int)du : IA; else IB = (lc == (j & 7)) ? (int)du : IB; } \
            else if (!isv) { float e0 = 0.f, e1 = 0.f; \
                _Pragma("unroll") for (int q = 0; q < 4; ++q) { const bf16x2_t lo = __builtin_amdgcn_cvt_scalef32_pk_bf16_fp8(B[j][q], 1.0f, false), hi = __builtin_amdgcn_cvt_scalef32_pk_bf16_fp8(B[j][q], 1.0f, true); \
                    e0 = __builtin_amdgcn_fdot2_f32_bf16(lo, __builtin_bit_cast(bf16x2_t, xw[2 * q]), e0, false); e1 = __builtin_amdgcn_fdot2_f32_bf16(hi, __builtin_bit_cast(bf16x2_t, xw[2 * q + 1]), e1, false); } \
                float d = e0 + e1; d += dpp_f<0xB1>(d); d += dpp_f<0x4E>(d); d += dpp_f<0x141>(d); \
                if (j < 8) RA = (lc == (j & 7)) ? d : RA; else RB = (lc == (j & 7)) ? d : RB; } \
            else { const float a1_ = __uint_as_float(W[j] & 0xffff0000u); const f32x2 a_ = (f32x2){a1_, a1_}; \
                _Pragma("unroll") for (int q = 0; q < 4; ++q) { const f32x2 lo = __builtin_amdgcn_cvt_pk_f32_fp8((int)B[j][q], false), hi = __builtin_amdgcn_cvt_pk_f32_fp8((int)B[j][q], true); \
                    acc[2 * q] = __builtin_elementwise_fma(a_, lo, acc[2 * q]); acc[2 * q + 1] = __builtin_elementwise_fma(a_, hi, acc[2 * q + 1]); } } } \
        if (!isv) { if (PEER_I8) { RA = (float)IA; RB = (float)IB; } bf16_t* po = (bf16_t*)PART + ((size_t)p * TL + tk) * 128 + 8 * lc + lg; po[0] = (bf16_t)(cvtpk(RA, 0.f) & 0xffffu); po[64] = (bf16_t)(cvtpk(RB, 0.f) & 0xffffu); }     \
        else { float ss = 0.f; float ac[16]; \
            _Pragma("unroll") for (int i = 0; i < 16; ++i) { float t = acc[i >> 1][i & 1]; t += dpp_f<0x128>(t); \
                { auto r_ = __builtin_amdgcn_permlane16_swap(__float_as_uint(t), __float_as_uint(t), false, false); t = __uint_as_float(r_[0]) + __uint_as_float(r_[1]); } \
                { auto r_ = __builtin_amdgcn_permlane32_swap(__float_as_uint(t), __float_as_uint(t), false, false); t = __uint_as_float(r_[0]) + __uint_as_float(r_[1]); } \
                ac[i] = t; ss += t * t; } \
            ss += dpp_f<0xB1>(ss); ss += dpp_f<0x4E>(ss); ss += dpp_f<0x141>(ss); \
            if (lg == 0) { u32x4 o0, o1; o0.x = cvtpk(ac[0], ac[1]); o0.y = cvtpk(ac[2], ac[3]); o0.z = cvtpk(ac[4], ac[5]); o0.w = cvtpk(ac[6], ac[7]); \
                o1.x = cvtpk(ac[8], ac[9]); o1.y = cvtpk(ac[10], ac[11]); o1.z = cvtpk(ac[12], ac[13]); o1.w = cvtpk(ac[14], ac[15]); \
                bf16_t* po = PEERO + tk * DM + p * 128 + lc * 16; *(u32x4*)po = o0; *(u32x4*)(po + 8) = o1; } \
            if (ln == 0) SSQP[(size_t)p * TL + tk] = ss; } } while (0)
                unsigned hA, hB, gA, gB; u32x4 xa0 = (u32x4){0u, 0u, 0u, 0u}, xa1 = xa0, xb0 = xa0, xb1 = xa0;
                HDR(0, hA, hB); HDR(1, gA, gB); XLD(0, xa0, xa1);
                PERM16(wA, hA, hB); LOAD16(bA, wA);
#pragma unroll 1
                for (int k = 0; k < T; k += 2) {
                    PERM16(wB, gA, gB); LOAD16(bB, wB); XLD(k + 1, xb0, xb1); HDR(k + 2, hA, hB); SBX();
                    CONSUME(bA, wA, xa0, xa1, k); SBX();
                    PERM16(wA, hA, hB); LOAD16(bA, wA); XLD(k + 2, xa0, xa1); HDR(k + 3, gA, gB); SBX();
                    CONSUME(bB, wB, xb0, xb1, k + 1); SBX();
                }
#undef PERM16
#undef LOAD16
#undef HDR
#undef XLD
#undef CONSUME
            }
#undef TOKEN
#undef PERM8
#undef LOAD8
#undef SBX
}
#ifndef SKIP_TOPK
#define SKIP_TOPK 0
#endif
#ifndef PROBE_PT
#define PROBE_PT 0
#endif
#ifndef PROBE_DIV
#define PROBE_DIV 1000
#endif
#ifndef PROBE_BASE
#define PROBE_BASE 190000
#endif
#ifndef PROBE_MODE
#define PROBE_MODE 0
#endif
#define PROBE(k) do { if (PROBE_PT == (k) && threadIdx.x == 0) { const unsigned tk_ = (unsigned)(__builtin_amdgcn_s_memrealtime() - probe_t0); \
        if (PROBE_MODE == 0) { if (blockIdx.x == 0) probe_val = ((float)tk_ - (float)PROBE_BASE) * (1.0f / PROBE_DIV); } \
        else atomicMax((unsigned*)args.ws + 8192, PROBE_MODE == 1 ? tk_ : 0xFFFFFFFFu - tk_); } } while (0)
#define DECL_PTRS \
    unsigned char* ws = args.ws; \
    const float* x = args.in[0]; const float* cvec = args.in[1]; const float* ctx = args.in[2]; const float* c_ctx = args.in[3]; \
    const float* w_ada = args.in[4]; const float* b_ada = args.in[5]; const float* g_mix_pre = args.in[6]; const float* g_mix_post = args.in[7]; \
    const float* g_ffn_pre = args.in[8]; const float* g_ffn_post = args.in[9]; const float* w_in = args.in[10]; const float* g_q_lora = args.in[11]; \
    const float* w_uq = args.in[12]; const float* g_kv_lora = args.in[13]; const float* w_ukv = args.in[14]; const float* w_pool = args.in[15]; \
    const float* pool_scale = args.in[16]; const float* w_out = args.in[17]; const float* peer_wq = args.in[18]; const float* peer_keys = args.in[19]; \
    const float* peer_u = args.in[20]; const float* peer_v = args.in[21]; \
    float* out = args.out; \
    float* MOD = (float*)(ws + WS_MODP); float* TAB = (float*)(ws + WS_ROPE); float* SSQCQ = (float*)(ws + WS_SSQCQ); float* SSQY = (float*)(ws + WS_SSQY); \
    bf16_t* WIN = (bf16_t*)(ws + WS_WIN); bf16_t* WQ = (bf16_t*)(ws + WS_WQ); bf16_t* WUV = (bf16_t*)(ws + WS_WUV); bf16_t* WPOOL = (bf16_t*)(ws + WS_WPOOL); \
    bf16_t* KEYS = (bf16_t*)(ws + WS_KEYS); bf16_t* WOUT = (bf16_t*)(ws + WS_WOUT); bf16_t* WPQ = (bf16_t*)(ws + WS_WPQ); \
    bf16_t* PU = (bf16_t*)(ws + WS_PU); bf16_t* PV = (bf16_t*)(ws + WS_PV); \
    bf16_t* HN = (bf16_t*)(ws + WS_HN); bf16_t* OLAT = HN; bf16_t* MG = HN; bf16_t* HF = HN; \
    bf16_t* CQ = (bf16_t*)(ws + WS_CQ); int* EIDX = (int*)(ws + WS_CQ); \
    float* KVRAW = (float*)(ws + WS_KVRAW); float* EW = (float*)(ws + WS_KVRAW); \
    bf16_t* KF = (bf16_t*)(ws + WS_KF); bf16_t* XP = (bf16_t*)(ws + WS_XP); bf16_t* GT = (bf16_t*)(ws + WS_GT); bf16_t* QP = GT; \
    bf16_t* QB = (bf16_t*)(ws + WS_Q); bf16_t* POOLED = QB; bf16_t* YB = QB; float* SB = (float*)(ws + WS_S);
__global__ void __launch_bounds__(NTHREADS, 2) mk_fwd(Args args) {
    extern __shared__ __attribute__((aligned(16))) unsigned char lds[];
    const int tid = threadIdx.x, lane = tid & 63, wave = __builtin_amdgcn_readfirstlane(tid >> 6);
    const int G = gridDim.x, bx = blockIdx.x, vcu = (G % 8 == 0) ? (bx % 8) * (G / 8) + bx / 8 : bx;
    const int gw = vcu * NWAVES + wave, NGW = G * NWAVES;
    LAS unsigned char* ring = (LAS unsigned char*)lds;
    LAS float* VEC = (LAS float*)(lds + VEC_OFF);
    const int lo = args.ph_lo, hi_ = args.ph_hi;
    volatile LAS unsigned* MISC = (volatile LAS unsigned*)(lds + MISC_OFF);
    if (tid < 16) MISC[tid] = 0u;
    __syncthreads();
    XcdBarrier xbar = xcd_barrier_post((unsigned*)args.ws + 1024, MISC + 8);
    unsigned long long probe_t0 = 0; float probe_val = 0.f; if (PROBE_PT) probe_t0 = __builtin_amdgcn_s_memrealtime();
#ifndef TAIL_MASK
#define TAIL_MASK 255
#endif
#define TM(k) if constexpr ((TAIL_MASK >> (k)) & 1)
#ifndef PH_MASK
#define PH_MASK 1023
#endif
#define IN(k) (((PH_MASK >> (k)) & 1) && lo <= (k) && (k) < hi_)
#define SEAM(k) do { if (IN(k) && IN((k) + 1)) { if ((k) == 0) cg::this_grid().sync(); else xcd_barrier(xbar); } } while (0)


#ifndef DBG_AT
#define DBG_AT 0
#endif
#define DBG_COPY(k, SRC, LD) if (DBG_AT == (k)) { DECL_PTRS for (size_t i = (size_t)gw * 64 + lane; i < (size_t)TL * 1024 / 8; i += (size_t)NGW * 64) { const size_t row = i >> 7, c8 = i & 127; \
        const u32x4 w = *(const u32x4*)((const bf16_t*)(SRC) + row * (LD) + c8 * 8); float* o = out + row * 1024 + c8 * 8; \
        *(f32x4*)o = (f32x4){bf_lo(w.x), bf_hi(w.x), bf_lo(w.y), bf_hi(w.y)}; *(f32x4*)(o + 4) = (f32x4){bf_lo(w.z), bf_hi(w.z), bf_lo(w.w), bf_hi(w.w)}; } }

#ifndef DBG_TAIL
#define DBG_TAIL 0
#endif
#define DBG_TCOPY(k, SRC) if (DBG_TAIL == (k)) { asm volatile("s_waitcnt vmcnt(0)" ::: "memory"); __syncthreads(); for (int i = tid; i < 256 * 128; i += NTHREADS) { const size_t row = (size_t)tok0 + (i >> 7); const int c8 = i & 127; \
        const u32x4 w = *(const u32x4*)((const bf16_t*)(SRC) + row * 1024 + c8 * 8); float* o = out + row * 1024 + c8 * 8; \
        *(f32x4*)o = (f32x4){bf_lo(w.x), bf_hi(w.x), bf_lo(w.y), bf_hi(w.y)}; *(f32x4*)(o + 4) = (f32x4){bf_lo(w.z), bf_hi(w.z), bf_lo(w.w), bf_hi(w.w)}; } continue; }
    if (IN(0)) {
        DECL_PTRS
        LAS float* scr = (LAS float*)(lds + wave * 16384);
        for (int it = gw; it < 192 * 2 * 4; it += NGW) {
            const int ks = it / 384, it2 = it - ks * 384, ct = it2 % 192, rg = it2 / 192, half = lane >> 5, col = ct * 32 + (lane & 31), r0 = rg * 17;
            float acc[17];
#pragma unroll
            for (int j = 0; j < 17; ++j) acc[j] = 0.f;
            for (int kc = ks * 4; kc < ks * 4 + 4; ++kc) {
#pragma unroll
                for (int j = 0; j < 17; ++j) { const int r = min(r0 + j, 32); const float v = (r < 32) ? cvec[(size_t)r * DM + kc * 64 + lane] : c_ctx[kc * 64 + lane];
                    scr[j * 64 + lane] = v / (1.0f + __expf(-v)); }
                asm volatile("s_waitcnt lgkmcnt(0)" ::: "memory");
#pragma unroll 16
                for (int i = 0; i < 32; ++i) { const int kk = 2 * i + half; const float w = w_ada[(size_t)(kc * 64 + kk) * 6144 + col];
#pragma unroll
                    for (int j = 0; j < 17; ++j) acc[j] += scr[j * 64 + kk] * w; }
                asm volatile("s_waitcnt lgkmcnt(0)" ::: "memory");
            }
#pragma unroll
            for (int j = 0; j < 17; ++j) { acc[j] += __shfl_xor(acc[j], 32); if (half == 0 && r0 + j < 33) MOD[((size_t)ks * 33 + r0 + j) * 6144 + col] = acc[j]; }
        }
        for (int i = gw * 64 + lane; i < 64 * 16; i += NGW * 64) { const int v = i >> 4, f = i & 15; const float inv = powf(10000.0f, -(float)f / 16.0f), ang = (float)v * inv;
            TAB[i * 2] = cosf(ang); TAB[i * 2 + 1] = sinf(ang); }
        for (int it = gw; it < 16 * 110; it += NGW) transpose_item(w_in, DM, INW, WIN, scr, it, lane, MapIn());
        for (int it = gw; it < 16 * 32; it += NGW) transpose_item(w_out, DM, DM, WOUT, scr, it, lane, MapId());
#if PEER_FOLD
        for (int it = NGW - 1 - gw; it < 16 * 16 * 8; it += NGW) {
            const int kq = it & 7, hp = it >> 7, k0 = ((it >> 3) & 15) * 64, pside = hp & 1; const float* wr = peer_wq + (size_t)(k0 + lane) * 2048 + hp * 128; f32x4 av[32];
            const float* kb = peer_keys + ((size_t)pside * 128 + kq * 16) * 128;
#pragma unroll
            for (int i = 0; i < 8; ++i) *(LAS f32x4*)(scr + (i * 64 + lane) * 4) = *(const f32x4*)(kb + (i * 64 + lane) * 4);
#pragma unroll
            for (int c = 0; c < 32; ++c) av[c] = *(const f32x4*)(wr + 4 * c);
            asm volatile("s_waitcnt lgkmcnt(0)" ::: "memory");
#pragma unroll 2
            for (int key = 0; key < 16; ++key) { const LAS float* kr = scr + key * 128; float s0 = 0.f, s1 = 0.f, s2 = 0.f, s3 = 0.f;
#pragma unroll
                for (int c = 0; c < 32; ++c) { const f32x4 kv = *(const LAS f32x4*)(kr + 4 * c); s0 += av[c][0] * kv[0]; s1 += av[c][1] * kv[1]; s2 += av[c][2] * kv[2]; s3 += av[c][3] * kv[3]; }
                WPQ[(size_t)(hp * 128 + kq * 16 + key) * DM + k0 + lane] = (bf16_t)(cvtpk((s0 + s1) + (s2 + s3), 0.f) & 0xffffu); }
            asm volatile("s_waitcnt lgkmcnt(0)" ::: "memory");
        }
#else
        for (int it = gw; it < 16 * 64; it += NGW) transpose_item(peer_wq, DM, 2048, WPQ, scr, it, lane, MapId());
#endif
        for (int i = gw * 64 + lane; i < 64 * 1024 / 8; i += NGW * 64) *(u32x4*)(WIN + (size_t)448 * 1024 + (size_t)i * 8) = (u32x4){0u, 0u, 0u, 0u};
        for (int it = gw; it < 8 * 4 * 16; it += NGW) {
            const int cb = it & 15, rb = (it >> 4) & 3, h = it >> 6, r = rb * 64 + lane; const float* a = w_uq + (size_t)r * QW + h * DQK; f32x4 av[32];
#pragma unroll
            for (int i = 0; i < 4; ++i) { const int idx = i * 64 + lane, j = idx >> 5, c4 = idx & 31; *(LAS f32x4*)(scr + j * 128 + c4 * 4) = *(const f32x4*)(w_ukv + (size_t)(cb * 8 + j) * 2048 + h * 256 + c4 * 4); }
#pragma unroll
            for (int c = 0; c < 32; ++c) av[c] = *(const f32x4*)(a + 4 * c);
            const float gq = g_q_lora[r];
            asm volatile("s_waitcnt lgkmcnt(0)" ::: "memory");
#pragma unroll 2
            for (int j = 0; j < 8; ++j) { const LAS float* br = scr + j * 128; float s0 = 0.f, s1 = 0.f, s2 = 0.f, s3 = 0.f;
#pragma unroll
                for (int c = 0; c < 32; ++c) { const f32x4 bv = *(const LAS f32x4*)(br + 4 * c); s0 += av[c][0] * bv[0]; s1 += av[c][1] * bv[1]; s2 += av[c][2] * bv[2]; s3 += av[c][3] * bv[3]; }
                WQ[(size_t)(h * DQK + cb * 8 + j) * 256 + r] = (bf16_t)(cvtpk(((s0 + s1) + (s2 + s3)) * gq, 0.f) & 0xffffu); }
            asm volatile("s_waitcnt lgkmcnt(0)" ::: "memory");
        }
        for (int i = gw * 64 + lane; i < NH * 64 * 256; i += NGW * 64) { const int r = i & 255, cc = (i >> 8) & 63, h = i >> 14;
            WQ[(size_t)(h * DQK + 128 + cc) * 256 + r] = (bf16_t)(cvtpk(w_uq[(size_t)r * QW + h * DQK + 128 + rope_src(cc)] * g_q_lora[r], 0.f) & 0xffffu); }
        for (int i = gw * 64 + lane; i < 1024 * 256; i += NGW * 64) { const int n = i >> 8, k = i & 255, h = n >> 7, d = n & 127, hh = k >> 7, c = k & 127;
            const float v = (hh == (h & 1)) ? w_ukv[(size_t)c * 2048 + h * 256 + 128 + d] : 0.f; WUV[i] = (bf16_t)(cvtpk(v, 0.f) & 0xffffu); }
        for (int i = gw * 64 + lane; i < 1024 * 256; i += NGW * 64) { const int n = i >> 8, k = i & 255, g = n >> 8, d = n & 255;
            WPOOL[i] = (bf16_t)(cvtpk(w_pool[((size_t)g * 256 + k) * 256 + d], 0.f) & 0xffffu); }
        for (int i = gw * 64 + lane; i < 256 * 256; i += NGW * 64) { const int n = i >> 8, k = i & 255, p = n >> 7, key = n & 127, pp = k >> 7, c = k & 127;
            const float v = (p == pp) ? peer_keys[((size_t)p * 128 + key) * 128 + c] : 0.f; KEYS[i] = (bf16_t)(cvtpk(v, 0.f) & 0xffffu); }
#if PEER_FP8
#pragma unroll 4
        for (size_t i = (size_t)gw * 64 + lane; i < (size_t)2 * 16384 * 1024 / 16; i += (size_t)NGW * 64) {
            const bool isu = i < (size_t)16384 * 1024 / 16; const size_t j = isu ? i : i - (size_t)16384 * 1024 / 16;
            const float* s = (isu ? peer_u : peer_v) + j * 16; u32x4 w;
#if PEER_I8
            if (isu) {
                f32x4 a4[4]; float am = 0.f;
#pragma unroll
                for (int q = 0; q < 4; ++q) { a4[q] = *(const f32x4*)(s + 4 * q); am = fmaxf(fmaxf(am, fmaxf(fabsf(a4[q][0]), fabsf(a4[q][1]))), fmaxf(fabsf(a4[q][2]), fabsf(a4[q][3]))); }
                am = wave_max(am); const float inv = am > 0.f ? 127.0f / am : 0.f;
#pragma unroll
                for (int q = 0; q < 4; ++q) w[q] = pack_i8(a4[q][0] * inv, a4[q][1] * inv, a4[q][2] * inv, a4[q][3] * inv);
                if (lane == 0) ((float*)(ws + WS_USCALE))[j >> 6] = am * (1.0f / 127.0f);
            } else
#endif
#pragma unroll
            for (int q = 0; q < 4; ++q) { const f32x4 a = *(const f32x4*)(s + 4 * q) * 64.0f; int t = __builtin_amdgcn_cvt_pk_fp8_f32(a[0], a[1], 0, false); t = __builtin_amdgcn_cvt_pk_fp8_f32(a[2], a[3], t, true); w[q] = (unsigned)t; }
#if PEER_XCD
            { const size_t e_ = j >> 6, c_ = (j & 63) * 16;
              *(u32x4*)((unsigned char*)(isu ? PU : PV) + (c_ >> 7) * ((size_t)16384 * 128) + e_ * 128 + (c_ & 127)) = w; }
#else
            *(u32x4*)((unsigned char*)(isu ? PU : PV) + j * 16) = w;
#endif
        }
#else
        for (size_t i = (size_t)gw * 64 + lane; i < (size_t)2 * 16384 * 1024 / 8; i += (size_t)NGW * 64) {
            const bool isu = i < (size_t)16384 * 1024 / 8; const size_t j = isu ? i : i - (size_t)16384 * 1024 / 8;
            const float* s = (isu ? peer_u : peer_v) + j * 8; const f32x4 a = *(const f32x4*)s, b = *(const f32x4*)(s + 4);
            *(u32x4*)((isu ? PU : PV) + j * 8) = pack8(a, b); }
#endif
    }
    if (PROBE_PT == 20 && threadIdx.x == 0) ((unsigned*)args.ws + 9000)[bx] = xb_xcc_id() + 1u;
    SEAM(0); PROBE(1);
    if (PROBE_PT == 20 && blockIdx.x == 0 && threadIdx.x == 0) { int bad = 0; for (int b_ = 0; b_ < G; ++b_) { const unsigned a_ = __hip_atomic_load((unsigned*)args.ws + 9000 + b_, __ATOMIC_RELAXED, __HIP_MEMORY_SCOPE_AGENT), c_ = __hip_atomic_load((unsigned*)args.ws + 9000 + (b_ & 7), __ATOMIC_RELAXED, __HIP_MEMORY_SCOPE_AGENT); bad += (a_ != c_); } probe_val = 10.f + (float)bad; }

    if (IN(1)) {
        DECL_PTRS
        for (int blk = vcu; blk < 256; blk += G) {
            const int b = blk >> 3;
            __syncthreads();
            for (int k = tid; k < DM; k += NTHREADS) { const float g = g_mix_pre[k];
                VEC[k] = g * (1.0f + modv(MOD, b_ada, b, 1024 + k)); VEC[1024 + k] = modv(MOD, b_ada, b, k);
                VEC[2048 + k] = g * (1.0f + modv(MOD, b_ada, 32, 1024 + k)); VEC[3072 + k] = modv(MOD, b_ada, 32, k); }
            __syncthreads();
#define P1_ROWPTR(rr_) (((rr_) >= 256) ? ctx + (size_t)(blk * 32 + (rr_) - 256) * DM : x + (size_t)(blk * 256 + (rr_)) * DM)
            f32x4 nv[4];
#pragma unroll
            for (int j = 0; j < 4; ++j) nv[j] = *(const f32x4*)(P1_ROWPTR(wave) + 4 * lane + 256 * j);
            for (int rr = wave; rr < 288; rr += NWAVES) {
                const bool isc = rr >= 256; const int row = isc ? TL + blk * 32 + (rr - 256) : blk * 256 + rr;
                const LAS float* Gv = VEC + (isc ? 2048 : 0); const LAS float* Sv = Gv + 1024;
                f32x4 v[4]; float s = 0.f;
#pragma unroll
                for (int j = 0; j < 4; ++j) { v[j] = nv[j]; s += (v[j][0] * v[j][0] + v[j][1] * v[j][1]) + (v[j][2] * v[j][2] + v[j][3] * v[j][3]); }
                if (rr + NWAVES < 288) {
#pragma unroll
                    for (int j = 0; j < 4; ++j) nv[j] = *(const f32x4*)(P1_ROWPTR(rr + NWAVES) + 4 * lane + 256 * j); }
                const float rs = rsqrtf(wave_sum(s) * (1.0f / DM) + EPS);
#pragma unroll
                for (int j = 0; j < 4; ++j) { const f32x4 gg = *(const LAS f32x4*)(Gv + 4 * lane + 256 * j), sh = *(const LAS f32x4*)(Sv + 4 * lane + 256 * j);
                    const f32x4 o = v[j] * rs * gg + sh; u32x2 w; w.x = cvtpk(o[0], o[1]); w.y = cvtpk(o[2], o[3]);
                    *(u32x2*)(HN + (size_t)row * DM + 4 * lane + 256 * j) = w; }
            }
#undef P1_ROWPTR
        }
    }
    SEAM(1); PROBE(2);

    if (IN(2)) {
        DECL_PTRS
        pg8::Gemm g{HN, WIN, DM, DM, DM}; SchedIn S{G, bx}; EpiIn E{CQ, SSQCQ, KVRAW, XP, GT};
        pg8::gemm_phase<EpiIn, SchedIn, true>(ring, g, S, E);
    }
    SEAM(2); PROBE(3);

    if (IN(3) && DBG_AT == 3) { DBG_COPY(3, GT, 2048) }
    if (IN(3) && !(DBG_AT && DBG_AT <= 3)) {
        DECL_PTRS
        for (int row0 = gw * 4; row0 < TALL; row0 += NGW * 4) {
            f32x4 vv[4];
#pragma unroll
            for (int i = 0; i < 4; ++i) { vv[i] = (f32x4){0.f, 0.f, 0.f, 0.f}; if (lane < 48) vv[i] = *(const f32x4*)(KVRAW + (size_t)(row0 + i) * 192 + 4 * lane); }
#pragma unroll
            for (int i = 0; i < 4; ++i) { const int row = row0 + i; const f32x4 v = vv[i];
                const bool isc = row >= TL; int b, key, t = 0;
                if (isc) { const int j = row - TL; b = j >> 8; key = j & 255; } else { b = row >> 11; t = row & 2047; key = 256 + t; }
                float s = (lane < 32) ? (v[0] * v[0] + v[1] * v[1]) + (v[2] * v[2] + v[3] * v[3]) : 0.f;
                const float rs = rsqrtf(wave_sum(s) * (1.0f / 128.0f) + EPS);
                f32x4 o;
                if (lane < 32) { const f32x4 gk = *(const f32x4*)(g_kv_lora + 4 * lane); o = v * rs * gk; }
                else if (!isc && lane < 48) { const int p0 = 2 * (lane - 32), vq = (p0 >> 4) ? (t & 63) : (t >> 6); const f32x4 tc = *(const f32x4*)(TAB + (vq * 16 + (p0 & 15)) * 2);
                    o[0] = v[0] * tc[0] - v[1] * tc[1]; o[1] = v[0] * tc[1] + v[1] * tc[0]; o[2] = v[2] * tc[2] - v[3] * tc[3]; o[3] = v[2] * tc[3] + v[3] * tc[2]; }
                else o = v;
                if (lane < 48) { u32x2 w; w.x = cvtpk(o[0], o[1]); w.y = cvtpk(o[2], o[3]); *(u32x2*)(KF + ((size_t)b * NKEY + key) * DQK + 4 * lane) = w; } }
        }
        pg8::Gemm g{CQ, WQ, 256, 256, 256}; SchedQ S{G, bx}; EpiQ E{QB, SSQCQ, TAB};
        pg8::gemm_phase<EpiQ, SchedQ, true>(ring, g, S, E);
    }
    SEAM(3); PROBE(4);

    if (IN(4) && !(DBG_AT && DBG_AT <= 4)) {
        DECL_PTRS
        const int ipb = (2048 + G - 1) / G;
        for (int i = 0; i < ipb; ++i) { const int uid = vcu * ipb + i; if (uid >= 2048) break;
            const int b = uid >> 6, rem = uid & 63, h = rem >> 3, qb = rem & 7;
            att::attn_unit(QB, KF + (size_t)b * NKEY * DQK, OLAT, b * SEQ + qb * 256, h, (char*)lds); }
    }
    SEAM(4); PROBE(5);


    if (PROBE_PT == 10 && IN(5) && blockIdx.x == 0 && wave == 0) {
        DECL_PTRS
        float worst = 0.f;
        for (int tc = 0; tc < 2; ++tc) {
            const int q = tc ? 150 : 37, h = tc ? 6 : 3;
            const bf16_t* qp = QB + (size_t)q * QW + h * DQK;
            float sc[36]; float mx = -1e30f;
            for (int kk = 0; kk < 36; ++kk) { const bf16_t* kp = KF + (size_t)(kk * 64 + lane) * DQK; float a = 0.f;
                for (int d = 0; d < DQK; ++d) a += __uint_as_float((unsigned)qp[d] << 16) * __uint_as_float((unsigned)kp[d] << 16);
                sc[kk] = a; mx = fmaxf(mx, a); }
            for (int o = 1; o < 64; o <<= 1) mx = fmaxf(mx, __shfl_xor(mx, o));
            float l = 0.f;
            for (int kk = 0; kk < 36; ++kk) { sc[kk] = exp2f(sc[kk] - mx); l += sc[kk]; }
            l = wave_sum(l);
            float omax = 0.f, dmax = 0.f;
            for (int c = 0; c < 128; ++c) { float a = 0.f;
                for (int kk = 0; kk < 36; ++kk) a += sc[kk] * __uint_as_float((unsigned)KF[(size_t)(kk * 64 + lane) * DQK + c] << 16);
                a = wave_sum(a) / l; const float got = __uint_as_float((unsigned)OLAT[(size_t)q * 1024 + h * 128 + c] << 16);
                omax = fmaxf(omax, fabsf(a)); dmax = fmaxf(dmax, fabsf(a - got)); }
            worst = fmaxf(worst, dmax / omax);
        }
        if (lane == 0) probe_val = 1000.f * worst;
    }
    if (PROBE_PT == 10 && IN(5) && blockIdx.x == 0) __syncthreads();
    if (IN(5) && DBG_AT == 5) { DBG_COPY(5, OLAT, 1024) }
    if (IN(5) && !(DBG_AT && DBG_AT <= 5)) {
        DECL_PTRS
        for (int pm = vcu; pm < 256; pm += G) {
            const int b = pm >> 3, tok0 = pm * 256;
            __syncthreads();
            TM(0) {
                int td = tid; asm volatile("" : "+v"(td));
                const int ln = td & 63, s0 = (pm & 7) * 256; LAS unsigned char* slab = (LAS unsigned char*)lds;
                const unsigned char* xg = (const unsigned char*)(XP + (size_t)b * SEQ * DM); unsigned* pb = (unsigned*)POOLED + (size_t)b * SEQ * 512 + 2 * ln;
#pragma unroll 1
                for (int g = 0; g < 4; ++g) { const int hw = 1 << g;
                    __syncthreads();
#pragma unroll
                    for (int i = td; i < 272 * 32; i += NTHREADS) { const int r = i >> 5, c16 = i & 31; const int jc = min(max(s0 - 8 + r, 0), SEQ - 1);
                        *(LAS u32x4*)(slab + r * 512 + c16 * 16) = *(const u32x4*)(xg + (size_t)jc * 2048 + g * 512 + c16 * 16); }
                    __syncthreads();
#pragma unroll 4
                    for (int it = 0; it < 32; ++it) { const int sl = it * 8 + wave, sq = s0 + sl; f32x4 sum = (f32x4){0.f, 0.f, 0.f, 0.f}, cen = sum;
                        for (int t = 0; t < 2 * hw; ++t) { const int jj = sq - hw + t; const float f = ((unsigned)jj < (unsigned)SEQ) ? 1.0f : 0.0f;
                            const u32x2 w = *(const LAS u32x2*)(slab + (sl + 8 - hw + t) * 512 + ln * 8); const f32x4 v = (f32x4){bf_lo(w.x), bf_hi(w.x), bf_lo(w.y), bf_hi(w.y)};
                            sum += v * f; if (t == hw) cen = v; }
                        const float rc = 1.0f / (float)(min(sq + hw, SEQ) - max(sq - hw, 0)); const f32x4 o = sum * rc - cen;
                        u32x2 ow; ow.x = cvtpk(o[0], o[1]); ow.y = cvtpk(o[2], o[3]); *(u32x2*)(pb + (size_t)sq * 512 + g * 128) = ow; } }
                __syncthreads();
            }
            for (int k = tid; k < DM; k += NTHREADS) {
                VEC[k] = modv(MOD, b_ada, b, 2048 + k) * g_mix_post[k];
                VEC[1024 + k] = g_ffn_pre[k] * (1.0f + modv(MOD, b_ada, b, 4096 + k));
                VEC[2048 + k] = modv(MOD, b_ada, b, 3072 + k);
                VEC[3072 + k] = modv(MOD, b_ada, b, 5120 + k) * g_ffn_post[k];
                VEC[4096 + k] = pool_scale[k]; }
            asm volatile("s_waitcnt vmcnt(0)" ::: "memory"); __syncthreads();
            DBG_TCOPY(1, POOLED)
            PROBE(14);
            TM(1) { pg8::Gemm g{OLAT, WUV, DM, 256, 256}; SchedRow S{pm, 0, 4, (long)tok0 * DM * 2, 512, 0, 256 * 256 * 2}; EpiU E{MG, GT}; pg8::gemm_phase<EpiU, SchedRow, true>(ring, g, S, E); }
            PROBE(15);
            DBG_TCOPY(4, MG)
            TM(2) { pg8::Gemm g{POOLED, WPOOL, DM, 256, 256}; SchedRow S{pm, 0, 4, (long)tok0 * DM * 2, 512, 0, 256 * 256 * 2}; EpiP E{MG, GT, VEC + 4096}; pg8::gemm_phase<EpiP, SchedRow, true>(ring, g, S, E); }
            PROBE(16);
            DBG_TCOPY(2, MG)
            TM(3) { pg8::Gemm g{MG, WOUT, DM, DM, DM}; SchedRow S{pm, 0, 4, (long)tok0 * DM * 2, 0, 0, 256 * DM * 2}; EpiO E{YB, SSQY}; pg8::gemm_phase<EpiO, SchedRow, true>(ring, g, S, E); }
            DBG_TCOPY(3, YB)
            PROBE(6);
            TM(4) {
                int ln = lane; asm volatile("" : "+v"(ln));
                const int c0 = 8 * ln, c1 = 512 + 8 * ln;
                f32x4 nq[4], nx[4]; u32x4 ny0, ny1;
#define E_LOAD(rr_) do { const size_t r_ = (size_t)tok0 + (rr_); _Pragma("unroll") for (int q = 0; q < 4; ++q) { nq[q] = *(const f32x4*)(SSQY + r_ * 16 + 4 * q); nx[q] = *(const f32x4*)(x + r_ * DM + ((q < 2 ? c0 : c1) + (q & 1) * 4)); } \
        ny0 = *(const u32x4*)(YB + r_ * DM + c0); ny1 = *(const u32x4*)(YB + r_ * DM + c1); } while (0)
                E_LOAD(wave * 32);
                for (int rr = wave * 32; rr < wave * 32 + 32; ++rr) {
                    const size_t row = (size_t)tok0 + rr;
                    const f32x4 qs = (nq[0] + nq[1]) + (nq[2] + nq[3]); const float ry = rsqrtf(((qs[0] + qs[1]) + (qs[2] + qs[3])) * (1.0f / DM) + EPS);
                    const u32x4 y0 = ny0, y1 = ny1; f32x4 xv[4];
#pragma unroll
                    for (int q = 0; q < 4; ++q) xv[q] = nx[q];
                    if (rr + 1 < wave * 32 + 32) E_LOAD(rr + 1);
                    float xm[16]; float yv[16] = {bf_lo(y0.x), bf_hi(y0.x), bf_lo(y0.y), bf_hi(y0.y), bf_lo(y0.z), bf_hi(y0.z), bf_lo(y0.w), bf_hi(y0.w), bf_lo(y1.x), bf_hi(y1.x), bf_lo(y1.y), bf_hi(y1.y), bf_lo(y1.z), bf_hi(y1.z), bf_lo(y1.w), bf_hi(y1.w)};
                    float s_ = 0.f;
#pragma unroll
                    for (int q = 0; q < 4; ++q) { const int cc = (q < 2 ? c0 : c1) + (q & 1) * 4; const f32x4 a1 = *(const LAS f32x4*)(VEC + cc);
#pragma unroll
                        for (int e = 0; e < 4; ++e) { const float m_ = xv[q][e] + a1[e] * (yv[q * 4 + e] * ry); xm[q * 4 + e] = m_; s_ += m_ * m_; } }
                    { u32x4 m0, m1; m0.x = cvtpk(xm[0], xm[1]); m0.y = cvtpk(xm[2], xm[3]); m0.z = cvtpk(xm[4], xm[5]); m0.w = cvtpk(xm[6], xm[7]);
                      m1.x = cvtpk(xm[8], xm[9]); m1.y = cvtpk(xm[10], xm[11]); m1.z = cvtpk(xm[12], xm[13]); m1.w = cvtpk(xm[14], xm[15]);
                      bf16_t* xmr = (bf16_t*)(ws + xm_off(row)); *(u32x4*)(xmr + c0) = m0; *(u32x4*)(xmr + c1) = m1; }
                    const float rm = rsqrtf(wave_sum(s_) * (1.0f / DM) + EPS);
                    u32x4 h0, h1; float hv[16];
#pragma unroll
                    for (int q = 0; q < 4; ++q) { const int cc = (q < 2 ? c0 : c1) + (q & 1) * 4; const f32x4 a2 = *(const LAS f32x4*)(VEC + 1024 + cc), a3 = *(const LAS f32x4*)(VEC + 2048 + cc);
#pragma unroll
                        for (int e = 0; e < 4; ++e) hv[q * 4 + e] = xm[q * 4 + e] * rm * a2[e] + a3[e]; }
                    h0.x = cvtpk(hv[0], hv[1]); h0.y = cvtpk(hv[2], hv[3]); h0.z = cvtpk(hv[4], hv[5]); h0.w = cvtpk(hv[6], hv[7]);
                    h1.x = cvtpk(hv[8], hv[9]); h1.y = cvtpk(hv[10], hv[11]); h1.z = cvtpk(hv[12], hv[13]); h1.w = cvtpk(hv[14], hv[15]);
                    *(u32x4*)(HF + row * DM + c0) = h0; *(u32x4*)(HF + row * DM + c1) = h1;
#if PEER_I8
                    {
                        float am = 0.f;
#pragma unroll
                        for (int e = 0; e < 16; ++e) am = fmaxf(am, fabsf(hv[e]));
                        am = wave_max(am); const float inv = am > 0.f ? 127.0f / am : 0.f;
                        u32x2 q0, q1; q0.x = pack_i8(hv[0] * inv, hv[1] * inv, hv[2] * inv, hv[3] * inv); q0.y = pack_i8(hv[4] * inv, hv[5] * inv, hv[6] * inv, hv[7] * inv);
                        q1.x = pack_i8(hv[8] * inv, hv[9] * inv, hv[10] * inv, hv[11] * inv); q1.y = pack_i8(hv[12] * inv, hv[13] * inv, hv[14] * inv, hv[15] * inv);
                        unsigned char* h8 = ws + WS_HF8 + row * DM; *(u32x2*)(h8 + c0) = q0; *(u32x2*)(h8 + c1) = q1;
                        if (ln == 0) ((float*)(ws + WS_XSCALE))[row] = am * (1.0f / 127.0f);
                    }
#endif
                }
#undef E_LOAD
            }
            asm volatile("s_waitcnt vmcnt(0)" ::: "memory"); __syncthreads();
#if PEER_FOLD
            PROBE(7);
            float* Sblk = (float*)(ws + WS_GT) + (size_t)pm * 262144; const int srot = (pm * 8) & 255;
            TM(6) for (int hq = 0; hq < (S_I16 ? 1 : 2); ++hq) {
                { pg8::Gemm g{HF, WPQ, DM, DM, DM}; SchedRow S{pm, 4 * hq, S_I16 ? 8 : 4, (long)tok0 * DM * 2, 0, 0, 256 * DM * 2}; EpiS4 E{Sblk, srot}; pg8::gemm_phase<EpiS4, SchedRow, true>(ring, g, S, E); }
                if (hq == 0) PROBE(17);
              {
#if S_I16
#define S_ROWP(rl, hh_) ((const short*)Sblk + (size_t)(((rl) + srot) & 255) * 2048 + (hh_) * 256)
#else
#define S_ROWP(rl, hh_) (Sblk + (size_t)(((rl) + srot) & 255) * 1024 + (hh_) * 256)
#endif
#else
            TM(5) { pg8::Gemm g{HF, WPQ, DM, DM, DM}; SchedRow S{pm, 0, 8, (long)tok0 * DM * 2, 0, 0, 256 * DM * 2}; EpiStore E{QP, 2048}; pg8::gemm_phase<EpiStore, SchedRow, true>(ring, g, S, E); }
            PROBE(7);
            float* Sblk = SB + (size_t)pm * (65536 + 1088);
            TM(6) for (int h = 0; h < NH; ++h) {
                { pg8::Gemm g{QP, KEYS, 2048, 256, 256}; SchedRow S{pm, h, 1, (long)tok0 * 2048 * 2, 512, 0, 0}; EpiS E{Sblk}; pg8::gemm_phase<EpiS, SchedRow, true>(ring, g, S, E); }
              {
#define S_ROWP(rl) (Sblk + (size_t)(rl) * 256)
#endif
                int ln = lane; asm volatile("" : "+v"(ln));
                const int i16 = ln & 15, g4 = ln >> 4;
                int cA[4], cB[4];
#pragma unroll
                for (int e = 0; e < 4; ++e) { const int c = 16 * e + i16; const int a = (c >= 16) + (c >= 24) + (c >= 29) + (c >= 33) + (c >= 36) + (c >= 38) + (c >= 40) + (c >= 42);
                    const int offs = (a == 0) ? 0 : (a == 1) ? 16 : (a == 2) ? 24 : (a == 3) ? 29 : (a == 4) ? 33 : (a == 5) ? 36 : (a == 6) ? 38 : (a == 7) ? 40 : 42;
                    if (c >= 42) { cA[e] = min(8 + (c - 42), 15); cB[e] = 0; } else { cA[e] = a; cB[e] = c - offs; } }
#if PEER_FOLD
#if S_I16
#define S_LD1(A_, B_, sp_) do { const short* p_ = (sp_); const u32x2 wa_ = *(const u32x2*)p_, wb_ = *(const u32x2*)(p_ + 64); A_ = (f32x4){__uint_as_float(wa_.x), __uint_as_float(wa_.y), 0.f, 0.f}; B_ = (f32x4){__uint_as_float(wb_.x), __uint_as_float(wb_.y), 0.f, 0.f}; } while (0)
#else
#define S_LD1(A_, B_, sp_) do { const float* p_ = (sp_); A_ = *(const f32x4*)p_; B_ = *(const f32x4*)(p_ + 64); } while (0)
#endif
#define S_LOAD(it_, A, B) do { const int hh_ = (it_) >> 2, r_ = wave * 32 + ((it_) & 3) * 8; _Pragma("unroll") for (int c_ = 0; c_ < 4; ++c_) { \
        S_LD1(A[c_], B[c_], S_ROWP(r_ + 2 * c_ + (g4 >> 1), hh_) + (g4 & 1) * 128 + 4 * i16); } } while (0)
                f32x4 na[4], nb[4]; S_LOAD(0, na, nb);
                for (int itk = 0; itk < (S_I16 ? 32 : 16); ++itk) { const int h = 4 * hq + (itk >> 2), r8 = wave * 32 + (itk & 3) * 8;
                    f32x4 ca[4], cbv[4];
#pragma unroll
                    for (int c_ = 0; c_ < 4; ++c_) { ca[c_] = na[c_]; cbv[c_] = nb[c_]; }
                    if (itk + 1 < (S_I16 ? 32 : 16)) S_LOAD(itk + 1, na, nb);
                    unsigned mq[4]; top16_of_128<4, S_I16 != 0>(ca, cbv, i16, mq);
#pragma unroll 1
                  for (int half = 0; half < 2; ++half) { const int r4 = r8 + 4 * half; const unsigned mA = half ? mq[2] : mq[0], mB = half ? mq[3] : mq[1];
#else
                for (int r4 = wave * 32; r4 < wave * 32 + 32; r4 += 4) {
                    if (SKIP_TOPK) { const size_t oi_ = ((size_t)tok0 + r4 + g4) * 128 + h * 16 + i16; EIDX[oi_] = (h * 16 + i16) * 97; EW[oi_] = 0.0625f; continue; }
                    const float* sp0 = S_ROWP(r4 + (g4 >> 1)) + (g4 & 1) * 128 + 4 * i16; const float* sp1 = S_ROWP(r4 + 2 + (g4 >> 1)) + (g4 & 1) * 128 + 4 * i16;
                    const f32x4 a0 = *(const f32x4*)sp0, b0 = *(const f32x4*)(sp0 + 64), a1 = *(const f32x4*)sp1, b1 = *(const f32x4*)(sp1 + 64);
#endif
#if !PEER_FOLD
                    unsigned mq2[2]; { const f32x4 sa_[2] = {a0, a1}, sb_[2] = {b0, b1}; top16_of_128<2>(sa_, sb_, i16, mq2); } const unsigned mA = mq2[0], mB = mq2[1];
#endif
                    const int src0 = ((2 * (g4 & 1)) * 16 + i16) * 4, src1 = src0 + 64;
                    const unsigned A0 = (unsigned)__builtin_amdgcn_ds_bpermute(src0, (int)mA), A1 = (unsigned)__builtin_amdgcn_ds_bpermute(src1, (int)mA);
                    const unsigned B0 = (unsigned)__builtin_amdgcn_ds_bpermute(src0, (int)mB), B1 = (unsigned)__builtin_amdgcn_ds_bpermute(src1, (int)mB);
                    const unsigned M0 = (g4 < 2) ? A0 : B0, M1 = (g4 < 2) ? A1 : B1;
#if S_I16 && PEER_FOLD
                    const float v0 = (float)((int)(M0 >> 16) - 32768) * (16.0f / 32767.0f), v1 = (float)((int)(M1 >> 16) - 32768) * (16.0f / 32767.0f);
#else
                    const float v0 = key2f(M0 & ~0x7Fu), v1 = key2f(M1 & ~0x7Fu);
#endif
                    const int kid0 = 127 - (int)(M0 & 0x7Fu), kid1 = 127 - (int)(M1 & 0x7Fu);
                    unsigned ck[4];
#pragma unroll
                    for (int e = 0; e < 4; ++e) { const float s0 = __uint_as_float((unsigned)__builtin_amdgcn_ds_bpermute((g4 * 16 + cA[e]) * 4, (int)__float_as_uint(v0)));
                        const float s1 = __uint_as_float((unsigned)__builtin_amdgcn_ds_bpermute((g4 * 16 + cB[e]) * 4, (int)__float_as_uint(v1)));
                        const int c = 16 * e + i16; ck[e] = (c < 50) ? ((f2key(s0 + s1) & ~0x3Fu) | (unsigned)(63 - c)) : 0u; }
                    CE_DESC(ck[0], ck[1]); CE_DESC(ck[2], ck[3]); CE_DESC(ck[0], ck[2]); CE_DESC(ck[1], ck[3]); CE_DESC(ck[1], ck[2]);
                    unsigned best = 0u;
#pragma unroll
                    for (int it = 0; it < 16; ++it) { unsigned m = ck[0]; ROW_MAXU(m); const bool tk = (ck[0] == m);
                        ck[0] = tk ? ck[1] : ck[0]; ck[1] = tk ? ck[2] : ck[1]; ck[2] = tk ? ck[3] : ck[2]; ck[3] = tk ? 0u : ck[3];
                        best = (i16 == it) ? m : best; }
                    const float bv = key2f(best & ~0x3Fu); const int c = 63 - (int)(best & 0x3Fu);
                    const int a = (c >= 16) + (c >= 24) + (c >= 29) + (c >= 33) + (c >= 36) + (c >= 38) + (c >= 40) + (c >= 42);
                    const int offs = (a == 0) ? 0 : (a == 1) ? 16 : (a == 2) ? 24 : (a == 3) ? 29 : (a == 4) ? 33 : (a == 5) ? 36 : (a == 6) ? 38 : (a == 7) ? 40 : 42;
                    const int ba = (c >= 42) ? 8 + (c - 42) : a, bb = (c >= 42) ? 0 : c - offs;
                    const int e0 = __builtin_amdgcn_ds_bpermute((g4 * 16 + ba) * 4, kid0), e1 = __builtin_amdgcn_ds_bpermute((g4 * 16 + bb) * 4, kid1);
                    const float top = __uint_as_float((unsigned)__builtin_amdgcn_ds_bpermute((g4 * 16) * 4, (int)__float_as_uint(bv)));
                    const float ex = __builtin_amdgcn_exp2f((bv - top) * 1.4426950408889634f);
                    float sum = ex; sum += dpp_f<0x128>(sum); sum += dpp_f<0x124>(sum); sum += dpp_f<0x122>(sum); sum += dpp_f<0x121>(sum);
                    const size_t oi = ((size_t)tok0 + r4 + g4) * 128 + h * 16 + i16;
                    EIDX[oi] = e0 * 128 + e1; EW[oi] = ex / sum;
#if PEER_FOLD
                  }
#endif
                }
              }
#undef S_ROWP
#undef S_LOAD
#undef S_LD1
                asm volatile("s_waitcnt vmcnt(0)" ::: "memory"); __syncthreads();
#if PEER_FOLD
                if (hq == 0) PROBE(18);
#endif
            }
            PROBE(8);
#if PEER_XCD
#elif PEER_FP8
            TM(7) for (int rr = wave * 32; rr < wave * 32 + 32; ++rr) {
                int ln = lane; asm volatile("" : "+v"(ln));
                LAS unsigned char* slots = ring + wave * 16384;
                const size_t row = (size_t)tok0 + rr; const int c0 = 16 * ln;
                const int idA = EIDX[row * 128 + ln], idB = EIDX[row * 128 + 64 + ln]; const float wA = EW[row * 128 + ln], wB = EW[row * 128 + 64 + ln];
                float xs[16];
                { const u32x4 xa = *(const u32x4*)(HF + row * DM + c0), xb = *(const u32x4*)(HF + row * DM + c0 + 8);
                  xs[0] = bf_lo(xa.x); xs[1] = bf_hi(xa.x); xs[2] = bf_lo(xa.y); xs[3] = bf_hi(xa.y); xs[4] = bf_lo(xa.z); xs[5] = bf_hi(xa.z); xs[6] = bf_lo(xa.w); xs[7] = bf_hi(xa.w);
                  xs[8] = bf_lo(xb.x); xs[9] = bf_hi(xb.x); xs[10] = bf_lo(xb.y); xs[11] = bf_hi(xb.y); xs[12] = bf_lo(xb.z); xs[13] = bf_hi(xb.z); xs[14] = bf_lo(xb.w); xs[15] = bf_hi(xb.w); }
                const unsigned char* PU8 = (const unsigned char*)PU; const unsigned char* PV8 = (const unsigned char*)PV;
                asm volatile("s_waitcnt vmcnt(0) lgkmcnt(0)" ::: "memory");
#define G_ISSUE(rix, slot) do { const int e_ = (rix) & 127; const int id_ = __builtin_amdgcn_readlane((e_ < 64) ? idA : idB, e_ & 63); \
        const unsigned char* src_ = (((rix) < 128) ? PU8 : PV8) + (size_t)id_ * DM + c0; \
        __builtin_amdgcn_global_load_lds((const unsigned*)src_, (LAS unsigned*)(slots + (slot) * 1024), 16, 0, 0); } while (0)
#define G_WAITV(n) asm volatile("s_waitcnt vmcnt(" #n ")" ::: "memory")
#define G_TAKE(dst, slot) do { dst = *(const LAS u32x4*)(slots + (slot) * 1024 + ln * 16); asm volatile("s_waitcnt lgkmcnt(0)" ::: "memory"); } while (0)
#pragma unroll
                for (int j = 0; j < 16; ++j) G_ISSUE(j, j);
                float dA = 0.f, dB = 0.f, r_[8];
                for (int it = 0; it < 8; ++it) {
#pragma unroll
                    for (int j = 0; j < 16; ++j) {
                        u32x4 u; G_WAITV(15); G_TAKE(u, j); G_ISSUE(16 * it + j + 16, j);
                        float d0 = 0.f, d1 = 0.f;
#pragma unroll
                        for (int k = 0; k < 4; ++k) { const f32x2 lo = __builtin_amdgcn_cvt_pk_f32_fp8((int)u[k], false), hi = __builtin_amdgcn_cvt_pk_f32_fp8((int)u[k], true);
                            d0 += lo[0] * xs[4 * k]; d1 += lo[1] * xs[4 * k + 1]; d0 += hi[0] * xs[4 * k + 2]; d1 += hi[1] * xs[4 * k + 3]; }
                        r_[j & 7] = d0 + d1;
                        if ((j & 7) == 7) { float r4[4], r2[2], r1;
#pragma unroll
                            for (int i = 0; i < 4; ++i) { const bool b_ = ln & 1; const float keep = b_ ? r_[2 * i + 1] : r_[2 * i], send = b_ ? r_[2 * i] : r_[2 * i + 1]; r4[i] = keep + __shfl_xor(send, 1); }
#pragma unroll
                            for (int i = 0; i < 2; ++i) { const bool b_ = ln & 2; const float keep = b_ ? r4[2 * i + 1] : r4[2 * i], send = b_ ? r4[2 * i] : r4[2 * i + 1]; r2[i] = keep + __shfl_xor(send, 2); }
                            { const bool b_ = ln & 4; const float keep = b_ ? r2[1] : r2[0], send = b_ ? r2[0] : r2[1]; r1 = keep + __shfl_xor(send, 4); }
                            r1 += __shfl_xor(r1, 8); r1 += __shfl_xor(r1, 16); r1 += __shfl_xor(r1, 32);
                            const int q = 2 * it + (j >> 3);
                            if ((ln >> 3) == (q & 7)) { if (q < 8) dA = r1; else dB = r1; } }
                    }
                }
                dA *= (1.0f / 64.0f); dB *= (1.0f / 64.0f);
                const float aA = 0.5f * dA * (1.0f + erff(dA * 0.70710678118654752f)) * wA * (1.0f / 64.0f), aB = 0.5f * dB * (1.0f + erff(dB * 0.70710678118654752f)) * wB * (1.0f / 64.0f);
                float acc[16];
#pragma unroll
                for (int i = 0; i < 16; ++i) acc[i] = 0.f;
#define G_VSTEP(WAITN, e_expr, REFILL) do { u32x4 v; G_WAITV(WAITN); G_TAKE(v, j); REFILL; const int e_ = (e_expr); \
        const float a_ = __uint_as_float(__builtin_amdgcn_readlane(__float_as_uint((e_ < 64) ? aA : aB), e_ & 63)); \
        _Pragma("unroll") for (int k = 0; k < 4; ++k) { const f32x2 lo = __builtin_amdgcn_cvt_pk_f32_fp8((int)v[k], false), hi = __builtin_amdgcn_cvt_pk_f32_fp8((int)v[k], true); \
            acc[4 * k] += a_ * lo[0]; acc[4 * k + 1] += a_ * lo[1]; acc[4 * k + 2] += a_ * hi[0]; acc[4 * k + 3] += a_ * hi[1]; } } while (0)
                for (int it = 0; it < 7; ++it) {
#pragma unroll
                    for (int j = 0; j < 16; ++j) G_VSTEP(15, 16 * it + j, G_ISSUE(128 + 16 * it + j + 16, j));
                }
                {
#define G_LAST(jj, n) do { const int j = jj; G_VSTEP(n, 112 + j, (void)0); } while (0)
                    G_LAST(0, 15); G_LAST(1, 14); G_LAST(2, 13); G_LAST(3, 12); G_LAST(4, 11); G_LAST(5, 10); G_LAST(6, 9); G_LAST(7, 8);
                    G_LAST(8, 7); G_LAST(9, 6); G_LAST(10, 5); G_LAST(11, 4); G_LAST(12, 3); G_LAST(13, 2); G_LAST(14, 1); G_LAST(15, 0);
#undef G_LAST
                }
#undef G_VSTEP
#undef G_ISSUE
#undef G_WAITV
#undef G_TAKE
                float s = 0.f;
#pragma unroll
                for (int i = 0; i < 16; ++i) s += acc[i] * acc[i];
                const float rp = rsqrtf(wave_sum(s) * (1.0f / DM) + EPS);
#pragma unroll
                for (int q = 0; q < 4; ++q) { const int cc = c0 + 4 * q; const f32x4 a4 = *(const LAS f32x4*)(VEC + 3072 + cc); f32x4 xm = *(const f32x4*)(out + row * DM + cc);
#pragma unroll
                    for (int e = 0; e < 4; ++e) xm[e] += a4[e] * (acc[q * 4 + e] * rp);
                    *(f32x4*)(out + row * DM + cc) = xm; }
            }
#else
            TM(7) for (int rr = wave * 32; rr < wave * 32 + 32; ++rr) {
                int ln = lane; asm volatile("" : "+v"(ln));
                const size_t row = (size_t)tok0 + rr; const int c0 = 8 * ln, c1 = 512 + 8 * ln;
                const int idA = EIDX[row * 128 + ln], idB = EIDX[row * 128 + 64 + ln]; const float wA = EW[row * 128 + ln], wB = EW[row * 128 + 64 + ln];
                const u32x4 xa = *(const u32x4*)(HF + row * DM + c0), xb = *(const u32x4*)(HF + row * DM + c1);
                float dA = 0.f, dB = 0.f;
#pragma unroll 2
                for (int q = 0; q < 16; ++q) {
                    float r[8];
#pragma unroll
                    for (int i = 0; i < 8; ++i) { const int id = __builtin_amdgcn_readlane((q < 8) ? idA : idB, (q & 7) * 8 + i); const u32x4* up = (const u32x4*)(PU + (size_t)id * DM) + ln;
                        const u32x4 u0 = up[0], u1 = up[64]; float d = dot2(u0.x, xa.x, 0.f); d = dot2(u0.y, xa.y, d); d = dot2(u0.z, xa.z, d); d = dot2(u0.w, xa.w, d);
                        d = dot2(u1.x, xb.x, d); d = dot2(u1.y, xb.y, d); d = dot2(u1.z, xb.z, d); d = dot2(u1.w, xb.w, d); r[i] = d; }
                    float r4[4], r2[2], r1;
#pragma unroll
                    for (int i = 0; i < 4; ++i) { const bool b0 = ln & 1; const float keep = b0 ? r[2 * i + 1] : r[2 * i], send = b0 ? r[2 * i] : r[2 * i + 1]; r4[i] = keep + __shfl_xor(send, 1); }
#pragma unroll
                    for (int i = 0; i < 2; ++i) { const bool b1 = ln & 2; const float keep = b1 ? r4[2 * i + 1] : r4[2 * i], send = b1 ? r4[2 * i] : r4[2 * i + 1]; r2[i] = keep + __shfl_xor(send, 2); }
                    { const bool b2 = ln & 4; const float keep = b2 ? r2[1] : r2[0], send = b2 ? r2[0] : r2[1]; r1 = keep + __shfl_xor(send, 4); }
                    r1 += __shfl_xor(r1, 8); r1 += __shfl_xor(r1, 16); r1 += __shfl_xor(r1, 32);
                    if ((ln >> 3) == (q & 7)) { if (q < 8) dA = r1; else dB = r1; }
                }
                const float aA = 0.5f * dA * (1.0f + erff(dA * 0.70710678118654752f)) * wA, aB = 0.5f * dB * (1.0f + erff(dB * 0.70710678118654752f)) * wB;
                float acc[16];
#pragma unroll
                for (int i = 0; i < 16; ++i) acc[i] = 0.f;
#pragma unroll 2
                for (int q = 0; q < 16; ++q) {
#pragma unroll
                    for (int i = 0; i < 8; ++i) { const int sl = (q & 7) * 8 + i; const int id = __builtin_amdgcn_readlane((q < 8) ? idA : idB, sl);
                        const float a = __uint_as_float(__builtin_amdgcn_readlane(__float_as_uint((q < 8) ? aA : aB), sl));
                        const u32x4* vp = (const u32x4*)(PV + (size_t)id * DM) + ln; const u32x4 v0 = vp[0], v1 = vp[64];
                        acc[0] += a * bf_lo(v0.x); acc[1] += a * bf_hi(v0.x); acc[2] += a * bf_lo(v0.y); acc[3] += a * bf_hi(v0.y); acc[4] += a * bf_lo(v0.z); acc[5] += a * bf_hi(v0.z); acc[6] += a * bf_lo(v0.w); acc[7] += a * bf_hi(v0.w);
                        acc[8] += a * bf_lo(v1.x); acc[9] += a * bf_hi(v1.x); acc[10] += a * bf_lo(v1.y); acc[11] += a * bf_hi(v1.y); acc[12] += a * bf_lo(v1.z); acc[13] += a * bf_hi(v1.z); acc[14] += a * bf_lo(v1.w); acc[15] += a * bf_hi(v1.w); }
                }
                float s = 0.f;
#pragma unroll
                for (int i = 0; i < 16; ++i) s += acc[i] * acc[i];
                const float rp = rsqrtf(wave_sum(s) * (1.0f / DM) + EPS);
#pragma unroll
                for (int q = 0; q < 4; ++q) { const int cc = (q < 2 ? c0 : c1) + (q & 1) * 4; const f32x4 a4 = *(const LAS f32x4*)(VEC + 3072 + cc); f32x4 xm = *(const f32x4*)(out + row * DM + cc);
#pragma unroll
                    for (int e = 0; e < 4; ++e) xm[e] += a4[e] * (acc[q * 4 + e] * rp);
                    *(f32x4*)(out + row * DM + cc) = xm; }
            }
#endif
        }
    }

#if PEER_XCD
    constexpr int NPH = 10;
    SEAM(5); PROBE(10);
    if (IN(6) || IN(8)) {
        DECL_PTRS
        float* PART = (float*)(ws + WS_GT); unsigned* PK = (unsigned*)(ws + WS_XP); float* SSQP = (float*)(ws + WS_XP + 32 * MiB); bf16_t* PEERO = (bf16_t*)(ws + WS_Q);
        const unsigned char* PU8 = (const unsigned char*)PU; const unsigned char* PV8 = (const unsigned char*)PV;
#pragma unroll 1
        for (int vph = 0; vph < 2; ++vph) {
            if (!(vph == 0 ? IN(6) : IN(8))) continue;
            const bool isv = vph == 1;
            int ln = lane; asm volatile("" : "+v"(ln));
            const int p = bx & 7, r = bx >> 3, nbp = (G - p + 7) >> 3;
            const int first = r * 8 + wave, stride = nbp * 8;
            const int T = (first < TL) ? (TL - 1 - first) / stride + 1 : 0;
            const int lg = ln >> 3, lc = ln & 7;
            const unsigned char* tab = (isv ? PV8 : PU8) + (size_t)p * ((size_t)16384 * 128);
            const int bp_base = lg * 4;
            const unsigned* HW = isv ? (const unsigned*)PK : (const unsigned*)EIDX;
            if (isv) gather_wave<true>(p, first, stride, T, ln, tab, bp_base, HW, HF, PART, PEERO, SSQP); else gather_wave<false>(p, first, stride, T, ln, tab, bp_base, HW, PEER_I8 ? (const bf16_t*)(ws + WS_HF8) : HF, PART, PEERO, SSQP);
            if (!isv) {
                SEAM(6); PROBE(11);
                if (IN(7)) for (int t0 = gw * 4; t0 < TL; t0 += NGW * 4) {
                    float dd[8]; float ew[8]; int ei[8]; float us[8];
#pragma unroll
                    for (int u_ = 0; u_ < 8; ++u_) { const size_t t = (size_t)t0 + (u_ >> 1); const int e = (u_ & 1) * 64 + lane; float d = 0.f;
#pragma unroll
                        for (int pp = 0; pp < 8; ++pp) d += __uint_as_float((unsigned)((const bf16_t*)PART)[((size_t)pp * TL + t) * 128 + e] << 16);
                        dd[u_] = PEER_I8 ? d * ((const float*)(ws + WS_XSCALE))[t] : d * (1.0f / 64.0f); ew[u_] = EW[t * 128 + e]; ei[u_] = EIDX[t * 128 + e]; }
#if PEER_I8
#pragma unroll
                    for (int u_ = 0; u_ < 8; ++u_) us[u_] = ((const float*)(ws + WS_USCALE))[ei[u_]];
#endif
#pragma unroll
                    for (int u_ = 0; u_ < 8; ++u_) { const size_t t = (size_t)t0 + (u_ >> 1); const int e = (u_ & 1) * 64 + lane; const float d = PEER_I8 ? dd[u_] * us[u_] : dd[u_];
                        const float a = 0.5f * d * (1.0f + erff(d * 0.70710678118654752f)) * ew[u_] * (1.0f / 64.0f);
                        PK[t * 128 + e] = (cvtpk(0.f, a) & 0xffff0000u) | (unsigned)ei[u_]; }
                }
                SEAM(7); PROBE(12);
            }
        }
    }
    SEAM(8); PROBE(13);
    if (IN(9)) {
        DECL_PTRS
        const float* SSQP = (const float*)(ws + WS_XP + 32 * MiB); const bf16_t* PEERO = (const bf16_t*)(ws + WS_Q);
        for (int blk = vcu; blk < 256; blk += G) {
            const int b = blk >> 3;
            __syncthreads();
            for (int k = tid; k < DM; k += NTHREADS) VEC[k] = modv(MOD, b_ada, b, 5120 + k) * g_ffn_post[k];
            __syncthreads();
            const int c0 = 8 * lane, c1 = 512 + 8 * lane;
            float nss[8]; u32x4 ny0, ny1, nm0, nm1;
#define F_LOAD(rr_) do { const size_t r_ = (size_t)blk * 256 + (rr_); _Pragma("unroll") for (int pp = 0; pp < 8; ++pp) nss[pp] = SSQP[(size_t)pp * TL + r_]; \
        ny0 = *(const u32x4*)(PEERO + r_ * DM + c0); ny1 = *(const u32x4*)(PEERO + r_ * DM + c1); \
        { const bf16_t* xmr_ = (const bf16_t*)(ws + xm_off(r_)); nm0 = *(const u32x4*)(xmr_ + c0); nm1 = *(const u32x4*)(xmr_ + c1); } } while (0)
            F_LOAD(wave);
            for (int rr = wave; rr < 256; rr += NWAVES) {
                const size_t row = (size_t)blk * 256 + rr; float ss = 0.f;
#pragma unroll
                for (int pp = 0; pp < 8; ++pp) ss += nss[pp];
                const u32x4 y0 = ny0, y1 = ny1, m0 = nm0, m1 = nm1;
                const f32x4 xmv[4] = {(f32x4){bf_lo(m0.x), bf_hi(m0.x), bf_lo(m0.y), bf_hi(m0.y)}, (f32x4){bf_lo(m0.z), bf_hi(m0.z), bf_lo(m0.w), bf_hi(m0.w)},
                                      (f32x4){bf_lo(m1.x), bf_hi(m1.x), bf_lo(m1.y), bf_hi(m1.y)}, (f32x4){bf_lo(m1.z), bf_hi(m1.z), bf_lo(m1.w), bf_hi(m1.w)}};
                if (rr + NWAVES < 256) F_LOAD(rr + NWAVES);
                const float rp = rsqrtf(ss * (1.0f / DM) + EPS);
                const float pv[16] = {bf_lo(y0.x), bf_hi(y0.x), bf_lo(y0.y), bf_hi(y0.y), bf_lo(y0.z), bf_hi(y0.z), bf_lo(y0.w), bf_hi(y0.w), bf_lo(y1.x), bf_hi(y1.x), bf_lo(y1.y), bf_hi(y1.y), bf_lo(y1.z), bf_hi(y1.z), bf_lo(y1.w), bf_hi(y1.w)};
#pragma unroll
                for (int q = 0; q < 4; ++q) { const int cc = (q < 2 ? c0 : c1) + (q & 1) * 4; const f32x4 a4 = *(const LAS f32x4*)(VEC + cc); f32x4 xm = xmv[q];
#pragma unroll
                    for (int e = 0; e < 4; ++e) xm[e] += a4[e] * (pv[q * 4 + e] * rp);
                    *(f32x4*)(out + row * DM + cc) = xm; }
            }
#undef F_LOAD
        }
    }
#else
    constexpr int NPH = 6;
#endif
    PROBE(9);
    if (PROBE_PT && PROBE_MODE) { xcd_barrier(xbar); if (blockIdx.x == 0 && threadIdx.x == 0) { const unsigned m_ = __hip_atomic_load((unsigned*)args.ws + 8192, __ATOMIC_RELAXED, __HIP_MEMORY_SCOPE_AGENT);
        probe_val = (float)(PROBE_MODE == 1 ? m_ : 0xFFFFFFFFu - m_) * (1.0f / PROBE_DIV); } }
    if (PROBE_PT && blockIdx.x == 0) { __syncthreads(); if (threadIdx.x == 0) args.out[0] = probe_val; }
#undef IN
#undef SEAM
}

extern "C" void kernel_launch(void* const* d_in, const int* in_sizes, int n_in, void* d_out, int out_size, void* d_ws, size_t ws_size, hipStream_t stream) {
    static int grid = 0;
    if (grid == 0) {
        if (n_in != 22 || out_size != TL * DM || ws_size < WS_END) { fprintf(stderr, "kernel_launch: unexpected shapes: n_in %d out %d ws %zu (need %zu)\n", n_in, out_size, ws_size, (size_t)WS_END); grid = -1; return; }
        int dev = 0, cus = 0, per_cu = 0;
        hipGetDevice(&dev); hipDeviceGetAttribute(&cus, hipDeviceAttributeMultiprocessorCount, dev);
        hipFuncSetAttribute((const void*)mk_fwd, hipFuncAttributeMaxDynamicSharedMemorySize, LDS_BYTES);
        hipOccupancyMaxActiveBlocksPerMultiprocessor(&per_cu, (const void*)mk_fwd, NTHREADS, LDS_BYTES);
        (void)hipGetLastError();
        if (per_cu < 1) { fprintf(stderr, "kernel_launch: occupancy query says %d blocks per CU\n", per_cu); }
        grid = cus;
    }
    if (grid < 0) return;
    if (hipMemsetAsync(d_ws, 0, 65536, stream) != hipSuccess) { fprintf(stderr, "kernel_launch: memset of the barrier words failed\n"); return; }
    Args a{};
    for (int i = 0; i < 22; ++i) a.in[i] = (const float*)d_in[i];
    a.out = (float*)d_out; a.ws = (unsigned char*)d_ws;
    if (MK_N_LAUNCHES == 1) {
        a.ph_lo = 0; a.ph_hi = PEER_XCD ? 10 : 6; void* kargs[] = {&a};
        hipError_t e = hipLaunchCooperativeKernel((const void*)mk_fwd, dim3(grid), dim3(NTHREADS), kargs, LDS_BYTES, stream);
        if (e != hipSuccess) fprintf(stderr, "cooperative launch failed: %s (grid %d)\n", hipGetErrorString(e), grid);
    } else {
        for (int p = 0; p < (PEER_XCD ? 10 : 6); ++p) { a.ph_lo = p; a.ph_hi = p + 1; hipLaunchKernelGGL(mk_fwd, dim3(grid), dim3(NTHREADS), LDS_BYTES, stream, a); }
    }
}
```

```cpp
#include <hip/hip_runtime.h>
#include <hip/hip_cooperative_groups.h>
#include <cstdint>
#include <cstdio>
namespace cg = cooperative_groups;

#ifndef PEER_I8
#define PEER_I8 1
#endif
#ifndef PEER_FOLD
#define PEER_FOLD 1
#endif
#ifndef S_I16
#define S_I16 1
#endif
#ifndef PEER_XCD
#define PEER_XCD 1
#endif
#ifndef PEER_FP8
#define PEER_FP8 1
#endif
#ifndef MK_N_LAUNCHES
#define MK_N_LAUNCHES 1
#endif

#define LAS __attribute__((address_space(3)))
typedef unsigned short bf16_t;
typedef short bf16x8 __attribute__((ext_vector_type(8)));
typedef short s16x4 __attribute__((ext_vector_type(4)));
typedef float f32x2 __attribute__((ext_vector_type(2)));
typedef float f32x4 __attribute__((ext_vector_type(4)));
typedef float f32x16 __attribute__((ext_vector_type(16)));
typedef unsigned u32x2 __attribute__((ext_vector_type(2)));
typedef unsigned u32x4 __attribute__((ext_vector_type(4)));
typedef __bf16 bf16x2_t __attribute__((ext_vector_type(2)));
typedef short s16x2 __attribute__((ext_vector_type(2)));

constexpr int DM = 1024, NB = 32, SEQ = 2048, CTXL = 256, TL = NB * SEQ, TC = NB * CTXL, TALL = TL + TC;
constexpr int NH = 8, DQK = 192, QW = NH * DQK, NKEY = CTXL + SEQ;
constexpr int NWIN = 3584;
constexpr int INW = 3520;
constexpr float EPS = 1e-6f;
constexpr float C2 = 0.07216878364870323f * 1.4426950408889634f;
constexpr int NWAVES = 8, NTHREADS = 512;

constexpr size_t MiB = 1u << 20;
constexpr size_t WS_MOD = 1 * MiB;
constexpr size_t WS_USCALE = 1 * MiB;
constexpr size_t WS_XSCALE = 1 * MiB + 128 * 1024;
constexpr size_t WS_ROPE = 2 * MiB;
constexpr size_t WS_SSQCQ = 3 * MiB;
constexpr size_t WS_SSQY = 4 * MiB;
constexpr size_t WS_WIN = 8 * MiB;
constexpr size_t WS_WQ = 15 * MiB;
constexpr size_t WS_WUV = 16 * MiB;
constexpr size_t WS_WPOOL = 16 * MiB + 512 * 1024;
constexpr size_t WS_KEYS = 17 * MiB;
constexpr size_t WS_WOUT = 18 * MiB;
constexpr size_t WS_WPQ = 20 * MiB;
constexpr size_t WS_PU = 24 * MiB;
constexpr size_t WS_PV = 56 * MiB;
constexpr size_t WS_HN = 88 * MiB;
constexpr size_t WS_CQ = 232 * MiB;
constexpr size_t WS_KVRAW = 264 * MiB;
constexpr size_t WS_KF = 318 * MiB;
constexpr size_t WS_XP = 345 * MiB;
constexpr size_t WS_GT = 473 * MiB;
constexpr size_t WS_Q = 729 * MiB;
constexpr size_t WS_S = WS_Q + 128 * MiB;
constexpr size_t WS_HF8 = WS_Q + 128 * MiB;
constexpr size_t WS_MODP = 922 * MiB;
constexpr size_t WS_XM_LO = 926 * MiB;
constexpr size_t WS_XM_HI = 296 * MiB;
constexpr size_t WS_END = 1022 * MiB;
__device__ __forceinline__ size_t xm_off(size_t row) { return row < 49152 ? WS_XM_LO + row * 2048 : WS_XM_HI + (row - 49152) * 2048; }

constexpr int RING_BYTES = 131072;
constexpr int VEC_OFF = RING_BYTES;
constexpr int MISC_OFF = 163840 - 1024;
constexpr int LDS_BYTES = 163840;

__device__ __forceinline__ unsigned cvtpk(float lo, float hi) { f32x2 v = {lo, hi}; bf16x2_t b = __builtin_convertvector(v, bf16x2_t); return __builtin_bit_cast(unsigned, b); }
__device__ __forceinline__ float bf_lo(unsigned w) { return __uint_as_float(w << 16); }
__device__ __forceinline__ float bf_hi(unsigned w) { return __uint_as_float(w & 0xffff0000u); }
__device__ __forceinline__ float wave_sum(float v) {
#pragma unroll
    for (int o = 1; o < 64; o <<= 1) v += __shfl_xor(v, o);
    return v;
}
__device__ __forceinline__ float wave_max(float v) {
#pragma unroll
    for (int o = 1; o < 64; o <<= 1) v = fmaxf(v, __shfl_xor(v, o));
    return v;
}
__device__ __forceinline__ unsigned pack_i8(float a, float b, float c, float d) {
    const int q0 = (int)__builtin_rintf(a), q1 = (int)__builtin_rintf(b), q2 = (int)__builtin_rintf(c), q3 = (int)__builtin_rintf(d);
    return (unsigned)(q0 & 255) | ((unsigned)(q1 & 255) << 8) | ((unsigned)(q2 & 255) << 16) | ((unsigned)q3 << 24); }
__device__ __forceinline__ float dot2(unsigned a, unsigned b, float c) { return __builtin_amdgcn_fdot2_f32_bf16(__builtin_bit_cast(bf16x2_t, a), __builtin_bit_cast(bf16x2_t, b), c, false); }
__device__ __forceinline__ float fast_sigmoid(float x) { return __builtin_amdgcn_rcpf(1.0f + __builtin_amdgcn_exp2f(-1.4426950408889634f * x)); }
__host__ __device__ __forceinline__ int rope_src(int j) { const int p = j >> 1; return (p >> 4) * 32 + (j & 1) * 16 + (p & 15); }

namespace pg8 {
constexpr int BM = 256, BK = 64, HALF = 128, HTB = HALF * BK * 2, STAGE_BYTES = 8 * HTB, NXCD = 8, WGM = 8;
__host__ __device__ __forceinline__ int lds_byte(int r, int c) { const int st = (r >> 4) * 2 + (c >> 5), rr = r & 15, cc = c & 31, ob = rr * 64 + cc * 2; return st * 1024 + (ob ^ (((ob >> 9) & 1) << 5)); }
__host__ __device__ __forceinline__ void stage_rc(int b, int& R, int& C) { const int st = b / 1024, sb = b % 1024, swz = sb ^ (((sb >> 9) & 1) << 5); R = (st >> 1) * 16 + swz / 64; C = (st & 1) * 32 + (swz % 64) / 2; }
__host__ __device__ __forceinline__ int perm32(int rho) { const int n = rho >> 4, i = rho & 15; return 8 * (i >> 2) + 4 * n + (i & 3); }

struct Unit { int pm, pn; long aoff, boff; };
struct Gemm { const bf16_t* A; const bf16_t* Bt; int lda, ldb, K; };

__device__ __forceinline__ bool grouped_tile(long L, int nM, int nN, int& pm, int& pn) {
    const int nwg = nM * nN; if (L >= nwg) return false;
    int wgid = (int)L; { const int q = nwg / NXCD, r = nwg % NXCD, xcd = wgid % NXCD, off = wgid / NXCD; wgid = (xcd < r ? xcd * (q + 1) : r * (q + 1) + (xcd - r) * q) + off; }
    const int nig = WGM * nN, gid = wgid / nig, fm = gid * WGM, gsz = (nM - fm) < WGM ? (nM - fm) : WGM;
    pm = fm + ((wgid % nig) % gsz); pn = (wgid % nig) / gsz; return true;
}

template <class Epi, class Sched, bool ALIGN_EPI>
__device__ __forceinline__ void gemm_phase(LAS unsigned char* lds, const Gemm g, const Sched& S, const Epi& E) {
    int tid = threadIdx.x; asm volatile("" : "+v"(tid));
    const int wid = __builtin_amdgcn_readfirstlane(tid >> 6), lane = tid & 63, wr = wid >> 2, wc = wid & 3, fr = lane & 15, fq = lane >> 4;
    const int nt = g.K / BK;
    unsigned voffA[2], voffB[2];
#pragma unroll
    for (int i = 0; i < 2; ++i) { int R, C; stage_rc(tid * 16 + i * 8192, R, C); const int Rb = Epi::PERM ? ((R & ~31) + perm32(R & 31)) : R;
        voffA[i] = (unsigned)(R * g.lda + C) * 2u; voffB[i] = (unsigned)(Rb * g.ldb + C) * 2u; }
    const size_t kstep = (size_t)(BK * 2);
    const size_t hA = (size_t)HALF * g.lda * 2, hB = (size_t)HALF * g.ldb * 2;
    const unsigned ldsw = (unsigned)wid * 1024u;
    const int aoff = lds_byte(wr * 64 + fr, fq * 8), boff = lds_byte(wc * 32 + fr, fq * 8);
#define PG8_SA(b, h) (((b) * 2 + (h)) * HTB)
#define PG8_SB(b, h) ((4 + (b) * 2 + (h)) * HTB)
#define PG8_STAGE(bufoff, gbase, voff) do { _Pragma("unroll") for (int _i = 0; _i < 2; ++_i) \
        __builtin_amdgcn_global_load_lds((const unsigned*)((const char*)(gbase) + (voff)[_i]), (LAS unsigned*)(lds + (bufoff) + ldsw + _i * 8192), 16, 0, 0); } while (0)
#define PG8_LDA(dst, b, h) do { _Pragma("unroll") for (int m = 0; m < 4; ++m) _Pragma("unroll") for (int k = 0; k < 2; ++k) dst[m][k] = *(const LAS bf16x8*)(lds + PG8_SA(b, h) + aoff + m * 2048 + k * 1024); } while (0)
#define PG8_LDB(dst, b, h) do { _Pragma("unroll") for (int n = 0; n < 2; ++n) _Pragma("unroll") for (int k = 0; k < 2; ++k) dst[n][k] = *(const LAS bf16x8*)(lds + PG8_SB(b, h) + boff + n * 2048 + k * 1024); } while (0)
#define PG8_MMA(ai, bj, At, Bt) do { __builtin_amdgcn_s_setprio(1); _Pragma("unroll") for (int m = 0; m < 4; ++m) _Pragma("unroll") for (int n = 0; n < 2; ++n) _Pragma("unroll") for (int k = 0; k < 2; ++k) \
        acc[ai][bj][m][n] = __builtin_amdgcn_mfma_f32_16x16x32_bf16(Bt[n][k], At[m][k], acc[ai][bj][m][n], 0, 0, 0); __builtin_amdgcn_s_setprio(0); } while (0)
#define PG8_WAIT_V(n) asm volatile("s_waitcnt vmcnt(" #n ")" ::: "memory")
#define PG8_WAIT_L(n) asm volatile("s_waitcnt lgkmcnt(" #n ")" ::: "memory")
#define PG8_BAR __builtin_amdgcn_s_barrier()
#define PG8_SCHED __builtin_amdgcn_sched_barrier(0)
    Unit cur, nxt; int ui = 0;
    if (!S.next(0, cur)) return;
    f32x4 acc[2][2][4][2];
#pragma unroll
    for (int a = 0; a < 2; ++a)
#pragma unroll
        for (int b = 0; b < 2; ++b)
#pragma unroll
            for (int m = 0; m < 4; ++m)
#pragma unroll
                for (int n = 0; n < 2; ++n) acc[a][b][m][n] = (f32x4){0.f, 0.f, 0.f, 0.f};
    bf16x8 At[4][2], B0[2][2], B1[2][2];
    const char* cA = (const char*)g.A + cur.aoff; const char* cB = (const char*)g.Bt + cur.boff;
    PG8_STAGE(PG8_SB(0, 0), cB, voffB); PG8_STAGE(PG8_SB(0, 1), cB + hB, voffB); PG8_STAGE(PG8_SA(0, 0), cA, voffA); PG8_STAGE(PG8_SA(0, 1), cA + hA, voffA);
    if (wr == 1) PG8_BAR;
    PG8_WAIT_V(2); PG8_BAR;
    PG8_STAGE(PG8_SB(1, 0), cB + kstep, voffB); PG8_STAGE(PG8_SA(1, 0), cA + kstep, voffA); PG8_STAGE(PG8_SB(1, 1), cB + hB + kstep, voffB);
    PG8_WAIT_V(6); PG8_BAR;
    for (;;) {
        const bool has_next = S.next(ui + 1, nxt);
        const char* nA = has_next ? (const char*)g.A + nxt.aoff : cA; const char* nB = has_next ? (const char*)g.Bt + nxt.boff : cB;
#pragma nounroll
        for (int t = 0; t < nt; t += 2) {
            const bool last = (t == nt - 2);
            const char* a1 = cA + (size_t)(t + 1) * kstep;
            const char* a2 = last ? nA : cA + (size_t)(t + 2) * kstep; const char* b2 = last ? nB : cB + (size_t)(t + 2) * kstep;
            const char* a3 = a2 + kstep; const char* b3 = b2 + kstep;
            PG8_LDB(B0, 0, 0); PG8_LDB(B1, 0, 1); PG8_SCHED; PG8_LDA(At, 0, 0); PG8_STAGE(PG8_SA(1, 1), a1 + hA, voffA);
            PG8_WAIT_V(8); PG8_WAIT_L(0); PG8_BAR; PG8_MMA(0, 0, At, B0); PG8_MMA(0, 1, At, B1); PG8_BAR; PG8_SCHED;
            PG8_LDA(At, 0, 1); PG8_STAGE(PG8_SB(0, 0), b2, voffB); PG8_STAGE(PG8_SB(0, 1), b2 + hB, voffB); PG8_STAGE(PG8_SA(0, 0), a2, voffA);
            PG8_WAIT_V(8); PG8_WAIT_L(0); PG8_BAR; PG8_MMA(1, 0, At, B0); PG8_MMA(1, 1, At, B1); PG8_BAR; PG8_SCHED;
            PG8_LDB(B0, 1, 0); PG8_LDB(B1, 1, 1); PG8_SCHED; PG8_LDA(At, 1, 0); PG8_STAGE(PG8_SA(0, 1), a2 + hA, voffA);
            PG8_WAIT_V(8); PG8_WAIT_L(0); PG8_BAR; PG8_MMA(0, 0, At, B0); PG8_MMA(0, 1, At, B1); PG8_BAR; PG8_SCHED;
            PG8_LDA(At, 1, 1); PG8_STAGE(PG8_SB(1, 0), b3, voffB); PG8_STAGE(PG8_SB(1, 1), b3 + hB, voffB); PG8_STAGE(PG8_SA(1, 0), a3, voffA);
            PG8_WAIT_V(8); PG8_WAIT_L(0); PG8_BAR; PG8_MMA(1, 0, At, B0); PG8_MMA(1, 1, At, B1); PG8_BAR; PG8_SCHED;
        }
        if constexpr (ALIGN_EPI) { if (wr == 0) PG8_BAR; }
        E(acc, cur, wr, wc, fr, fq);
        if (!has_next) break;
#pragma unroll
        for (int a = 0; a < 2; ++a)
#pragma unroll
            for (int b = 0; b < 2; ++b)
#pragma unroll
                for (int m = 0; m < 4; ++m)
#pragma unroll
                    for (int n = 0; n < 2; ++n) acc[a][b][m][n] = (f32x4){0.f, 0.f, 0.f, 0.f};
        cur = nxt; cA = nA; cB = nB; ++ui;
        if constexpr (ALIGN_EPI) { if (wr == 1) PG8_BAR; }
    }
    PG8_WAIT_V(0);
    if constexpr (!ALIGN_EPI) { if (wr == 0) PG8_BAR; }
    PG8_BAR;
#undef PG8_SA
#undef PG8_SB
#undef PG8_STAGE
#undef PG8_LDA
#undef PG8_LDB
#undef PG8_MMA
#undef PG8_WAIT_V
#undef PG8_WAIT_L
#undef PG8_BAR
#undef PG8_SCHED
}
}
using pg8::Unit;

struct SchedIn {
    int G, c;
    __device__ __forceinline__ bool next(int i, Unit& u) const {
        const long L = (long)i * G + c; if (L >= 256 * 14 + 32) return false;
        int pm, pn;
        if (L < 256 * 14) pg8::grouped_tile(L, 256, 14, pm, pn); else { pm = 256 + (int)(L - 256 * 14); pn = 1; }
        u.pm = pm; u.pn = pn; u.aoff = (long)pm * 256 * DM * 2; u.boff = (long)pn * 256 * DM * 2; return true;
    }
};
struct SchedQ {
    int G, c;
    __device__ __forceinline__ bool next(int i, Unit& u) const {
        const long L = (long)i * G + c; int pm, pn; if (!pg8::grouped_tile(L, 256, 6, pm, pn)) return false;
        u.pm = pm; u.pn = pn; u.aoff = (long)pm * 256 * 256 * 2; u.boff = (long)pn * 256 * 256 * 2; return true;
    }
};
struct SchedRow {
    int pm, pn0, n; long a_base, a_pn, b_base, b_pn;
    __device__ __forceinline__ bool next(int i, Unit& u) const {
        if (i >= n) return false; u.pm = pm; u.pn = pn0 + i; u.aoff = a_base + (long)(pn0 + i) * a_pn; u.boff = b_base + (long)(pn0 + i) * b_pn; return true;
    }
};

#define EPI_ROWS_BEGIN _Pragma("unroll") for (int ai = 0; ai < 2; ++ai) _Pragma("unroll") for (int m = 0; m < 4; ++m) { const int row = row0 + ai * 128 + m * 16;
#define EPI_ROWS_END asm volatile("" ::: "memory"); }
__device__ __forceinline__ u32x4 pack8(f32x4 v0, f32x4 v1) { u32x4 w; w.x = cvtpk(v0[0], v0[1]); w.y = cvtpk(v0[2], v0[3]); w.z = cvtpk(v1[0], v1[1]); w.w = cvtpk(v1[2], v1[3]); return w; }

struct EpiIn {
    static constexpr bool PERM = true;
    bf16_t* CQ; float* SSQ; float* KVRAW; bf16_t* XP; bf16_t* GT;
    __device__ __forceinline__ void operator()(const f32x4 (&acc)[2][2][4][2], const Unit& u, int wr, int wc, int fr, int fq) const {
        const int row0 = u.pm * 256 + wr * 64 + fr, cb = wc * 32 + 8 * fq, pn = u.pn;
        if (pn == 0) {
            EPI_ROWS_BEGIN  float s = 0.f;
#pragma unroll
                for (int bj = 0; bj < 2; ++bj) { const f32x4 v0 = acc[ai][bj][m][0], v1 = acc[ai][bj][m][1];
                    s += (v0[0] * v0[0] + v0[1] * v0[1]) + (v0[2] * v0[2] + v0[3] * v0[3]) + (v1[0] * v1[0] + v1[1] * v1[1]) + (v1[2] * v1[2] + v1[3] * v1[3]);
                    *(u32x4*)(CQ + (size_t)row * 256 + bj * 128 + cb) = pack8(v0, v1); }
                s += __shfl_xor(s, 16); s += __shfl_xor(s, 32);
                if (fq == 0) SSQ[(size_t)row * 4 + wc] = s;  EPI_ROWS_END
        } else if (pn == 1) {
            EPI_ROWS_BEGIN
#pragma unroll
                for (int bj = 0; bj < 2; ++bj) { const int col = bj * 128 + cb;
                    if (col < 192) { float* p = KVRAW + (size_t)row * 192 + col; *(f32x4*)p = acc[ai][bj][m][0]; *(f32x4*)(p + 4) = acc[ai][bj][m][1]; } }  EPI_ROWS_END
        } else if (pn < 6) {
            EPI_ROWS_BEGIN
#pragma unroll
                for (int bj = 0; bj < 2; ++bj) *(u32x4*)(XP + (size_t)row * 1024 + (pn - 2) * 256 + bj * 128 + cb) = pack8(acc[ai][bj][m][0], acc[ai][bj][m][1]);  EPI_ROWS_END
        } else {
            EPI_ROWS_BEGIN
#pragma unroll
                for (int bj = 0; bj < 2; ++bj) { f32x4 v0 = acc[ai][bj][m][0], v1 = acc[ai][bj][m][1];
#pragma unroll
                    for (int e = 0; e < 4; ++e) { v0[e] = fast_sigmoid(v0[e]); v1[e] = fast_sigmoid(v1[e]); }
                    *(u32x4*)(GT + (size_t)row * 2048 + (pn - 6) * 256 + bj * 128 + cb) = pack8(v0, v1); }  EPI_ROWS_END
        }
    }
};

struct EpiQ {
    static constexpr bool PERM = true;
    bf16_t* Q; const float* SSQ; const float* TAB;
    __device__ __forceinline__ void operator()(const f32x4 (&acc)[2][2][4][2], const Unit& u, int wr, int wc, int fr, int fq) const {
        const int row0 = u.pm * 256 + wr * 64 + fr, cb = wc * 32 + 8 * fq;
        EPI_ROWS_BEGIN  const f32x4 sq = *(const f32x4*)(SSQ + (size_t)row * 4);
            const float rs = rsqrtf(((sq[0] + sq[1]) + (sq[2] + sq[3])) * (1.0f / 256.0f) + EPS) * C2;
            const int t = row & (SEQ - 1), vr = t >> 6, vc = t & 63;
#pragma unroll
            for (int bj = 0; bj < 2; ++bj) { const int col = u.pn * 256 + bj * 128 + cb, h = col / DQK, hc = col - h * DQK;
                f32x4 v0 = acc[ai][bj][m][0] * rs, v1 = acc[ai][bj][m][1] * rs;
                if (hc >= 128) { const int p0 = (hc - 128) >> 1, v = (p0 >> 4) ? vc : vr; const float* tp = TAB + (v * 16 + (p0 & 15)) * 2;
                    const f32x4 t0 = *(const f32x4*)tp, t1 = *(const f32x4*)(tp + 4);
                    f32x4 r0, r1;
                    r0[0] = v0[0] * t0[0] - v0[1] * t0[1]; r0[1] = v0[0] * t0[1] + v0[1] * t0[0]; r0[2] = v0[2] * t0[2] - v0[3] * t0[3]; r0[3] = v0[2] * t0[3] + v0[3] * t0[2];
                    r1[0] = v1[0] * t1[0] - v1[1] * t1[1]; r1[1] = v1[0] * t1[1] + v1[1] * t1[0]; r1[2] = v1[2] * t1[2] - v1[3] * t1[3]; r1[3] = v1[2] * t1[3] + v1[3] * t1[2];
                    v0 = r0; v1 = r1; }
                *(u32x4*)(Q + (size_t)row * QW + col) = pack8(v0, v1); }  EPI_ROWS_END
    }
};

struct EpiU {
    static constexpr bool PERM = true;
    bf16_t* MG; const bf16_t* GT;
    __device__ __forceinline__ void operator()(const f32x4 (&acc)[2][2][4][2], const Unit& u, int wr, int wc, int fr, int fq) const {
        const int row0 = u.pm * 256 + wr * 64 + fr, cb = wc * 32 + 8 * fq;
        EPI_ROWS_BEGIN
#pragma unroll
            for (int bj = 0; bj < 2; ++bj) { const int col = u.pn * 256 + bj * 128 + cb; const u32x4 gw = *(const u32x4*)(GT + (size_t)row * 2048 + col);
                f32x4 v0 = acc[ai][bj][m][0], v1 = acc[ai][bj][m][1];
                v0[0] *= bf_lo(gw.x); v0[1] *= bf_hi(gw.x); v0[2] *= bf_lo(gw.y); v0[3] *= bf_hi(gw.y); v1[0] *= bf_lo(gw.z); v1[1] *= bf_hi(gw.z); v1[2] *= bf_lo(gw.w); v1[3] *= bf_hi(gw.w);
                *(u32x4*)(MG + (size_t)row * 1024 + col) = pack8(v0, v1); }  EPI_ROWS_END
    }
};
struct EpiP {
    static constexpr bool PERM = true;
    bf16_t* MG; const bf16_t* GT; const LAS float* PS;
    __device__ __forceinline__ void operator()(const f32x4 (&acc)[2][2][4][2], const Unit& u, int wr, int wc, int fr, int fq) const {
        const int row0 = u.pm * 256 + wr * 64 + fr, cb = wc * 32 + 8 * fq;
        EPI_ROWS_BEGIN
#pragma unroll
            for (int bj = 0; bj < 2; ++bj) { const int col = u.pn * 256 + bj * 128 + cb; const u32x4 gw = *(const u32x4*)(GT + (size_t)row * 2048 + 1024 + col);
                const u32x4 mw = *(const u32x4*)(MG + (size_t)row * 1024 + col);
                const f32x4 p0 = *(const LAS f32x4*)(PS + col), p1 = *(const LAS f32x4*)(PS + col + 4);
                f32x4 v0 = acc[ai][bj][m][0] * p0, v1 = acc[ai][bj][m][1] * p1;
                v0[0] = bf_lo(mw.x) + v0[0] * bf_lo(gw.x); v0[1] = bf_hi(mw.x) + v0[1] * bf_hi(gw.x); v0[2] = bf_lo(mw.y) + v0[2] * bf_lo(gw.y); v0[3] = bf_hi(mw.y) + v0[3] * bf_hi(gw.y);
                v1[0] = bf_lo(mw.z) + v1[0] * bf_lo(gw.z); v1[1] = bf_hi(mw.z) + v1[1] * bf_hi(gw.z); v1[2] = bf_lo(mw.w) + v1[2] * bf_lo(gw.w); v1[3] = bf_hi(mw.w) + v1[3] * bf_hi(gw.w);
                *(u32x4*)(MG + (size_t)row * 1024 + col) = pack8(v0, v1); }  EPI_ROWS_END
    }
};
struct EpiO {
    static constexpr bool PERM = true;
    bf16_t* Y; float* SSQ;
    __device__ __forceinline__ void operator()(const f32x4 (&acc)[2][2][4][2], const Unit& u, int wr, int wc, int fr, int fq) const {
        const int row0 = u.pm * 256 + wr * 64 + fr, cb = wc * 32 + 8 * fq;
        EPI_ROWS_BEGIN  float s = 0.f;
#pragma unroll
            for (int bj = 0; bj < 2; ++bj) { const f32x4 v0 = acc[ai][bj][m][0], v1 = acc[ai][bj][m][1];
                s += (v0[0] * v0[0] + v0[1] * v0[1]) + (v0[2] * v0[2] + v0[3] * v0[3]) + (v1[0] * v1[0] + v1[1] * v1[1]) + (v1[2] * v1[2] + v1[3] * v1[3]);
                *(u32x4*)(Y + (size_t)row * 1024 + u.pn * 256 + bj * 128 + cb) = pack8(v0, v1); }
            s += __shfl_xor(s, 16); s += __shfl_xor(s, 32);
            if (fq == 0) SSQ[(size_t)row * 16 + u.pn * 4 + wc] = s;  EPI_ROWS_END
    }
};
struct EpiStore {
    static constexpr bool PERM = true;
    bf16_t* O; int ld;
    __device__ __forceinline__ void operator()(const f32x4 (&acc)[2][2][4][2], const Unit& u, int wr, int wc, int fr, int fq) const {
        const int row0 = u.pm * 256 + wr * 64 + fr, cb = wc * 32 + 8 * fq;
        EPI_ROWS_BEGIN
#pragma unroll
            for (int bj = 0; bj < 2; ++bj) *(u32x4*)(O + (size_t)row * ld + u.pn * 256 + bj * 128 + cb) = pack8(acc[ai][bj][m][0], acc[ai][bj][m][1]);  EPI_ROWS_END
    }
};
struct EpiS4 {
    static constexpr bool PERM = true;
    float* S; int rot;
    __device__ __forceinline__ void operator()(const f32x4 (&acc)[2][2][4][2], const Unit& u, int wr, int wc, int fr, int fq) const {
        const int row0 = wr * 64 + fr, cb = wc * 32 + 8 * fq;
        EPI_ROWS_BEGIN
#pragma unroll
            for (int bj = 0; bj < 2; ++bj) {
#if S_I16
                const f32x4 v0 = acc[ai][bj][m][0] * 0.0625f, v1 = acc[ai][bj][m][1] * 0.0625f; u32x4 w;
                w.x = __builtin_bit_cast(unsigned, __builtin_amdgcn_cvt_pknorm_i16(v0[0], v0[1])); w.y = __builtin_bit_cast(unsigned, __builtin_amdgcn_cvt_pknorm_i16(v0[2], v0[3]));
                w.z = __builtin_bit_cast(unsigned, __builtin_amdgcn_cvt_pknorm_i16(v1[0], v1[1])); w.w = __builtin_bit_cast(unsigned, __builtin_amdgcn_cvt_pknorm_i16(v1[2], v1[3]));
                *(u32x4*)((short*)S + (size_t)((row + rot) & 255) * 2048 + (u.pn & 7) * 256 + bj * 128 + cb) = w;
#else
                float* p = S + (size_t)((row + rot) & 255) * 1024 + (u.pn & 3) * 256 + bj * 128 + cb; *(f32x4*)p = acc[ai][bj][m][0]; *(f32x4*)(p + 4) = acc[ai][bj][m][1];
#endif
            }
        EPI_ROWS_END
    }
};
struct EpiS {
    static constexpr bool PERM = true;
    float* S;
    __device__ __forceinline__ void operator()(const f32x4 (&acc)[2][2][4][2], const Unit& u, int wr, int wc, int fr, int fq) const {
        const int row0 = wr * 64 + fr, cb = wc * 32 + 8 * fq;
        EPI_ROWS_BEGIN
#pragma unroll
            for (int bj = 0; bj < 2; ++bj) { float* p = S + (size_t)row * 256 + bj * 128 + cb; *(f32x4*)p = acc[ai][bj][m][0]; *(f32x4*)(p + 4) = acc[ai][bj][m][1]; }  EPI_ROWS_END
    }
};

namespace att {
constexpr int KSTR = 400, SHM_K = 64 * KSTR, SHM_V = 16384;
constexpr int OFF_V = 0, OFF_K = 2 * SHM_V, OFF_WS = OFF_K + 2 * SHM_K, OFF_QL = OFF_WS + NWAVES * 256, NQL = 0, ATT_LDS = OFF_QL + NWAVES * NQL * 1024;
#define SBAR() __builtin_amdgcn_sched_barrier(0)
__device__ __forceinline__ int crow(int r, int hi) { return (r & 3) + 8 * (r >> 2) + 4 * hi; }
__device__ __forceinline__ int v_st(int k, int c) { const int kk = (k & ~0xC) | ((k & 4) << 1) | ((k & 8) >> 1); return ((kk >> 3) * 4 + (c >> 5)) * 512 + ((kk & 7) * 32 + (c & 31)) * 2; }
__device__ __forceinline__ int v_rd_base(int lane) { return ((lane & 3) << 3) | (((lane >> 2) & 3) << 6) | (((lane >> 4) & 1) << 5) | (((lane >> 5) & 1) << 8); }
constexpr int v_rd_off(int d0, int ks, int half) { return d0 * 512 + ks * 4096 + half * 2048; }
template <int OFF> __device__ __forceinline__ s16x4 tr_read(int vb) { s16x4 r; asm volatile("ds_read_b64_tr_b16 %0, %1 offset:%2" : "=&v"(r) : "v"(vb), "i"(OFF) : "memory"); return r; }
template <int D0> __device__ __forceinline__ void pv_one(f32x16& od, int vb, bf16x8 pa0, bf16x8 pa1, bf16x8 pa2, bf16x8 pa3) {
    const s16x4 l0 = tr_read<v_rd_off(D0, 0, 0)>(vb), h0 = tr_read<v_rd_off(D0, 0, 1)>(vb), l1 = tr_read<v_rd_off(D0, 1, 0)>(vb), h1 = tr_read<v_rd_off(D0, 1, 1)>(vb);
    const s16x4 l2 = tr_read<v_rd_off(D0, 2, 0)>(vb), h2 = tr_read<v_rd_off(D0, 2, 1)>(vb), l3 = tr_read<v_rd_off(D0, 3, 0)>(vb), h3 = tr_read<v_rd_off(D0, 3, 1)>(vb);
    asm volatile("s_waitcnt lgkmcnt(0)" ::: "memory"); SBAR();
#define PK(L, H) (bf16x8){L[0], L[1], L[2], L[3], H[0], H[1], H[2], H[3]}
    od = __builtin_amdgcn_mfma_f32_32x32x16_bf16(pa0, PK(l0, h0), od, 0, 0, 0);
    od = __builtin_amdgcn_mfma_f32_32x32x16_bf16(pa1, PK(l1, h1), od, 0, 0, 0);
    od = __builtin_amdgcn_mfma_f32_32x32x16_bf16(pa2, PK(l2, h2), od, 0, 0, 0);
    od = __builtin_amdgcn_mfma_f32_32x32x16_bf16(pa3, PK(l3, h3), od, 0, 0, 0);
#undef PK
}
__device__ __forceinline__ void pv_d0(f32x16* o, int vb, bf16x8 pa0, bf16x8 pa1, bf16x8 pa2, bf16x8 pa3) {
    pv_one<0>(o[0], vb, pa0, pa1, pa2, pa3); pv_one<1>(o[1], vb, pa0, pa1, pa2, pa3); pv_one<2>(o[2], vb, pa0, pa1, pa2, pa3); pv_one<3>(o[3], vb, pa0, pa1, pa2, pa3);
}
constexpr float THR = 8.0f;
__device__ __forceinline__ void partialSM(f32x16& p0, f32x16& p1, float& m_reg, float& mn, float& alpha) {
    float pmax = p0[0];
#pragma unroll
    for (int r = 1; r < 16; ++r) pmax = fmaxf(pmax, p0[r]);
#pragma unroll
    for (int r = 0; r < 16; ++r) pmax = fmaxf(pmax, p1[r]);
    { auto rr = __builtin_amdgcn_permlane32_swap(__float_as_uint(pmax), __float_as_uint(pmax), false, false); pmax = fmaxf(__uint_as_float(rr[0]), __uint_as_float(rr[1])); }
    if (__builtin_expect(__all(pmax - m_reg <= THR), 1)) { mn = m_reg; alpha = 1.f; }
    else { mn = fmaxf(m_reg, pmax); alpha = __builtin_amdgcn_exp2f(m_reg - mn); m_reg = mn; }
#pragma unroll
    for (int r = 0; r < 16; ++r) { p0[r] -= mn; p1[r] -= mn; }
#pragma unroll
    for (int r = 0; r < 16; ++r) p0[r] = __builtin_amdgcn_exp2f(p0[r]);
}
__device__ __forceinline__ void finishSM(f32x16& p0, f32x16& p1, float alpha, float& l_reg, bf16x8& pa0, bf16x8& pa1, bf16x8& pa2, bf16x8& pa3) {
#pragma unroll
    for (int r = 0; r < 16; ++r) p1[r] = __builtin_amdgcn_exp2f(p1[r]);
    float ps = 0;
#pragma unroll
    for (int r = 0; r < 16; ++r) ps += p0[r];
#pragma unroll
    for (int r = 0; r < 16; ++r) ps += p1[r];
    { auto rr = __builtin_amdgcn_permlane32_swap(__float_as_uint(ps), __float_as_uint(ps), false, false); ps = __uint_as_float(rr[0]) + __uint_as_float(rr[1]); }
    l_reg = l_reg * alpha + ps;
#define PK4(P, BASE, OUT) do { unsigned a0 = cvtpk(P[BASE + 0], P[BASE + 1]), a1 = cvtpk(P[BASE + 2], P[BASE + 3]);   \
    unsigned b0 = cvtpk(P[BASE + 4], P[BASE + 5]), b1 = cvtpk(P[BASE + 6], P[BASE + 7]);                              \
    auto r0 = __builtin_amdgcn_permlane32_swap(a0, b0, false, false); auto r1 = __builtin_amdgcn_permlane32_swap(a1, b1, false, false); \
    u32x4 w = {r0[0], r1[0], r0[1], r1[1]}; OUT = *reinterpret_cast<bf16x8*>(&w); } while (0)
    PK4(p0, 0, pa0); PK4(p0, 8, pa1); PK4(p1, 0, pa2); PK4(p1, 8, pa3);
#undef PK4
}
__device__ __forceinline__ void qkt(f32x16& p0, f32x16& p1, const char* Ks, const bf16x8* qr, const char* ql, int r32, int hi) {
    p0 = f32x16{}; p1 = f32x16{};
#pragma unroll
    for (int d0 = 0; d0 < 12; ++d0) { const int cbb = (d0 * 16 + hi * 8) * 2;
        const bf16x8 b0 = *reinterpret_cast<const bf16x8*>(Ks + r32 * KSTR + cbb);
        const bf16x8 b1 = *reinterpret_cast<const bf16x8*>(Ks + (32 + r32) * KSTR + cbb);
        const bf16x8 qf = (d0 < 12 - NQL) ? qr[d0] : *reinterpret_cast<const bf16x8*>(ql + (d0 - (12 - NQL)) * 1024);
        p0 = __builtin_amdgcn_mfma_f32_32x32x16_bf16(b0, qf, p0, 0, 0, 0);
        p1 = __builtin_amdgcn_mfma_f32_32x32x16_bf16(b1, qf, p1, 0, 0, 0);
        if ((d0 & 3) == 3) SBAR(); }
}
__device__ __forceinline__ void attn_unit(const bf16_t* __restrict__ Qg, const bf16_t* __restrict__ Kb, bf16_t* __restrict__ Og, int token0, int h, char* lds) {
    const int tid = threadIdx.x, wid = tid >> 6, lane = tid & 63, r32 = lane & 31, hi = lane >> 5;
    char* V_lds = lds + OFF_V; char* K_lds = lds + OFF_K;
    float* ws = (float*)(lds + OFF_WS) + wid * 64; float* li_l = ws; float* al_l = ws + 32;
    float m_reg = -1e30f, l_reg = 0; f32x16 o[4] = {}; bf16x8 qr[12 - NQL];
    const bf16_t* Qw = Qg + (size_t)(token0 + wid * 32 + r32) * QW + h * DQK + hi * 8;
    char* ql = lds + OFF_QL + wid * (NQL * 1024) + lane * 16;
#pragma unroll
    for (int d0 = 0; d0 < 12 - NQL; ++d0) qr[d0] = *reinterpret_cast<const bf16x8*>(Qw + d0 * 16);
#pragma unroll
    for (int d0 = 12 - NQL; d0 < 12; ++d0) *reinterpret_cast<bf16x8*>(ql + (d0 - (12 - NQL)) * 1024) = *reinterpret_cast<const bf16x8*>(Qw + d0 * 16);
    const int vb0 = (int)(uintptr_t)V_lds + v_rd_base(lane);
    bf16x8 sA[3];
#define SLOAD(S_, t_) do { int td_ = tid; asm volatile("" : "+v"(td_)); const bf16_t* tb_ = Kb + (size_t)(t_) * 64 * DQK + (td_ >> 3) * DQK + (td_ & 7) * 8; _Pragma("unroll") for (int i = 0; i < 3; ++i) S_[i] = *reinterpret_cast<const bf16x8*>(tb_ + i * 64); } while (0)
#define SWRITE(b_, S_) do { int td_ = tid; asm volatile("" : "+v"(td_)); const int kst = (td_ >> 3) * KSTR + (td_ & 7) * 16, vst = v_st(td_ >> 3, (td_ & 7) * 8); \
    _Pragma("unroll") for (int i = 0; i < 3; ++i) { *(bf16x8*)(K_lds + (b_) * SHM_K + kst + i * 128) = S_[i]; if (i < 2) *(bf16x8*)(V_lds + (b_) * SHM_V + vst + i * 1024) = S_[i]; } } while (0)
#define SWAIT() asm volatile("s_waitcnt vmcnt(0)" ::: "memory")
#define RESC(a) do { if (__any((a) < 1.f)) { if (hi == 0) al_l[r32] = (a); asm volatile("s_waitcnt lgkmcnt(0)" ::: "memory"); \
    _Pragma("unroll") for (int d = 0; d < 4; ++d) _Pragma("unroll") for (int r = 0; r < 16; ++r) o[d][r] *= al_l[crow(r, hi)]; } } while (0)
    f32x16 pA0, pA1, pB0, pB1; float mnA, mnB, alA, alB; bf16x8 pa0, pa1, pa2, pa3; constexpr int NT = NKEY / 64;
    SLOAD(sA, 0); asm volatile("s_waitcnt vmcnt(0)" ::: "memory"); SWRITE(0, sA); __syncthreads();
    qkt(pA0, pA1, K_lds, qr, ql, r32, hi); partialSM(pA0, pA1, m_reg, mnA, alA);
    SLOAD(sA, 1);
    SWAIT(); SWRITE(1, sA); __syncthreads();
    for (int j = 1; j + 1 < NT; j += 2) {
        SBAR(); qkt(pB0, pB1, K_lds + SHM_K, qr, ql, r32, hi);
        finishSM(pA0, pA1, alA, l_reg, pa0, pa1, pa2, pa3); SBAR();
        SLOAD(sA, j + 1); SBAR();
        pv_d0(o, vb0, pa0, pa1, pa2, pa3); partialSM(pB0, pB1, m_reg, mnB, alB);
        __syncthreads(); SWAIT(); SWRITE(0, sA);
        RESC(alB); __syncthreads();
        SBAR(); qkt(pA0, pA1, K_lds, qr, ql, r32, hi);
        finishSM(pB0, pB1, alB, l_reg, pa0, pa1, pa2, pa3); SBAR();
        SLOAD(sA, j + 2); SBAR();
        pv_d0(o, vb0 + SHM_V, pa0, pa1, pa2, pa3); partialSM(pA0, pA1, m_reg, mnA, alA);
        __syncthreads(); SWAIT(); SWRITE(1, sA);
        RESC(alA); __syncthreads();
    }
    SBAR(); qkt(pB0, pB1, K_lds + SHM_K, qr, ql, r32, hi);
    finishSM(pA0, pA1, alA, l_reg, pa0, pa1, pa2, pa3); SBAR();
    pv_d0(o, vb0, pa0, pa1, pa2, pa3); partialSM(pB0, pB1, m_reg, mnB, alB);
    __syncthreads(); RESC(alB);
    finishSM(pB0, pB1, alB, l_reg, pa0, pa1, pa2, pa3); SBAR();
    pv_d0(o, vb0 + SHM_V, pa0, pa1, pa2, pa3);
    if (hi == 0) li_l[r32] = l_reg; asm volatile("s_waitcnt lgkmcnt(0)" ::: "memory");
    float rli[16];
#pragma unroll
    for (int r = 0; r < 16; ++r) rli[r] = __builtin_amdgcn_rcpf(li_l[crow(r, hi)]);
    __syncthreads();
    int le = lane; asm volatile("" : "+v"(le));
    const int r32e = le & 31, hie = le >> 5;
    bf16_t* stg = (bf16_t*)(lds + wid * 8192) + (hie * 4) * 128 + r32e;
#pragma unroll
    for (int r = 0; r < 16; ++r) { const int orow = (r & 3) + 8 * (r >> 2);
#pragma unroll
        for (int d0 = 0; d0 < 4; ++d0) stg[orow * 128 + d0 * 32] = (bf16_t)(cvtpk(o[d0][r] * rli[r], 0.f) & 0xffffu); }
    asm volatile("s_waitcnt lgkmcnt(0)" ::: "memory");
    const bf16_t* stg2 = (const bf16_t*)(lds + wid * 8192) + (le >> 4) * 128 + (le & 15) * 8;
    bf16_t* Ow = Og + (size_t)(token0 + wid * 32 + (le >> 4)) * 1024 + h * 128 + (le & 15) * 8;
#pragma unroll
    for (int i = 0; i < 8; ++i) { const u32x4 v = *(const u32x4*)(stg2 + i * 4 * 128); *(u32x4*)(Ow + (size_t)i * 4 * 1024) = v; }
    __syncthreads();
#undef SLOAD
#undef SWRITE
#undef SWAIT
#undef RESC
}
#undef SBAR
}


#define XB_TMO      128
#define XB_XCNT(j)  (256  + 64 * (j))
#define XB_XSUB(j)  (1280 + 64 * (j))
#define XB_XGEN(j)  (2304 + 64 * (j))
#define XB_TOP      3328
#define XB_TOPGEN   3392
#define XCD_BAR_WORDS 3456
#define XB_SPIN_CAP (1u << 18)
__device__ __forceinline__ unsigned xb_ld(unsigned* p)              { return __hip_atomic_load(p, __ATOMIC_RELAXED, __HIP_MEMORY_SCOPE_AGENT); }
__device__ __forceinline__ unsigned xb_add(unsigned* p, unsigned v) { return __hip_atomic_fetch_add(p, v, __ATOMIC_RELAXED, __HIP_MEMORY_SCOPE_AGENT); }
__device__ __forceinline__ unsigned xb_xcc_id() { return (unsigned)__builtin_amdgcn_s_getreg((3 << 11) | 20) & 0xFu; }
#define XB_SPIN(cond, bar) do { unsigned _sp = 0; while (cond) { __builtin_amdgcn_s_sleep(1); \
    if ((++_sp & 255u) == 0u) { if (xb_ld(&(bar)[XB_TMO])) break; if (_sp > XB_SPIN_CAP) { atomicAdd(&(bar)[XB_TMO], 1u); break; } } } } while (0)
struct XcdBarrier { unsigned* bar; unsigned x; volatile LAS unsigned* st; };
__device__ __forceinline__ XcdBarrier xcd_barrier_post(unsigned* bar, volatile LAS unsigned* st) {
    XcdBarrier b; b.bar = bar; b.x = xb_xcc_id(); b.st = st;
    if (threadIdx.x == 0) (void)xb_add(&bar[XB_XCNT(b.x)], 1u);
    return b;
}
__device__ __forceinline__ void xcd_barrier_complete(unsigned* bar, unsigned x, unsigned& nloc, unsigned& nx) {
    const unsigned G = gridDim.x * gridDim.y * gridDim.z;
    unsigned sum, cnt, mine, sp = 0u;
    for (;;) {
        sum = 0u; cnt = 0u; mine = 0u;
#pragma unroll
        for (unsigned j = 0; j < 16; ++j) { const unsigned c = xb_ld(&bar[XB_XCNT(j)]); sum += c; cnt += (c > 0u) ? 1u : 0u; mine = (j == x) ? c : mine; }
        if (sum == G) break;
        __builtin_amdgcn_s_sleep(1);
        if ((++sp & 255u) == 0u) { if (xb_ld(&bar[XB_TMO])) break; if (sp > XB_SPIN_CAP) { atomicAdd(&bar[XB_TMO], 1u); break; } }
    }
    nloc = mine > 0u ? mine : 1u; nx = cnt > 0u ? cnt : 1u;
}
__device__ __forceinline__ void xcd_barrier(const XcdBarrier& b) {
    asm volatile("s_waitcnt vmcnt(0)" ::: "memory");
    __syncthreads();
    if (threadIdx.x == 0) {
        unsigned* bar = b.bar;
        __builtin_amdgcn_s_waitcnt(0);
        unsigned nloc = b.st[0], nx = b.st[1];
        if (nloc == 0u) { xcd_barrier_complete(bar, b.x, nloc, nx); b.st[0] = nloc; b.st[1] = nx; }
        const unsigned old = xb_add(&bar[XB_XSUB(b.x)], 1u);
        const unsigned gen = old / nloc;
        if (old + 1u == (gen + 1u) * nloc) {
            __builtin_amdgcn_fence(__ATOMIC_RELEASE, "agent");
            asm volatile("s_waitcnt vmcnt(0)" ::: "memory");
            const unsigned og = xb_add(&bar[XB_TOP], 1u);
            const unsigned tg = og / nx;
            if (og + 1u == (tg + 1u) * nx) xb_add(&bar[XB_TOPGEN], 1u);
            else XB_SPIN(xb_ld(&bar[XB_TOPGEN]) == tg, bar);
            __builtin_amdgcn_fence(__ATOMIC_ACQUIRE, "agent");
            xb_add(&bar[XB_XGEN(b.x)], 1u);
            asm volatile("s_waitcnt vmcnt(0)" ::: "memory");
        } else {
            XB_SPIN(xb_ld(&bar[XB_XGEN(b.x)]) == gen, bar);
            __builtin_amdgcn_fence(__ATOMIC_ACQUIRE, "agent");
            asm volatile("s_waitcnt vmcnt(0)" ::: "memory");
        }
    }
    __syncthreads();
}


__device__ __forceinline__ float modv(const float* MODP, const float* b_ada, int r, int col) {
    const float* p = MODP + (size_t)r * 6144 + col; constexpr size_t KS = (size_t)33 * 6144;
    return ((p[0] + p[KS]) + (p[2 * KS] + p[3 * KS])) + b_ada[col];
}

struct Args { const float* in[22]; float* out; unsigned char* ws; int ph_lo, ph_hi; };

template <class RowMap>
__device__ __forceinline__ void transpose_item(const float* __restrict__ W, int K, int N, bf16_t* __restrict__ WT, LAS float* scr, int item, int lane, const RowMap& rowmap) {
    const int nblk = N / 32, kb = item / nblk, nb = item % nblk, k0 = 64 * kb, n0 = 32 * nb;
#pragma unroll 8
    for (int i = 0; i < 32; ++i) { const int kk = 2 * i + (lane >> 5); scr[kk * 33 + (lane & 31)] = W[(size_t)(k0 + kk) * N + n0 + (lane & 31)]; }
    asm volatile("s_waitcnt lgkmcnt(0)" ::: "memory");
    const int c = lane & 7;
#pragma unroll
    for (int j = 0; j < 4; ++j) { const int n = (lane >> 3) + 8 * j; const LAS float* s = scr + (8 * c) * 33 + n;
        u32x4 o; o.x = cvtpk(s[0 * 33], s[1 * 33]); o.y = cvtpk(s[2 * 33], s[3 * 33]); o.z = cvtpk(s[4 * 33], s[5 * 33]); o.w = cvtpk(s[6 * 33], s[7 * 33]);
        *(u32x4*)(WT + (size_t)rowmap(n0 + n) * K + k0 + 8 * c) = o; }
    asm volatile("s_waitcnt lgkmcnt(0)" ::: "memory");
}
struct MapIn { __device__ __forceinline__ int operator()(int n) const {
    if (n < 128) return 256 + n;
    if (n < 192) { const int s = n - 128, axis = s >> 5, e = (s >> 4) & 1, f = s & 15; return 384 + 2 * (axis * 16 + f) + e; }
    if (n < 448) return n - 192;
    if (n < 1472) return 512 + (n - 448);
    return 1536 + (n - 1472); } };
struct MapId { __device__ __forceinline__ int operator()(int n) const { return n; } };

__device__ __forceinline__ unsigned f2key(float f) { const unsigned u = __float_as_uint(f); return (u & 0x80000000u) ? ~u : (u | 0x80000000u); }
__device__ __forceinline__ float key2f(unsigned k) { const unsigned u = (k & 0x80000000u) ? (k & 0x7fffffffu) : ~k; return __uint_as_float(u); }

template <int CTRL> __device__ __forceinline__ unsigned dpp_u(unsigned v) { return (unsigned)__builtin_amdgcn_update_dpp(0, (int)v, CTRL, 0xF, 0xF, true); }
template <int CTRL> __device__ __forceinline__ float dpp_f(float v) { return __uint_as_float((unsigned)__builtin_amdgcn_update_dpp(0, (int)__float_as_uint(v), CTRL, 0xF, 0xF, true)); }
#define ROW_MAXU(m) do { m = max(m, dpp_u<0x128>(m)); m = max(m, dpp_u<0x124>(m)); m = max(m, dpp_u<0x122>(m)); m = max(m, dpp_u<0x121>(m)); } while (0)
#define CE_DESC(a, b) do { const unsigned hi_ = max(a, b), lo_ = min(a, b); a = hi_; b = lo_; } while (0)
template <int NC, bool I16 = false>
__device__ __forceinline__ void top16_of_128(const f32x4 (&sa)[NC], const f32x4 (&sb)[NC], int i16, unsigned (&mine)[NC]) {
    unsigned k[NC][8];
#pragma unroll
    for (int c = 0; c < NC; ++c) {
#pragma unroll
        for (int e = 0; e < 4; ++e) {
            if (I16) {
                const unsigned wa = __float_as_uint(sa[c][e >> 1]), wb = __float_as_uint(sb[c][e >> 1]);
                const unsigned ha = ((e & 1) ? (wa >> 16) : (wa & 0xffffu)) ^ 0x8000u, hb = ((e & 1) ? (wb >> 16) : (wb & 0xffffu)) ^ 0x8000u;
                k[c][e] = (ha << 16) | (unsigned)(127 - (4 * i16 + e)); k[c][4 + e] = (hb << 16) | (unsigned)(127 - (64 + 4 * i16 + e));
            } else { k[c][e] = (f2key(sa[c][e]) & ~0x7Fu) | (unsigned)(127 - (4 * i16 + e)); k[c][4 + e] = (f2key(sb[c][e]) & ~0x7Fu) | (unsigned)(127 - (64 + 4 * i16 + e)); } }
        CE_DESC(k[c][0], k[c][1]); CE_DESC(k[c][2], k[c][3]); CE_DESC(k[c][4], k[c][5]); CE_DESC(k[c][6], k[c][7]);
        CE_DESC(k[c][0], k[c][2]); CE_DESC(k[c][1], k[c][3]); CE_DESC(k[c][4], k[c][6]); CE_DESC(k[c][5], k[c][7]);
        CE_DESC(k[c][1], k[c][2]); CE_DESC(k[c][5], k[c][6]);
        CE_DESC(k[c][0], k[c][4]); CE_DESC(k[c][1], k[c][5]); CE_DESC(k[c][2], k[c][6]); CE_DESC(k[c][3], k[c][7]);
        CE_DESC(k[c][2], k[c][4]); CE_DESC(k[c][3], k[c][5]);
        CE_DESC(k[c][1], k[c][2]); CE_DESC(k[c][3], k[c][4]); CE_DESC(k[c][5], k[c][6]);
        mine[c] = 0u; }
#pragma unroll
    for (int it = 0; it < 16; ++it) {
        unsigned m[NC];
#pragma unroll
        for (int c = 0; c < NC; ++c) m[c] = max(k[c][0], dpp_u<0x128>(k[c][0]));
#pragma unroll
        for (int c = 0; c < NC; ++c) m[c] = max(m[c], dpp_u<0x124>(m[c]));
#pragma unroll
        for (int c = 0; c < NC; ++c) m[c] = max(m[c], dpp_u<0x122>(m[c]));
#pragma unroll
        for (int c = 0; c < NC; ++c) m[c] = max(m[c], dpp_u<0x121>(m[c]));
#pragma unroll
        for (int c = 0; c < NC; ++c) { const bool tk = (k[c][0] == m[c]);
#pragma unroll
            for (int e = 0; e < 7; ++e) k[c][e] = tk ? k[c][e + 1] : k[c][e];
            k[c][7] = tk ? 0u : k[c][7];
            mine[c] = (i16 == it) ? m[c] : mine[c]; }
    }
}
__device__ __forceinline__ void topk_head(const f32x4 sc, int lane, int ca, int cb, int& expert, float& gate) {
    const int j = lane & 31;
    unsigned k0 = (f2key(sc[0]) & ~0x7Fu) | (unsigned)(127 - (4 * j + 0)), k1 = (f2key(sc[1]) & ~0x7Fu) | (unsigned)(127 - (4 * j + 1));
    unsigned k2 = (f2key(sc[2]) & ~0x7Fu) | (unsigned)(127 - (4 * j + 2)), k3 = (f2key(sc[3]) & ~0x7Fu) | (unsigned)(127 - (4 * j + 3));
    unsigned mine = 0u;
#pragma unroll 1
    for (int it = 0; it < 16; ++it) {
        unsigned mx = max(max(k0, k1), max(k2, k3));
#pragma unroll
        for (int o = 1; o < 32; o <<= 1) mx = max(mx, (unsigned)__shfl_xor((int)mx, o));
        if (j == it) mine = mx;
        k0 = (k0 == mx) ? 0u : k0; k1 = (k1 == mx) ? 0u : k1; k2 = (k2 == mx) ? 0u : k2; k3 = (k3 == mx) ? 0u : k3;
    }
    const float val = key2f(mine & ~0x7Fu); const int kid = 127 - (int)(mine & 0x7Fu);
    const float s0 = __shfl(val, ca), s1 = __shfl(val, 32 + cb);
    const int i0 = __shfl(kid, ca), i1 = __shfl(kid, 32 + cb);
    const int myexp = i0 * 128 + i1;
    unsigned ck = (lane < 50) ? ((f2key(s0 + s1) & ~0x3Fu) | (unsigned)(63 - lane)) : 0u;
    unsigned best = 0u;
#pragma unroll 1
    for (int it = 0; it < 16; ++it) {
        unsigned mx = ck;
#pragma unroll
        for (int o = 1; o < 64; o <<= 1) mx = max(mx, (unsigned)__shfl_xor((int)mx, o));
        if (lane == it) best = mx;
        ck = (ck == mx) ? 0u : ck;
    }
    const float bv = key2f(best & ~0x3Fu); const int bc = 63 - (int)(best & 0x3Fu);
    expert = __shfl(myexp, bc);
    const float top = __shfl(bv, 0);
    float ex = (lane < 16) ? __builtin_amdgcn_exp2f((bv - top) * 1.4426950408889634f) : 0.f;
    float sum = ex;
#pragma unroll
    for (int o = 1; o < 16; o <<= 1) sum += __shfl_xor(sum, o);
    gate = ex / sum;
}


template <bool ISV>
__device__ __forceinline__ void gather_wave(int p, int first, int stride, int T, int ln, const unsigned char* tabu, int bp_base, const unsigned* HW, const bf16_t* HF, float* PART, bf16_t* PEERO, float* SSQP) {
    constexpr bool isv = ISV; const int lg = ln >> 3, lc = ln & 7; const unsigned lc16 = (unsigned)lc * 16u;
#define TOKEN(k_) ((size_t)first + (size_t)(((k_) < T ? (k_) : T - 1)) * stride)
#define PERM8(W, H_, o_) do { _Pragma("unroll") for (int j_ = 0; j_ < 8; ++j_) W[j_] = (unsigned)__builtin_amdgcn_ds_bpermute(bp_base + 32 * j_, (int)(H_)); } while (0)
#define LOAD8(B, W) do { _Pragma("unroll") for (int j_ = 0; j_ < 8; ++j_) B[j_] = *(const u32x4*)(tab + (size_t)(W[j_] & 0x3FFFu) * 128); } while (0)
#define SBX() __builtin_amdgcn_sched_barrier(0)
            if (T > 0) {
                u32x4 bA[16], bB[16]; unsigned wA[16], wB[16];
#define PERM16(W, HA_, HB_) do { _Pragma("unroll") for (int j_ = 0; j_ < 16; ++j_) W[j_] = (unsigned)__builtin_amdgcn_ds_bpermute(bp_base + 32 * (j_ & 7), (int)((j_ < 8) ? (HA_) : (HB_))); } while (0)
#define LOAD16(B, W) do { _Pragma("unroll") for (int j_ = 0; j_ < 16; ++j_) B[j_] = *(const u32x4*)(tabu + (((W[j_] & 0x3FFFu) << 7) | lc16)); } while (0)
#define HDR(k_, HA_, HB_) do { const size_t t_ = TOKEN(k_); HA_ = HW[t_ * 128 + ln]; HB_ = HW[t_ * 128 + 64 + ln]; } while (0)
#if PEER_I8
#define XLD(k_, X0, X1) do { if (!isv) { X0 = *(const u32x4*)((const unsigned char*)HF + TOKEN(k_) * DM + p * 128 + lc * 16); } } while (0)
#else
#define XLD(k_, X0, X1) do { if (!isv) { const bf16_t* xp_ = HF + TOKEN(k_) * DM + p * 128 + lc * 16; X0 = *(const u32x4*)xp_; X1 = *(const u32x4*)(xp_ + 8); } } while (0)
#endif
#define CONSUME(B, W, X0, X1, k_) do { const size_t tk = TOKEN(k_); float RA = 0.f, RB = 0.f; int IA = 0, IB = 0; f32x2 acc[8]; \
        const unsigned xw[8] = {X0.x, X0.y, X0.z, X0.w, X1.x, X1.y, X1.z, X1.w};     \
        _Pragma("unroll") for (int i = 0; i < 8; ++i) acc[i] = (f32x2){0.f, 0.f}; \
        _Pragma("unroll") for (int j = 0; j < 16; ++j) { \
            if (!isv && PEER_I8) { int e_ = 0;     \
                _Pragma("unroll") for (int q = 0; q < 4; ++q) e_ = __builtin_amdgcn_sdot4((int)B[j][q], (int)xw[q], e_, false); \
                unsigned du = (unsigned)e_; du += dpp_u<0xB1>(du); du += dpp_u<0x4E>(du); du += dpp_u<0x141>(du); \
                if (j < 8) IA = (lc == (j & 7)) ? (int)du : IA; else IB = (lc == (j & 7)) ? (int)du : IB; } \
            else if (!isv) { float e0 = 0.f, e1 = 0.f; \
                _Pragma("unroll") for (int q = 0; q < 4; ++q) { const bf16x2_t lo = __builtin_amdgcn_cvt_scalef32_pk_bf16_fp8(B[j][q], 1.0f, false), hi = __builtin_amdgcn_cvt_scalef32_pk_bf16_fp8(B[j][q], 1.0f, true); \
                    e0 = __builtin_amdgcn_fdot2_f32_bf16(lo, __builtin_bit_cast(bf16x2_t, xw[2 * q]), e0, false); e1 = __builtin_amdgcn_fdot2_f32_bf16(hi, __builtin_bit_cast(bf16x2_t, xw[2 * q + 1]), e1, false); } \
                float d = e0 + e1; d += dpp_f<0xB1>(d); d += dpp_f<0x4E>(d); d += dpp_f<0x141>(d); \
                if (j < 8) RA = (lc == (j & 7)) ? d : RA; else RB = (lc == (j & 7)) ? d : RB; } \
            else { const float a1_ = __uint_as_float(W[j] & 0xffff0000u); const f32x2 a_ = (f32x2){a1_, a1_}; \
                _Pragma("unroll") for (int q = 0; q < 4; ++q) { const f32x2 lo = __builtin_amdgcn_cvt_pk_f32_fp8((int)B[j][q], false), hi = __builtin_amdgcn_cvt_pk_f32_fp8((int)B[j][q], true); \
                    acc[2 * q] = __builtin_elementwise_fma(a_, lo, acc[2 * q]); acc[2 * q + 1] = __builtin_elementwise_fma(a_, hi, acc[2 * q + 1]); } } } \
        if (!isv) { if (PEER_I8) { RA = (float)IA; RB = (float)IB; } bf16_t* po = (bf16_t*)PART + ((size_t)p * TL + tk) * 128 + 8 * lc + lg; po[0] = (bf16_t)(cvtpk(RA, 0.f) & 0xffffu); po[64] = (bf16_t)(cvtpk(RB, 0.f) & 0xffffu); }     \
        else { float ss = 0.f; float ac[16]; \
            _Pragma("unroll") for (int i = 0; i < 16; ++i) { float t = acc[i >> 1][i & 1]; t += dpp_f<0x128>(t); \
                { auto r_ = __builtin_amdgcn_permlane16_swap(__float_as_uint(t), __float_as_uint(t), false, false); t = __uint_as_float(r_[0]) + __uint_as_float(r_[1]); } \
                { auto r_ = __builtin_amdgcn_permlane32_swap(__float_as_uint(t), __float_as_uint(t), false, false); t = __uint_as_float(r_[0]) + __uint_as_float(r_[1]); } \
                ac[i] = t; ss += t * t; } \
            ss += dpp_f<0xB1>(ss); ss += dpp_f<0x4E>(ss); ss += dpp_f<0x141>(ss); \
            if (lg == 0) { u32x4 o0, o1; o0.x = cvtpk(ac[0], ac[1]); o0.y = cvtpk(ac[2], ac[3]); o0.z = cvtpk(ac[4], ac[5]); o0.w = cvtpk(ac[6], ac[7]); \
                o1.x = cvtpk(ac[8], ac[9]); o1.y = cvtpk(ac[10], ac[11]); o1.z = cvtpk(ac[12], ac[13]); o1.w = cvtpk(ac[14], ac[15]); \
                bf16_t* po = PEERO + tk * DM + p * 128 + lc * 16; *(u32x4*)po = o0; *(u32x4*)(po + 8) = o1; } \
            if (ln == 0) SSQP[(size_t)p * TL + tk] = ss; } } while (0)
                unsigned hA, hB, gA, gB; u32x4 xa0 = (u32x4){0u, 0u, 0u, 0u}, xa1 = xa0, xb0 = xa0, xb1 = xa0;
                HDR(0, hA, hB); HDR(1, gA, gB); XLD(0, xa0, xa1);
                PERM16(wA, hA, hB); LOAD16(bA, wA);
#pragma unroll 1
                for (int k = 0; k < T; k += 2) {
                    PERM16(wB, gA, gB); LOAD16(bB, wB); XLD(k + 1, xb0, xb1); HDR(k + 2, hA, hB); SBX();
                    CONSUME(bA, wA, xa0, xa1, k); SBX();
                    PERM16(wA, hA, hB); LOAD16(bA, wA); XLD(k + 2, xa0, xa1); HDR(k + 3, gA, gB); SBX();
                    CONSUME(bB, wB, xb0, xb1, k + 1); SBX();
                }
#undef PERM16
#undef LOAD16
#undef HDR
#undef XLD
#undef CONSUME
            }
#undef TOKEN
#undef PERM8
#undef LOAD8
#undef SBX
}
#ifndef SKIP_TOPK
#define SKIP_TOPK 0
#endif
#ifndef PROBE_PT
#define PROBE_PT 0
#endif
#ifndef PROBE_DIV
#define PROBE_DIV 1000
#endif
#ifndef PROBE_BASE
#define PROBE_BASE 190000
#endif
#ifndef PROBE_MODE
#define PROBE_MODE 0
#endif
#define PROBE(k) do { if (PROBE_PT == (k) && threadIdx.x == 0) { const unsigned tk_ = (unsigned)(__builtin_amdgcn_s_memrealtime() - probe_t0); \
        if (PROBE_MODE == 0) { if (blockIdx.x == 0) probe_val = ((float)tk_ - (float)PROBE_BASE) * (1.0f / PROBE_DIV); } \
        else atomicMax((unsigned*)args.ws + 8192, PROBE_MODE == 1 ? tk_ : 0xFFFFFFFFu - tk_); } } while (0)
#define DECL_PTRS \
    unsigned char* ws = args.ws; \
    const float* x = args.in[0]; const float* cvec = args.in[1]; const float* ctx = args.in[2]; const float* c_ctx = args.in[3]; \
    const float* w_ada = args.in[4]; const float* b_ada = args.in[5]; const float* g_mix_pre = args.in[6]; const float* g_mix_post = args.in[7]; \
    const float* g_ffn_pre = args.in[8]; const float* g_ffn_post = args.in[9]; const float* w_in = args.in[10]; const float* g_q_lora = args.in[11]; \
    const float* w_uq = args.in[12]; const float* g_kv_lora = args.in[13]; const float* w_ukv = args.in[14]; const float* w_pool = args.in[15]; \
    const float* pool_scale = args.in[16]; const float* w_out = args.in[17]; const float* peer_wq = args.in[18]; const float* peer_keys = args.in[19]; \
    const float* peer_u = args.in[20]; const float* peer_v = args.in[21]; \
    float* out = args.out; \
    float* MOD = (float*)(ws + WS_MODP); float* TAB = (float*)(ws + WS_ROPE); float* SSQCQ = (float*)(ws + WS_SSQCQ); float* SSQY = (float*)(ws + WS_SSQY); \
    bf16_t* WIN = (bf16_t*)(ws + WS_WIN); bf16_t* WQ = (bf16_t*)(ws + WS_WQ); bf16_t* WUV = (bf16_t*)(ws + WS_WUV); bf16_t* WPOOL = (bf16_t*)(ws + WS_WPOOL); \
    bf16_t* KEYS = (bf16_t*)(ws + WS_KEYS); bf16_t* WOUT = (bf16_t*)(ws + WS_WOUT); bf16_t* WPQ = (bf16_t*)(ws + WS_WPQ); \
    bf16_t* PU = (bf16_t*)(ws + WS_PU); bf16_t* PV = (bf16_t*)(ws + WS_PV); \
    bf16_t* HN = (bf16_t*)(ws + WS_HN); bf16_t* OLAT = HN; bf16_t* MG = HN; bf16_t* HF = HN; \
    bf16_t* CQ = (bf16_t*)(ws + WS_CQ); int* EIDX = (int*)(ws + WS_CQ); \
    float* KVRAW = (float*)(ws + WS_KVRAW); float* EW = (float*)(ws + WS_KVRAW); \
    bf16_t* KF = (bf16_t*)(ws + WS_KF); bf16_t* XP = (bf16_t*)(ws + WS_XP); bf16_t* GT = (bf16_t*)(ws + WS_GT); bf16_t* QP = GT; \
    bf16_t* QB = (bf16_t*)(ws + WS_Q); bf16_t* POOLED = QB; bf16_t* YB = QB; float* SB = (float*)(ws + WS_S);
__global__ void __launch_bounds__(NTHREADS, 2) mk_fwd(Args args) {
    extern __shared__ __attribute__((aligned(16))) unsigned char lds[];
    const int tid = threadIdx.x, lane = tid & 63, wave = __builtin_amdgcn_readfirstlane(tid >> 6);
    const int G = gridDim.x, bx = blockIdx.x, vcu = (G % 8 == 0) ? (bx % 8) * (G / 8) + bx / 8 : bx;
    const int gw = vcu * NWAVES + wave, NGW = G * NWAVES;
    LAS unsigned char* ring = (LAS unsigned char*)lds;
    LAS float* VEC = (LAS float*)(lds + VEC_OFF);
    const int lo = args.ph_lo, hi_ = args.ph_hi;
    volatile LAS unsigned* MISC = (volatile LAS unsigned*)(lds + MISC_OFF);
    if (tid < 16) MISC[tid] = 0u;
    __syncthreads();
    XcdBarrier xbar = xcd_barrier_post((unsigned*)args.ws + 1024, MISC + 8);
    unsigned long long probe_t0 = 0; float probe_val = 0.f; if (PROBE_PT) probe_t0 = __builtin_amdgcn_s_memrealtime();
#ifndef TAIL_MASK
#define TAIL_MASK 255
#endif
#define TM(k) if constexpr ((TAIL_MASK >> (k)) & 1)
#ifndef PH_MASK
#define PH_MASK 1023
#endif
#define IN(k) (((PH_MASK >> (k)) & 1) && lo <= (k) && (k) < hi_)
#define SEAM(k) do { if (IN(k) && IN((k) + 1)) { if ((k) == 0) cg::this_grid().sync(); else xcd_barrier(xbar); } } while (0)


#ifndef DBG_AT
#define DBG_AT 0
#endif
#define DBG_COPY(k, SRC, LD) if (DBG_AT == (k)) { DECL_PTRS for (size_t i = (size_t)gw * 64 + lane; i < (size_t)TL * 1024 / 8; i += (size_t)NGW * 64) { const size_t row = i >> 7, c8 = i & 127; \
        const u32x4 w = *(const u32x4*)((const bf16_t*)(SRC) + row * (LD) + c8 * 8); float* o = out + row * 1024 + c8 * 8; \
        *(f32x4*)o = (f32x4){bf_lo(w.x), bf_hi(w.x), bf_lo(w.y), bf_hi(w.y)}; *(f32x4*)(o + 4) = (f32x4){bf_lo(w.z), bf_hi(w.z), bf_lo(w.w), bf_hi(w.w)}; } }

#ifndef DBG_TAIL
#define DBG_TAIL 0
#endif
#define DBG_TCOPY(k, SRC) if (DBG_TAIL == (k)) { asm volatile("s_waitcnt vmcnt(0)" ::: "memory"); __syncthreads(); for (int i = tid; i < 256 * 128; i += NTHREADS) { const size_t row = (size_t)tok0 + (i >> 7); const int c8 = i & 127; \
        const u32x4 w = *(const u32x4*)((const bf16_t*)(SRC) + row * 1024 + c8 * 8); float* o = out + row * 1024 + c8 * 8; \
        *(f32x4*)o = (f32x4){bf_lo(w.x), bf_hi(w.x), bf_lo(w.y), bf_hi(w.y)}; *(f32x4*)(o + 4) = (f32x4){bf_lo(w.z), bf_hi(w.z), bf_lo(w.w), bf_hi(w.w)}; } continue; }
    if (IN(0)) {
        DECL_PTRS
        LAS float* scr = (LAS float*)(lds + wave * 16384);
        for (int it = gw; it < 192 * 2 * 4; it += NGW) {
            const int ks = it / 384, it2 = it - ks * 384, ct = it2 % 192, rg = it2 / 192, half = lane >> 5, col = ct * 32 + (lane & 31), r0 = rg * 17;
            float acc[17];
#pragma unroll
            for (int j = 0; j < 17; ++j) acc[j] = 0.f;
            for (int kc = ks * 4; kc < ks * 4 + 4; ++kc) {
#pragma unroll
                for (int j = 0; j < 17; ++j) { const int r = min(r0 + j, 32); const float v = (r < 32) ? cvec[(size_t)r * DM + kc * 64 + lane] : c_ctx[kc * 64 + lane];
                    scr[j * 64 + lane] = v / (1.0f + __expf(-v)); }
                asm volatile("s_waitcnt lgkmcnt(0)" ::: "memory");
#pragma unroll 16
                for (int i = 0; i < 32; ++i) { const int kk = 2 * i + half; const float w = w_ada[(size_t)(kc * 64 + kk) * 6144 + col];
#pragma unroll
                    for (int j = 0; j < 17; ++j) acc[j] += scr[j * 64 + kk] * w; }
                asm volatile("s_waitcnt lgkmcnt(0)" ::: "memory");
            }
#pragma unroll
            for (int j = 0; j < 17; ++j) { acc[j] += __shfl_xor(acc[j], 32); if (half == 0 && r0 + j < 33) MOD[((size_t)ks * 33 + r0 + j) * 6144 + col] = acc[j]; }
        }
        for (int i = gw * 64 + lane; i < 64 * 16; i += NGW * 64) { const int v = i >> 4, f = i & 15; const float inv = powf(10000.0f, -(float)f / 16.0f), ang = (float)v * inv;
            TAB[i * 2] = cosf(ang); TAB[i * 2 + 1] = sinf(ang); }
        for (int it = gw; it < 16 * 110; it += NGW) transpose_item(w_in, DM, INW, WIN, scr, it, lane, MapIn());
        for (int it = gw; it < 16 * 32; it += NGW) transpose_item(w_out, DM, DM, WOUT, scr, it, lane, MapId());
#if PEER_FOLD
        for (int it = NGW - 1 - gw; it < 16 * 16 * 8; it += NGW) {
            const int kq = it & 7, hp = it >> 7, k0 = ((it >> 3) & 15) * 64, pside = hp & 1; const float* wr = peer_wq + (size_t)(k0 + lane) * 2048 + hp * 128; f32x4 av[32];
            const float* kb = peer_keys + ((size_t)pside * 128 + kq * 16) * 128;
#pragma unroll
            for (int i = 0; i < 8; ++i) *(LAS f32x4*)(scr + (i * 64 + lane) * 4) = *(const f32x4*)(kb + (i * 64 + lane) * 4);
#pragma unroll
            for (int c = 0; c < 32; ++c) av[c] = *(const f32x4*)(wr + 4 * c);
            asm volatile("s_waitcnt lgkmcnt(0)" ::: "memory");
#pragma unroll 2
            for (int key = 0; key < 16; ++key) { const LAS float* kr = scr + key * 128; float s0 = 0.f, s1 = 0.f, s2 = 0.f, s3 = 0.f;
#pragma unroll
                for (int c = 0; c < 32; ++c) { const f32x4 kv = *(const LAS f32x4*)(kr + 4 * c); s0 += av[c][0] * kv[0]; s1 += av[c][1] * kv[1]; s2 += av[c][2] * kv[2]; s3 += av[c][3] * kv[3]; }
                WPQ[(size_t)(hp * 128 + kq * 16 + key) * DM + k0 + lane] = (bf16_t)(cvtpk((s0 + s1) + (s2 + s3), 0.f) & 0xffffu); }
            asm volatile("s_waitcnt lgkmcnt(0)" ::: "memory");
        }
#else
        for (int it = gw; it < 16 * 64; it += NGW) transpose_item(peer_wq, DM, 2048, WPQ, scr, it, lane, MapId());
#endif
        for (int i = gw * 64 + lane; i < 64 * 1024 / 8; i += NGW * 64) *(u32x4*)(WIN + (size_t)448 * 1024 + (size_t)i * 8) = (u32x4){0u, 0u, 0u, 0u};
        for (int it = gw; it < 8 * 4 * 16; it += NGW) {
            const int cb = it & 15, rb = (it >> 4) & 3, h = it >> 6, r = rb * 64 + lane; const float* a = w_uq + (size_t)r * QW + h * DQK; f32x4 av[32];
#pragma unroll
            for (int i = 0; i < 4; ++i) { const int idx = i * 64 + lane, j = idx >> 5, c4 = idx & 31; *(LAS f32x4*)(scr + j * 128 + c4 * 4) = *(const f32x4*)(w_ukv + (size_t)(cb * 8 + j) * 2048 + h * 256 + c4 * 4); }
#pragma unroll
            for (int c = 0; c < 32; ++c) av[c] = *(const f32x4*)(a + 4 * c);
            const float gq = g_q_lora[r];
            asm volatile("s_waitcnt lgkmcnt(0)" ::: "memory");
#pragma unroll 2
            for (int j = 0; j < 8; ++j) { const LAS float* br = scr + j * 128; float s0 = 0.f, s1 = 0.f, s2 = 0.f, s3 = 0.f;
#pragma unroll
                for (int c = 0; c < 32; ++c) { const f32x4 bv = *(const LAS f32x4*)(br + 4 * c); s0 += av[c][0] * bv[0]; s1 += av[c][1] * bv[1]; s2 += av[c][2] * bv[2]; s3 += av[c][3] * bv[3]; }
                WQ[(size_t)(h * DQK + cb * 8 + j) * 256 + r] = (bf16_t)(cvtpk(((s0 + s1) + (s2 + s3)) * gq, 0.f) & 0xffffu); }
            asm volatile("s_waitcnt lgkmcnt(0)" ::: "memory");
        }
        for (int i = gw * 64 + lane; i < NH * 64 * 256; i += NGW * 64) { const int r = i & 255, cc = (i >> 8) & 63, h = i >> 14;
            WQ[(size_t)(h * DQK + 128 + cc) * 256 + r] = (bf16_t)(cvtpk(w_uq[(size_t)r * QW + h * DQK + 128 + rope_src(cc)] * g_q_lora[r], 0.f) & 0xffffu); }
        for (int i = gw * 64 + lane; i < 1024 * 256; i += NGW * 64) { const int n = i >> 8, k = i & 255, h = n >> 7, d = n & 127, hh = k >> 7, c = k & 127;
            const float v = (hh == (h & 1)) ? w_ukv[(size_t)c * 2048 + h * 256 + 128 + d] : 0.f; WUV[i] = (bf16_t)(cvtpk(v, 0.f) & 0xffffu); }
        for (int i = gw * 64 + lane; i < 1024 * 256; i += NGW * 64) { const int n = i >> 8, k = i & 255, g = n >> 8, d = n & 255;
            WPOOL[i] = (bf16_t)(cvtpk(w_pool[((size_t)g * 256 + k) * 256 + d], 0.f) & 0xffffu); }
        for (int i = gw * 64 + lane; i < 256 * 256; i += NGW * 64) { const int n = i >> 8, k = i & 255, p = n >> 7, key = n & 127, pp = k >> 7, c = k & 127;
            const float v = (p == pp) ? peer_keys[((size_t)p * 128 + key) * 128 + c] : 0.f; KEYS[i] = (bf16_t)(cvtpk(v, 0.f) & 0xffffu); }
#if PEER_FP8
#pragma unroll 4
        for (size_t i = (size_t)gw * 64 + lane; i < (size_t)2 * 16384 * 1024 / 16; i += (size_t)NGW * 64) {
            const bool isu = i < (size_t)16384 * 1024 / 16; const size_t j = isu ? i : i - (size_t)16384 * 1024 / 16;
            const float* s = (isu ? peer_u : peer_v) + j * 16; u32x4 w;
#if PEER_I8
            if (isu) {
                f32x4 a4[4]; float am = 0.f;
#pragma unroll
                for (int q = 0; q < 4; ++q) { a4[q] = *(const f32x4*)(s + 4 * q); am = fmaxf(fmaxf(am, fmaxf(fabsf(a4[q][0]), fabsf(a4[q][1]))), fmaxf(fabsf(a4[q][2]), fabsf(a4[q][3]))); }
                am = wave_max(am); const float inv = am > 0.f ? 127.0f / am : 0.f;
#pragma unroll
                for (int q = 0; q < 4; ++q) w[q] = pack_i8(a4[q][0] * inv, a4[q][1] * inv, a4[q][2] * inv, a4[q][3] * inv);
                if (lane == 0) ((float*)(ws + WS_USCALE))[j >> 6] = am * (1.0f / 127.0f);
            } else
#endif
#pragma unroll
            for (int q = 0; q < 4; ++q) { const f32x4 a = *(const f32x4*)(s + 4 * q) * 64.0f; int t = __builtin_amdgcn_cvt_pk_fp8_f32(a[0], a[1], 0, false); t = __builtin_amdgcn_cvt_pk_fp8_f32(a[2], a[3], t, true); w[q] = (unsigned)t; }
#if PEER_XCD
            { const size_t e_ = j >> 6, c_ = (j & 63) * 16;
              *(u32x4*)((unsigned char*)(isu ? PU : PV) + (c_ >> 7) * ((size_t)16384 * 128) + e_ * 128 + (c_ & 127)) = w; }
#else
            *(u32x4*)((unsigned char*)(isu ? PU : PV) + j * 16) = w;
#endif
        }
#else
        for (size_t i = (size_t)gw * 64 + lane; i < (size_t)2 * 16384 * 1024 / 8; i += (size_t)NGW * 64) {
            const bool isu = i < (size_t)16384 * 1024 / 8; const size_t j = isu ? i : i - (size_t)16384 * 1024 / 8;
            const float* s = (isu ? peer_u : peer_v) + j * 8; const f32x4 a = *(const f32x4*)s, b = *(const f32x4*)(s + 4);
            *(u32x4*)((isu ? PU : PV) + j * 8) = pack8(a, b); }
#endif
    }
    if (PROBE_PT == 20 && threadIdx.x == 0) ((unsigned*)args.ws + 9000)[bx] = xb_xcc_id() + 1u;
    SEAM(0); PROBE(1);
    if (PROBE_PT == 20 && blockIdx.x == 0 && threadIdx.x == 0) { int bad = 0; for (int b_ = 0; b_ < G; ++b_) { const unsigned a_ = __hip_atomic_load((unsigned*)args.ws + 9000 + b_, __ATOMIC_RELAXED, __HIP_MEMORY_SCOPE_AGENT), c_ = __hip_atomic_load((unsigned*)args.ws + 9000 + (b_ & 7), __ATOMIC_RELAXED, __HIP_MEMORY_SCOPE_AGENT); bad += (a_ != c_); } probe_val = 10.f + (float)bad; }

    if (IN(1)) {
        DECL_PTRS
        for (int blk = vcu; blk < 256; blk += G) {
            const int b = blk >> 3;
            __syncthreads();
            for (int k = tid; k < DM; k += NTHREADS) { const float g = g_mix_pre[k];
                VEC[k] = g * (1.0f + modv(MOD, b_ada, b, 1024 + k)); VEC[1024 + k] = modv(MOD, b_ada, b, k);
                VEC[2048 + k] = g * (1.0f + modv(MOD, b_ada, 32, 1024 + k)); VEC[3072 + k] = modv(MOD, b_ada, 32, k); }
            __syncthreads();
#define P1_ROWPTR(rr_) (((rr_) >= 256) ? ctx + (size_t)(blk * 32 + (rr_) - 256) * DM : x + (size_t)(blk * 256 + (rr_)) * DM)
            f32x4 nv[4];
#pragma unroll
            for (int j = 0; j < 4; ++j) nv[j] = *(const f32x4*)(P1_ROWPTR(wave) + 4 * lane + 256 * j);
            for (int rr = wave; rr < 288; rr += NWAVES) {
                const bool isc = rr >= 256; const int row = isc ? TL + blk * 32 + (rr - 256) : blk * 256 + rr;
                const LAS float* Gv = VEC + (isc ? 2048 : 0); const LAS float* Sv = Gv + 1024;
                f32x4 v[4]; float s = 0.f;
#pragma unroll
                for (int j = 0; j < 4; ++j) { v[j] = nv[j]; s += (v[j][0] * v[j][0] + v[j][1] * v[j][1]) + (v[j][2] * v[j][2] + v[j][3] * v[j][3]); }
                if (rr + NWAVES < 288) {
#pragma unroll
                    for (int j = 0; j < 4; ++j) nv[j] = *(const f32x4*)(P1_ROWPTR(rr + NWAVES) + 4 * lane + 256 * j); }
                const float rs = rsqrtf(wave_sum(s) * (1.0f / DM) + EPS);
#pragma unroll
                for (int j = 0; j < 4; ++j) { const f32x4 gg = *(const LAS f32x4*)(Gv + 4 * lane + 256 * j), sh = *(const LAS f32x4*)(Sv + 4 * lane + 256 * j);
                    const f32x4 o = v[j] * rs * gg + sh; u32x2 w; w.x = cvtpk(o[0], o[1]); w.y = cvtpk(o[2], o[3]);
                    *(u32x2*)(HN + (size_t)row * DM + 4 * lane + 256 * j) = w; }
            }
#undef P1_ROWPTR
        }
    }
    SEAM(1); PROBE(2);

    if (IN(2)) {
        DECL_PTRS
        pg8::Gemm g{HN, WIN, DM, DM, DM}; SchedIn S{G, bx}; EpiIn E{CQ, SSQCQ, KVRAW, XP, GT};
        pg8::gemm_phase<EpiIn, SchedIn, true>(ring, g, S, E);
    }
    SEAM(2); PROBE(3);

    if (IN(3) && DBG_AT == 3) { DBG_COPY(3, GT, 2048) }
    if (IN(3) && !(DBG_AT && DBG_AT <= 3)) {
        DECL_PTRS
        for (int row0 = gw * 4; row0 < TALL; row0 += NGW * 4) {
            f32x4 vv[4];
#pragma unroll
            for (int i = 0; i < 4; ++i) { vv[i] = (f32x4){0.f, 0.f, 0.f, 0.f}; if (lane < 48) vv[i] = *(const f32x4*)(KVRAW + (size_t)(row0 + i) * 192 + 4 * lane); }
#pragma unroll
            for (int i = 0; i < 4; ++i) { const int row = row0 + i; const f32x4 v = vv[i];
                const bool isc = row >= TL; int b, key, t = 0;
                if (isc) { const int j = row - TL; b = j >> 8; key = j & 255; } else { b = row >> 11; t = row & 2047; key = 256 + t; }
                float s = (lane < 32) ? (v[0] * v[0] + v[1] * v[1]) + (v[2] * v[2] + v[3] * v[3]) : 0.f;
                const float rs = rsqrtf(wave_sum(s) * (1.0f / 128.0f) + EPS);
                f32x4 o;
                if (lane < 32) { const f32x4 gk = *(const f32x4*)(g_kv_lora + 4 * lane); o = v * rs * gk; }
                else if (!isc && lane < 48) { const int p0 = 2 * (lane - 32), vq = (p0 >> 4) ? (t & 63) : (t >> 6); const f32x4 tc = *(const f32x4*)(TAB + (vq * 16 + (p0 & 15)) * 2);
                    o[0] = v[0] * tc[0] - v[1] * tc[1]; o[1] = v[0] * tc[1] + v[1] * tc[0]; o[2] = v[2] * tc[2] - v[3] * tc[3]; o[3] = v[2] * tc[3] + v[3] * tc[2]; }
                else o = v;
                if (lane < 48) { u32x2 w; w.x = cvtpk(o[0], o[1]); w.y = cvtpk(o[2], o[3]); *(u32x2*)(KF + ((size_t)b * NKEY + key) * DQK + 4 * lane) = w; } }
        }
        pg8::Gemm g{CQ, WQ, 256, 256, 256}; SchedQ S{G, bx}; EpiQ E{QB, SSQCQ, TAB};
        pg8::gemm_phase<EpiQ, SchedQ, true>(ring, g, S, E);
    }
    SEAM(3); PROBE(4);

    if (IN(4) && !(DBG_AT && DBG_AT <= 4)) {
        DECL_PTRS
        const int ipb = (2048 + G - 1) / G;
        for (int i = 0; i < ipb; ++i) { const int uid = vcu * ipb + i; if (uid >= 2048) break;
            const int b = uid >> 6, rem = uid & 63, h = rem >> 3, qb = rem & 7;
            att::attn_unit(QB, KF + (size_t)b * NKEY * DQK, OLAT, b * SEQ + qb * 256, h, (char*)lds); }
    }
    SEAM(4); PROBE(5);


    if (PROBE_PT == 10 && IN(5) && blockIdx.x == 0 && wave == 0) {
        DECL_PTRS
        float worst = 0.f;
        for (int tc = 0; tc < 2; ++tc) {
            const int q = tc ? 150 : 37, h = tc ? 6 : 3;
            const bf16_t* qp = QB + (size_t)q * QW + h * DQK;
            float sc[36]; float mx = -1e30f;
            for (int kk = 0; kk < 36; ++kk) { const bf16_t* kp = KF + (size_t)(kk * 64 + lane) * DQK; float a = 0.f;
                for (int d = 0; d < DQK; ++d) a += __uint_as_float((unsigned)qp[d] << 16) * __uint_as_float((unsigned)kp[d] << 16);
                sc[kk] = a; mx = fmaxf(mx, a); }
            for (int o = 1; o < 64; o <<= 1) mx = fmaxf(mx, __shfl_xor(mx, o));
            float l = 0.f;
            for (int kk = 0; kk < 36; ++kk) { sc[kk] = exp2f(sc[kk] - mx); l += sc[kk]; }
            l = wave_sum(l);
            float omax = 0.f, dmax = 0.f;
            for (int c = 0; c < 128; ++c) { float a = 0.f;
                for (int kk = 0; kk < 36; ++kk) a += sc[kk] * __uint_as_float((unsigned)KF[(size_t)(kk * 64 + lane) * DQK + c] << 16);
                a = wave_sum(a) / l; const float got = __uint_as_float((unsigned)OLAT[(size_t)q * 1024 + h * 128 + c] << 16);
                omax = fmaxf(omax, fabsf(a)); dmax = fmaxf(dmax, fabsf(a - got)); }
            worst = fmaxf(worst, dmax / omax);
        }
        if (lane == 0) probe_val = 1000.f * worst;
    }
    if (PROBE_PT == 10 && IN(5) && blockIdx.x == 0) __syncthreads();
    if (IN(5) && DBG_AT == 5) { DBG_COPY(5, OLAT, 1024) }
    if (IN(5) && !(DBG_AT && DBG_AT <= 5)) {
        DECL_PTRS
        for (int pm = vcu; pm < 256; pm += G) {
            const int b = pm >> 3, tok0 = pm * 256;
            __syncthreads();
            TM(0) {
                int td = tid; asm volatile("" : "+v"(td));
                const int ln = td & 63, s0 = (pm & 7) * 256; LAS unsigned char* slab = (LAS unsigned char*)lds;
                const unsigned char* xg = (const unsigned char*)(XP + (size_t)b * SEQ * DM); unsigned* pb = (unsigned*)POOLED + (size_t)b * SEQ * 512 + 2 * ln;
#pragma unroll
                for (int g = 0; g < 4; ++g) { const int hw = 1 << g;
                    __syncthreads();
#pragma unroll
                    for (int i = td; i < 272 * 32; i += NTHREADS) { const int r = i >> 5, c16 = i & 31; const int jc = min(max(s0 - 8 + r, 0), SEQ - 1);
                        *(LAS u32x4*)(slab + r * 512 + c16 * 16) = *(const u32x4*)(xg + (size_t)jc * 2048 + g * 512 + c16 * 16); }
                    __syncthreads();
#pragma unroll 2
                    for (int it = 0; it < 32; ++it) { const int sl = it * 8 + wave, sq = s0 + sl; f32x4 sum = (f32x4){0.f, 0.f, 0.f, 0.f}, cen = sum;
#pragma unroll
                        for (int t = 0; t < 2 * hw; ++t) { const int jj = sq - hw + t; const float f = ((unsigned)jj < (unsigned)SEQ) ? 1.0f : 0.0f;
                            const u32x2 w = *(const LAS u32x2*)(slab + (sl + 8 - hw + t) * 512 + ln * 8); const f32x4 v = (f32x4){bf_lo(w.x), bf_hi(w.x), bf_lo(w.y), bf_hi(w.y)};
                            sum += v * f; if (t == hw) cen = v; }
                        const float rc = 1.0f / (float)(min(sq + hw, SEQ) - max(sq - hw, 0)); const f32x4 o = sum * rc - cen;
                        u32x2 ow; ow.x = cvtpk(o[0], o[1]); ow.y = cvtpk(o[2], o[3]); *(u32x2*)(pb + (size_t)sq * 512 + g * 128) = ow; } }
                __syncthreads();
            }
            for (int k = tid; k < DM; k += NTHREADS) {
                VEC[k] = modv(MOD, b_ada, b, 2048 + k) * g_mix_post[k];
                VEC[1024 + k] = g_ffn_pre[k] * (1.0f + modv(MOD, b_ada, b, 4096 + k));
                VEC[2048 + k] = modv(MOD, b_ada, b, 3072 + k);
                VEC[3072 + k] = modv(MOD, b_ada, b, 5120 + k) * g_ffn_post[k];
                VEC[4096 + k] = pool_scale[k]; }
            asm volatile("s_waitcnt vmcnt(0)" ::: "memory"); __syncthreads();
            DBG_TCOPY(1, POOLED)
            PROBE(14);
            TM(1) { pg8::Gemm g{OLAT, WUV, DM, 256, 256}; SchedRow S{pm, 0, 4, (long)tok0 * DM * 2, 512, 0, 256 * 256 * 2}; EpiU E{MG, GT}; pg8::gemm_phase<EpiU, SchedRow, true>(ring, g, S, E); }
            PROBE(15);
            DBG_TCOPY(4, MG)
            TM(2) { pg8::Gemm g{POOLED, WPOOL, DM, 256, 256}; SchedRow S{pm, 0, 4, (long)tok0 * DM * 2, 512, 0, 256 * 256 * 2}; EpiP E{MG, GT, VEC + 4096}; pg8::gemm_phase<EpiP, SchedRow, true>(ring, g, S, E); }
            PROBE(16);
            DBG_TCOPY(2, MG)
            TM(3) { pg8::Gemm g{MG, WOUT, DM, DM, DM}; SchedRow S{pm, 0, 4, (long)tok0 * DM * 2, 0, 0, 256 * DM * 2}; EpiO E{YB, SSQY}; pg8::gemm_phase<EpiO, SchedRow, true>(ring, g, S, E); }
            DBG_TCOPY(3, YB)
            PROBE(6);
            TM(4) {
                int ln = lane; asm volatile("" : "+v"(ln));
                const int c0 = 8 * ln, c1 = 512 + 8 * ln;
                f32x4 nq[4], nx[4]; u32x4 ny0, ny1;
#define E_LOAD(rr_) do { const size_t r_ = (size_t)tok0 + (rr_); _Pragma("unroll") for (int q = 0; q < 4; ++q) { nq[q] = *(const f32x4*)(SSQY + r_ * 16 + 4 * q); nx[q] = *(const f32x4*)(x + r_ * DM + ((q < 2 ? c0 : c1) + (q & 1) * 4)); } \
        ny0 = *(const u32x4*)(YB + r_ * DM + c0); ny1 = *(const u32x4*)(YB + r_ * DM + c1); } while (0)
                E_LOAD(wave * 32);
                for (int rr = wave * 32; rr < wave * 32 + 32; ++rr) {
                    const size_t row = (size_t)tok0 + rr;
                    const f32x4 qs = (nq[0] + nq[1]) + (nq[2] + nq[3]); const float ry = rsqrtf(((qs[0] + qs[1]) + (qs[2] + qs[3])) * (1.0f / DM) + EPS);
                    const u32x4 y0 = ny0, y1 = ny1; f32x4 xv[4];
#pragma unroll
                    for (int q = 0; q < 4; ++q) xv[q] = nx[q];
                    if (rr + 1 < wave * 32 + 32) E_LOAD(rr + 1);
                    float xm[16]; float yv[16] = {bf_lo(y0.x), bf_hi(y0.x), bf_lo(y0.y), bf_hi(y0.y), bf_lo(y0.z), bf_hi(y0.z), bf_lo(y0.w), bf_hi(y0.w), bf_lo(y1.x), bf_hi(y1.x), bf_lo(y1.y), bf_hi(y1.y), bf_lo(y1.z), bf_hi(y1.z), bf_lo(y1.w), bf_hi(y1.w)};
                    float s_ = 0.f;
#pragma unroll
                    for (int q = 0; q < 4; ++q) { const int cc = (q < 2 ? c0 : c1) + (q & 1) * 4; const f32x4 a1 = *(const LAS f32x4*)(VEC + cc);
#pragma unroll
                        for (int e = 0; e < 4; ++e) { const float m_ = xv[q][e] + a1[e] * (yv[q * 4 + e] * ry); xm[q * 4 + e] = m_; s_ += m_ * m_; } }
                    { u32x4 m0, m1; m0.x = cvtpk(xm[0], xm[1]); m0.y = cvtpk(xm[2], xm[3]); m0.z = cvtpk(xm[4], xm[5]); m0.w = cvtpk(xm[6], xm[7]);
                      m1.x = cvtpk(xm[8], xm[9]); m1.y = cvtpk(xm[10], xm[11]); m1.z = cvtpk(xm[12], xm[13]); m1.w = cvtpk(xm[14], xm[15]);
                      bf16_t* xmr = (bf16_t*)(ws + xm_off(row)); *(u32x4*)(xmr + c0) = m0; *(u32x4*)(xmr + c1) = m1; }
                    const float rm = rsqrtf(wave_sum(s_) * (1.0f / DM) + EPS);
                    u32x4 h0, h1; float hv[16];
#pragma unroll
                    for (int q = 0; q < 4; ++q) { const int cc = (q < 2 ? c0 : c1) + (q & 1) * 4; const f32x4 a2 = *(const LAS f32x4*)(VEC + 1024 + cc), a3 = *(const LAS f32x4*)(VEC + 2048 + cc);
#pragma unroll
                        for (int e = 0; e < 4; ++e) hv[q * 4 + e] = xm[q * 4 + e] * rm * a2[e] + a3[e]; }
                    h0.x = cvtpk(hv[0], hv[1]); h0.y = cvtpk(hv[2], hv[3]); h0.z = cvtpk(hv[4], hv[5]); h0.w = cvtpk(hv[6], hv[7]);
                    h1.x = cvtpk(hv[8], hv[9]); h1.y = cvtpk(hv[10], hv[11]); h1.z = cvtpk(hv[12], hv[13]); h1.w = cvtpk(hv[14], hv[15]);
                    *(u32x4*)(HF + row * DM + c0) = h0; *(u32x4*)(HF + row * DM + c1) = h1;
#if PEER_I8
                    {
                        float am = 0.f;
#pragma unroll
                        for (int e = 0; e < 16; ++e) am = fmaxf(am, fabsf(hv[e]));
                        am = wave_max(am); const float inv = am > 0.f ? 127.0f / am : 0.f;
                        u32x2 q0, q1; q0.x = pack_i8(hv[0] * inv, hv[1] * inv, hv[2] * inv, hv[3] * inv); q0.y = pack_i8(hv[4] * inv, hv[5] * inv, hv[6] * inv, hv[7] * inv);
                        q1.x = pack_i8(hv[8] * inv, hv[9] * inv, hv[10] * inv, hv[11] * inv); q1.y = pack_i8(hv[12] * inv, hv[13] * inv, hv[14] * inv, hv[15] * inv);
                        unsigned char* h8 = ws + WS_HF8 + row * DM; *(u32x2*)(h8 + c0) = q0; *(u32x2*)(h8 + c1) = q1;
                        if (ln == 0) ((float*)(ws + WS_XSCALE))[row] = am * (1.0f / 127.0f);
                    }
#endif
                }
#undef E_LOAD
            }
            asm volatile("s_waitcnt vmcnt(0)" ::: "memory"); __syncthreads();
#if PEER_FOLD
            PROBE(7);
            float* Sblk = (float*)(ws + WS_GT) + (size_t)pm * 262144; const int srot = (pm * 8) & 255;
            TM(6) for (int hq = 0; hq < (S_I16 ? 1 : 2); ++hq) {
                { pg8::Gemm g{HF, WPQ, DM, DM, DM}; SchedRow S{pm, 4 * hq, S_I16 ? 8 : 4, (long)tok0 * DM * 2, 0, 0, 256 * DM * 2}; EpiS4 E{Sblk, srot}; pg8::gemm_phase<EpiS4, SchedRow, true>(ring, g, S, E); }
                if (hq == 0) PROBE(17);
              {
#if S_I16
#define S_ROWP(rl, hh_) ((const short*)Sblk + (size_t)(((rl) + srot) & 255) * 2048 + (hh_) * 256)
#else
#define S_ROWP(rl, hh_) (Sblk + (size_t)(((rl) + srot) & 255) * 1024 + (hh_) * 256)
#endif
#else
            TM(5) { pg8::Gemm g{HF, WPQ, DM, DM, DM}; SchedRow S{pm, 0, 8, (long)tok0 * DM * 2, 0, 0, 256 * DM * 2}; EpiStore E{QP, 2048}; pg8::gemm_phase<EpiStore, SchedRow, true>(ring, g, S, E); }
            PROBE(7);
            float* Sblk = SB + (size_t)pm * (65536 + 1088);
            TM(6) for (int h = 0; h < NH; ++h) {
                { pg8::Gemm g{QP, KEYS, 2048, 256, 256}; SchedRow S{pm, h, 1, (long)tok0 * 2048 * 2, 512, 0, 0}; EpiS E{Sblk}; pg8::gemm_phase<EpiS, SchedRow, true>(ring, g, S, E); }
              {
#define S_ROWP(rl) (Sblk + (size_t)(rl) * 256)
#endif
                int ln = lane; asm volatile("" : "+v"(ln));
                const int i16 = ln & 15, g4 = ln >> 4;
                int cA[4], cB[4];
#pragma unroll
                for (int e = 0; e < 4; ++e) { const int c = 16 * e + i16; const int a = (c >= 16) + (c >= 24) + (c >= 29) + (c >= 33) + (c >= 36) + (c >= 38) + (c >= 40) + (c >= 42);
                    const int offs = (a == 0) ? 0 : (a == 1) ? 16 : (a == 2) ? 24 : (a == 3) ? 29 : (a == 4) ? 33 : (a == 5) ? 36 : (a == 6) ? 38 : (a == 7) ? 40 : 42;
                    if (c >= 42) { cA[e] = min(8 + (c - 42), 15); cB[e] = 0; } else { cA[e] = a; cB[e] = c - offs; } }
#if PEER_FOLD
#if S_I16
#define S_LD1(A_, B_, sp_) do { const short* p_ = (sp_); const u32x2 wa_ = *(const u32x2*)p_, wb_ = *(const u32x2*)(p_ + 64); A_ = (f32x4){__uint_as_float(wa_.x), __uint_as_float(wa_.y), 0.f, 0.f}; B_ = (f32x4){__uint_as_float(wb_.x), __uint_as_float(wb_.y), 0.f, 0.f}; } while (0)
#else
#define S_LD1(A_, B_, sp_) do { const float* p_ = (sp_); A_ = *(const f32x4*)p_; B_ = *(const f32x4*)(p_ + 64); } while (0)
#endif
#define S_LOAD(it_, A, B) do { const int hh_ = (it_) >> 2, r_ = wave * 32 + ((it_) & 3) * 8; _Pragma("unroll") for (int c_ = 0; c_ < 4; ++c_) { \
        S_LD1(A[c_], B[c_], S_ROWP(r_ + 2 * c_ + (g4 >> 1), hh_) + (g4 & 1) * 128 + 4 * i16); } } while (0)
                f32x4 na[4], nb[4]; S_LOAD(0, na, nb);
                for (int itk = 0; itk < (S_I16 ? 32 : 16); ++itk) { const int h = 4 * hq + (itk >> 2), r8 = wave * 32 + (itk & 3) * 8;
                    f32x4 ca[4], cbv[4];
#pragma unroll
                    for (int c_ = 0; c_ < 4; ++c_) { ca[c_] = na[c_]; cbv[c_] = nb[c_]; }
                    if (itk + 1 < (S_I16 ? 32 : 16)) S_LOAD(itk + 1, na, nb);
                    unsigned mq[4]; top16_of_128<4, S_I16 != 0>(ca, cbv, i16, mq);
#pragma unroll 1
                  for (int half = 0; half < 2; ++half) { const int r4 = r8 + 4 * half; const unsigned mA = half ? mq[2] : mq[0], mB = half ? mq[3] : mq[1];
#else
                for (int r4 = wave * 32; r4 < wave * 32 + 32; r4 += 4) {
                    if (SKIP_TOPK) { const size_t oi_ = ((size_t)tok0 + r4 + g4) * 128 + h * 16 + i16; EIDX[oi_] = (h * 16 + i16) * 97; EW[oi_] = 0.0625f; continue; }
                    const float* sp0 = S_ROWP(r4 + (g4 >> 1)) + (g4 & 1) * 128 + 4 * i16; const float* sp1 = S_ROWP(r4 + 2 + (g4 >> 1)) + (g4 & 1) * 128 + 4 * i16;
                    const f32x4 a0 = *(const f32x4*)sp0, b0 = *(const f32x4*)(sp0 + 64), a1 = *(const f32x4*)sp1, b1 = *(const f32x4*)(sp1 + 64);
#endif
#if !PEER_FOLD
                    unsigned mq2[2]; { const f32x4 sa_[2] = {a0, a1}, sb_[2] = {b0, b1}; top16_of_128<2>(sa_, sb_, i16, mq2); } const unsigned mA = mq2[0], mB = mq2[1];
#endif
                    const int src0 = ((2 * (g4 & 1)) * 16 + i16) * 4, src1 = src0 + 64;
                    const unsigned A0 = (unsigned)__builtin_amdgcn_ds_bpermute(src0, (int)mA), A1 = (unsigned)__builtin_amdgcn_ds_bpermute(src1, (int)mA);
                    const unsigned B0 = (unsigned)__builtin_amdgcn_ds_bpermute(src0, (int)mB), B1 = (unsigned)__builtin_amdgcn_ds_bpermute(src1, (int)mB);
                    const unsigned M0 = (g4 < 2) ? A0 : B0, M1 = (g4 < 2) ? A1 : B1;
#if S_I16 && PEER_FOLD
                    const float v0 = (float)((int)(M0 >> 16) - 32768) * (16.0f / 32767.0f), v1 = (float)((int)(M1 >> 16) - 32768) * (16.0f / 32767.0f);
#else
                    const float v0 = key2f(M0 & ~0x7Fu), v1 = key2f(M1 & ~0x7Fu);
#endif
                    const int kid0 = 127 - (int)(M0 & 0x7Fu), kid1 = 127 - (int)(M1 & 0x7Fu);
                    unsigned ck[4];
#pragma unroll
                    for (int e = 0; e < 4; ++e) { const float s0 = __uint_as_float((unsigned)__builtin_amdgcn_ds_bpermute((g4 * 16 + cA[e]) * 4, (int)__float_as_uint(v0)));
                        const float s1 = __uint_as_float((unsigned)__builtin_amdgcn_ds_bpermute((g4 * 16 + cB[e]) * 4, (int)__float_as_uint(v1)));
                        const int c = 16 * e + i16; ck[e] = (c < 50) ? ((f2key(s0 + s1) & ~0x3Fu) | (unsigned)(63 - c)) : 0u; }
                    CE_DESC(ck[0], ck[1]); CE_DESC(ck[2], ck[3]); CE_DESC(ck[0], ck[2]); CE_DESC(ck[1], ck[3]); CE_DESC(ck[1], ck[2]);
                    unsigned best = 0u;
#pragma unroll
                    for (int it = 0; it < 16; ++it) { unsigned m = ck[0]; ROW_MAXU(m); const bool tk = (ck[0] == m);
                        ck[0] = tk ? ck[1] : ck[0]; ck[1] = tk ? ck[2] : ck[1]; ck[2] = tk ? ck[3] : ck[2]; ck[3] = tk ? 0u : ck[3];
                        best = (i16 == it) ? m : best; }
                    const float bv = key2f(best & ~0x3Fu); const int c = 63 - (int)(best & 0x3Fu);
                    const int a = (c >= 16) + (c >= 24) + (c >= 29) + (c >= 33) + (c >= 36) + (c >= 38) + (c >= 40) + (c >= 42);
                    const int offs = (a == 0) ? 0 : (a == 1) ? 16 : (a == 2) ? 24 : (a == 3) ? 29 : (a == 4) ? 33 : (a == 5) ? 36 : (a == 6) ? 38 : (a == 7) ? 40 : 42;
                    const int ba = (c >= 42) ? 8 + (c - 42) : a, bb = (c >= 42) ? 0 : c - offs;
                    const int e0 = __builtin_amdgcn_ds_bpermute((g4 * 16 + ba) * 4, kid0), e1 = __builtin_amdgcn_ds_bpermute((g4 * 16 + bb) * 4, kid1);
                    const float top = __uint_as_float((unsigned)__builtin_amdgcn_ds_bpermute((g4 * 16) * 4, (int)__float_as_uint(bv)));
                    const float ex = __builtin_amdgcn_exp2f((bv - top) * 1.4426950408889634f);
                    float sum = ex; sum += dpp_f<0x128>(sum); sum += dpp_f<0x124>(sum); sum += dpp_f<0x122>(sum); sum += dpp_f<0x121>(sum);
                    const size_t oi = ((size_t)tok0 + r4 + g4) * 128 + h * 16 + i16;
                    EIDX[oi] = e0 * 128 + e1; EW[oi] = ex / sum;
#if PEER_FOLD
                  }
#endif
                }
              }
#undef S_ROWP
#undef S_LOAD
#undef S_LD1
                asm volatile("s_waitcnt vmcnt(0)" ::: "memory"); __syncthreads();
#if PEER_FOLD
                if (hq == 0) PROBE(18);
#endif
            }
            PROBE(8);
#if PEER_XCD
#elif PEER_FP8
            TM(7) for (int rr = wave * 32; rr < wave * 32 + 32; ++rr) {
                int ln = lane; asm volatile("" : "+v"(ln));
                LAS unsigned char* slots = ring + wave * 16384;
                const size_t row = (size_t)tok0 + rr; const int c0 = 16 * ln;
                const int idA = EIDX[row * 128 + ln], idB = EIDX[row * 128 + 64 + ln]; const float wA = EW[row * 128 + ln], wB = EW[row * 128 + 64 + ln];
                float xs[16];
                { const u32x4 xa = *(const u32x4*)(HF + row * DM + c0), xb = *(const u32x4*)(HF + row * DM + c0 + 8);
                  xs[0] = bf_lo(xa.x); xs[1] = bf_hi(xa.x); xs[2] = bf_lo(xa.y); xs[3] = bf_hi(xa.y); xs[4] = bf_lo(xa.z); xs[5] = bf_hi(xa.z); xs[6] = bf_lo(xa.w); xs[7] = bf_hi(xa.w);
                  xs[8] = bf_lo(xb.x); xs[9] = bf_hi(xb.x); xs[10] = bf_lo(xb.y); xs[11] = bf_hi(xb.y); xs[12] = bf_lo(xb.z); xs[13] = bf_hi(xb.z); xs[14] = bf_lo(xb.w); xs[15] = bf_hi(xb.w); }
                const unsigned char* PU8 = (const unsigned char*)PU; const unsigned char* PV8 = (const unsigned char*)PV;
                asm volatile("s_waitcnt vmcnt(0) lgkmcnt(0)" ::: "memory");
#define G_ISSUE(rix, slot) do { const int e_ = (rix) & 127; const int id_ = __builtin_amdgcn_readlane((e_ < 64) ? idA : idB, e_ & 63); \
        const unsigned char* src_ = (((rix) < 128) ? PU8 : PV8) + (size_t)id_ * DM + c0; \
        __builtin_amdgcn_global_load_lds((const unsigned*)src_, (LAS unsigned*)(slots + (slot) * 1024), 16, 0, 0); } while (0)
#define G_WAITV(n) asm volatile("s_waitcnt vmcnt(" #n ")" ::: "memory")
#define G_TAKE(dst, slot) do { dst = *(const LAS u32x4*)(slots + (slot) * 1024 + ln * 16); asm volatile("s_waitcnt lgkmcnt(0)" ::: "memory"); } while (0)
#pragma unroll
                for (int j = 0; j < 16; ++j) G_ISSUE(j, j);
                float dA = 0.f, dB = 0.f, r_[8];
                for (int it = 0; it < 8; ++it) {
#pragma unroll
                    for (int j = 0; j < 16; ++j) {
                        u32x4 u; G_WAITV(15); G_TAKE(u, j); G_ISSUE(16 * it + j + 16, j);
                        float d0 = 0.f, d1 = 0.f;
#pragma unroll
                        for (int k = 0; k < 4; ++k) { const f32x2 lo = __builtin_amdgcn_cvt_pk_f32_fp8((int)u[k], false), hi = __builtin_amdgcn_cvt_pk_f32_fp8((int)u[k], true);
                            d0 += lo[0] * xs[4 * k]; d1 += lo[1] * xs[4 * k + 1]; d0 += hi[0] * xs[4 * k + 2]; d1 += hi[1] * xs[4 * k + 3]; }
                        r_[j & 7] = d0 + d1;
                        if ((j & 7) == 7) { float r4[4], r2[2], r1;
#pragma unroll
                            for (int i = 0; i < 4; ++i) { const bool b_ = ln & 1; const float keep = b_ ? r_[2 * i + 1] : r_[2 * i], send = b_ ? r_[2 * i] : r_[2 * i + 1]; r4[i] = keep + __shfl_xor(send, 1); }
#pragma unroll
                            for (int i = 0; i < 2; ++i) { const bool b_ = ln & 2; const float keep = b_ ? r4[2 * i + 1] : r4[2 * i], send = b_ ? r4[2 * i] : r4[2 * i + 1]; r2[i] = keep + __shfl_xor(send, 2); }
                            { const bool b_ = ln & 4; const float keep = b_ ? r2[1] : r2[0], send = b_ ? r2[0] : r2[1]; r1 = keep + __shfl_xor(send, 4); }
                            r1 += __shfl_xor(r1, 8); r1 += __shfl_xor(r1, 16); r1 += __shfl_xor(r1, 32);
                            const int q = 2 * it + (j >> 3);
                            if ((ln >> 3) == (q & 7)) { if (q < 8) dA = r1; else dB = r1; } }
                    }
                }
                dA *= (1.0f / 64.0f); dB *= (1.0f / 64.0f);
                const float aA = 0.5f * dA * (1.0f + erff(dA * 0.70710678118654752f)) * wA * (1.0f / 64.0f), aB = 0.5f * dB * (1.0f + erff(dB * 0.70710678118654752f)) * wB * (1.0f / 64.0f);
                float acc[16];
#pragma unroll
                for (int i = 0; i < 16; ++i) acc[i] = 0.f;
#define G_VSTEP(WAITN, e_expr, REFILL) do { u32x4 v; G_WAITV(WAITN); G_TAKE(v, j); REFILL; const int e_ = (e_expr); \
        const float a_ = __uint_as_float(__builtin_amdgcn_readlane(__float_as_uint((e_ < 64) ? aA : aB), e_ & 63)); \
        _Pragma("unroll") for (int k = 0; k < 4; ++k) { const f32x2 lo = __builtin_amdgcn_cvt_pk_f32_fp8((int)v[k], false), hi = __builtin_amdgcn_cvt_pk_f32_fp8((int)v[k], true); \
            acc[4 * k] += a_ * lo[0]; acc[4 * k + 1] += a_ * lo[1]; acc[4 * k + 2] += a_ * hi[0]; acc[4 * k + 3] += a_ * hi[1]; } } while (0)
                for (int it = 0; it < 7; ++it) {
#pragma unroll
                    for (int j = 0; j < 16; ++j) G_VSTEP(15, 16 * it + j, G_ISSUE(128 + 16 * it + j + 16, j));
                }
                {
#define G_LAST(jj, n) do { const int j = jj; G_VSTEP(n, 112 + j, (void)0); } while (0)
                    G_LAST(0, 15); G_LAST(1, 14); G_LAST(2, 13); G_LAST(3, 12); G_LAST(4, 11); G_LAST(5, 10); G_LAST(6, 9); G_LAST(7, 8);
                    G_LAST(8, 7); G_LAST(9, 6); G_LAST(10, 5); G_LAST(11, 4); G_LAST(12, 3); G_LAST(13, 2); G_LAST(14, 1); G_LAST(15, 0);
#undef G_LAST
                }
#undef G_VSTEP
#undef G_ISSUE
#undef G_WAITV
#undef G_TAKE
                float s = 0.f;
#pragma unroll
                for (int i = 0; i < 16; ++i) s += acc[i] * acc[i];
                const float rp = rsqrtf(wave_sum(s) * (1.0f / DM) + EPS);
#pragma unroll
                for (int q = 0; q < 4; ++q) { const int cc = c0 + 4 * q; const f32x4 a4 = *(const LAS f32x4*)(VEC + 3072 + cc); f32x4 xm = *(const f32x4*)(out + row * DM + cc);
#pragma unroll
                    for (int e = 0; e < 4; ++e) xm[e] += a4[e] * (acc[q * 4 + e] * rp);
                    *(f32x4*)(out + row * DM + cc) = xm; }
            }
#else
            TM(7) for (int rr = wave * 32; rr < wave * 32 + 32; ++rr) {
                int ln = lane; asm volatile("" : "+v"(ln));
                const size_t row = (size_t)tok0 + rr; const int c0 = 8 * ln, c1 = 512 + 8 * ln;
                const int idA = EIDX[row * 128 + ln], idB = EIDX[row * 128 + 64 + ln]; const float wA = EW[row * 128 + ln], wB = EW[row * 128 + 64 + ln];
                const u32x4 xa = *(const u32x4*)(HF + row * DM + c0), xb = *(const u32x4*)(HF + row * DM + c1);
                float dA = 0.f, dB = 0.f;
#pragma unroll 2
                for (int q = 0; q < 16; ++q) {
                    float r[8];
#pragma unroll
                    for (int i = 0; i < 8; ++i) { const int id = __builtin_amdgcn_readlane((q < 8) ? idA : idB, (q & 7) * 8 + i); const u32x4* up = (const u32x4*)(PU + (size_t)id * DM) + ln;
                        const u32x4 u0 = up[0], u1 = up[64]; float d = dot2(u0.x, xa.x, 0.f); d = dot2(u0.y, xa.y, d); d = dot2(u0.z, xa.z, d); d = dot2(u0.w, xa.w, d);
                        d = dot2(u1.x, xb.x, d); d = dot2(u1.y, xb.y, d); d = dot2(u1.z, xb.z, d); d = dot2(u1.w, xb.w, d); r[i] = d; }
                    float r4[4], r2[2], r1;
#pragma unroll
                    for (int i = 0; i < 4; ++i) { const bool b0 = ln & 1; const float keep = b0 ? r[2 * i + 1] : r[2 * i], send = b0 ? r[2 * i] : r[2 * i + 1]; r4[i] = keep + __shfl_xor(send, 1); }
#pragma unroll
                    for (int i = 0; i < 2; ++i) { const bool b1 = ln & 2; const float keep = b1 ? r4[2 * i + 1] : r4[2 * i], send = b1 ? r4[2 * i] : r4[2 * i + 1]; r2[i] = keep + __shfl_xor(send, 2); }
                    { const bool b2 = ln & 4; const float keep = b2 ? r2[1] : r2[0], send = b2 ? r2[0] : r2[1]; r1 = keep + __shfl_xor(send, 4); }
                    r1 += __shfl_xor(r1, 8); r1 += __shfl_xor(r1, 16); r1 += __shfl_xor(r1, 32);
                    if ((ln >> 3) == (q & 7)) { if (q < 8) dA = r1; else dB = r1; }
                }
                const float aA = 0.5f * dA * (1.0f + erff(dA * 0.70710678118654752f)) * wA, aB = 0.5f * dB * (1.0f + erff(dB * 0.70710678118654752f)) * wB;
                float acc[16];
#pragma unroll
                for (int i = 0; i < 16; ++i) acc[i] = 0.f;
#pragma unroll 2
                for (int q = 0; q < 16; ++q) {
#pragma unroll
                    for (int i = 0; i < 8; ++i) { const int sl = (q & 7) * 8 + i; const int id = __builtin_amdgcn_readlane((q < 8) ? idA : idB, sl);
                        const float a = __uint_as_float(__builtin_amdgcn_readlane(__float_as_uint((q < 8) ? aA : aB), sl));
                        const u32x4* vp = (const u32x4*)(PV + (size_t)id * DM) + ln; const u32x4 v0 = vp[0], v1 = vp[64];
                        acc[0] += a * bf_lo(v0.x); acc[1] += a * bf_hi(v0.x); acc[2] += a * bf_lo(v0.y); acc[3] += a * bf_hi(v0.y); acc[4] += a * bf_lo(v0.z); acc[5] += a * bf_hi(v0.z); acc[6] += a * bf_lo(v0.w); acc[7] += a * bf_hi(v0.w);
                        acc[8] += a * bf_lo(v1.x); acc[9] += a * bf_hi(v1.x); acc[10] += a * bf_lo(v1.y); acc[11] += a * bf_hi(v1.y); acc[12] += a * bf_lo(v1.z); acc[13] += a * bf_hi(v1.z); acc[14] += a * bf_lo(v1.w); acc[15] += a * bf_hi(v1.w); }
                }
                float s = 0.f;
#pragma unroll
                for (int i = 0; i < 16; ++i) s += acc[i] * acc[i];
                const float rp = rsqrtf(wave_sum(s) * (1.0f / DM) + EPS);
#pragma unroll
                for (int q = 0; q < 4; ++q) { const int cc = (q < 2 ? c0 : c1) + (q & 1) * 4; const f32x4 a4 = *(const LAS f32x4*)(VEC + 3072 + cc); f32x4 xm = *(const f32x4*)(out + row * DM + cc);
#pragma unroll
                    for (int e = 0; e < 4; ++e) xm[e] += a4[e] * (acc[q * 4 + e] * rp);
                    *(f32x4*)(out + row * DM + cc) = xm; }
            }
#endif
        }
    }

#if PEER_XCD
    constexpr int NPH = 10;
    SEAM(5); PROBE(10);
    if (IN(6) || IN(8)) {
        DECL_PTRS
        float* PART = (float*)(ws + WS_GT); unsigned* PK = (unsigned*)(ws + WS_XP); float* SSQP = (float*)(ws + WS_XP + 32 * MiB); bf16_t* PEERO = (bf16_t*)(ws + WS_Q);
        const unsigned char* PU8 = (const unsigned char*)PU; const unsigned char* PV8 = (const unsigned char*)PV;
#pragma unroll 1
        for (int vph = 0; vph < 2; ++vph) {
            if (!(vph == 0 ? IN(6) : IN(8))) continue;
            const bool isv = vph == 1;
            int ln = lane; asm volatile("" : "+v"(ln));
            const int p = bx & 7, r = bx >> 3, nbp = (G - p + 7) >> 3;
            const int first = r * 8 + wave, stride = nbp * 8;
            const int T = (first < TL) ? (TL - 1 - first) / stride + 1 : 0;
            const int lg = ln >> 3, lc = ln & 7;
            const unsigned char* tab = (isv ? PV8 : PU8) + (size_t)p * ((size_t)16384 * 128);
            const int bp_base = lg * 4;
            const unsigned* HW = isv ? (const unsigned*)PK : (const unsigned*)EIDX;
            if (isv) gather_wave<true>(p, first, stride, T, ln, tab, bp_base, HW, HF, PART, PEERO, SSQP); else gather_wave<false>(p, first, stride, T, ln, tab, bp_base, HW, PEER_I8 ? (const bf16_t*)(ws + WS_HF8) : HF, PART, PEERO, SSQP);
            if (!isv) {
                SEAM(6); PROBE(11);
                if (IN(7)) for (int t0 = gw * 4; t0 < TL; t0 += NGW * 4) {
                    float dd[8]; float ew[8]; int ei[8]; float us[8];
#pragma unroll
                    for (int u_ = 0; u_ < 8; ++u_) { const size_t t = (size_t)t0 + (u_ >> 1); const int e = (u_ & 1) * 64 + lane; float d = 0.f;
#pragma unroll
                        for (int pp = 0; pp < 8; ++pp) d += __uint_as_float((unsigned)((const bf16_t*)PART)[((size_t)pp * TL + t) * 128 + e] << 16);
                        dd[u_] = PEER_I8 ? d * ((const float*)(ws + WS_XSCALE))[t] : d * (1.0f / 64.0f); ew[u_] = EW[t * 128 + e]; ei[u_] = EIDX[t * 128 + e]; }
#if PEER_I8
#pragma unroll
                    for (int u_ = 0; u_ < 8; ++u_) us[u_] = ((const float*)(ws + WS_USCALE))[ei[u_]];
#endif
#pragma unroll
                    for (int u_ = 0; u_ < 8; ++u_) { const size_t t = (size_t)t0 + (u_ >> 1); const int e = (u_ & 1) * 64 + lane; const float d = PEER_I8 ? dd[u_] * us[u_] : dd[u_];
                        const float a = 0.5f * d * (1.0f + erff(d * 0.70710678118654752f)) * ew[u_] * (1.0f / 64.0f);
                        PK[t * 128 + e] = (cvtpk(0.f, a) & 0xffff0000u) | (unsigned)ei[u_]; }
                }
                SEAM(7); PROBE(12);
            }
        }
    }
    SEAM(8); PROBE(13);
    if (IN(9)) {
        DECL_PTRS
        const float* SSQP = (const float*)(ws + WS_XP + 32 * MiB); const bf16_t* PEERO = (const bf16_t*)(ws + WS_Q);
        for (int blk = vcu; blk < 256; blk += G) {
            const int b = blk >> 3;
            __syncthreads();
            for (int k = tid; k < DM; k += NTHREADS) VEC[k] = modv(MOD, b_ada, b, 5120 + k) * g_ffn_post[k];
            __syncthreads();
            const int c0 = 8 * lane, c1 = 512 + 8 * lane;
            float nss[8]; u32x4 ny0, ny1, nm0, nm1;
#define F_LOAD(rr_) do { const size_t r_ = (size_t)blk * 256 + (rr_); _Pragma("unroll") for (int pp = 0; pp < 8; ++pp) nss[pp] = SSQP[(size_t)pp * TL + r_]; \
        ny0 = *(const u32x4*)(PEERO + r_ * DM + c0); ny1 = *(const u32x4*)(PEERO + r_ * DM + c1); \
        { const bf16_t* xmr_ = (const bf16_t*)(ws + xm_off(r_)); nm0 = *(const u32x4*)(xmr_ + c0); nm1 = *(const u32x4*)(xmr_ + c1); } } while (0)
            F_LOAD(wave);
            for (int rr = wave; rr < 256; rr += NWAVES) {
                const size_t row = (size_t)blk * 256 + rr; float ss = 0.f;
#pragma unroll
                for (int pp = 0; pp < 8; ++pp) ss += nss[pp];
                const u32x4 y0 = ny0, y1 = ny1, m0 = nm0, m1 = nm1;
                const f32x4 xmv[4] = {(f32x4){bf_lo(m0.x), bf_hi(m0.x), bf_lo(m0.y), bf_hi(m0.y)}, (f32x4){bf_lo(m0.z), bf_hi(m0.z), bf_lo(m0.w), bf_hi(m0.w)},
                                      (f32x4){bf_lo(m1.x), bf_hi(m1.x), bf_lo(m1.y), bf_hi(m1.y)}, (f32x4){bf_lo(m1.z), bf_hi(m1.z), bf_lo(m1.w), bf_hi(m1.w)}};
                if (rr + NWAVES < 256) F_LOAD(rr + NWAVES);
                const float rp = rsqrtf(ss * (1.0f / DM) + EPS);
                const float pv[16] = {bf_lo(y0.x), bf_hi(y0.x), bf_lo(y0.y), bf_hi(y0.y), bf_lo(y0.z), bf_hi(y0.z), bf_lo(y0.w), bf_hi(y0.w), bf_lo(y1.x), bf_hi(y1.x), bf_lo(y1.y), bf_hi(y1.y), bf_lo(y1.z), bf_hi(y1.z), bf_lo(y1.w), bf_hi(y1.w)};
#pragma unroll
                for (int q = 0; q < 4; ++q) { const int cc = (q < 2 ? c0 : c1) + (q & 1) * 4; const f32x4 a4 = *(const LAS f32x4*)(VEC + cc); f32x4 xm = xmv[q];
#pragma unroll
                    for (int e = 0; e < 4; ++e) xm[e] += a4[e] * (pv[q * 4 + e] * rp);
                    *(f32x4*)(out + row * DM + cc) = xm; }
            }
#undef F_LOAD
        }
    }
#else
    constexpr int NPH = 6;
#endif
    PROBE(9);
    if (PROBE_PT && PROBE_MODE) { xcd_barrier(xbar); if (blockIdx.x == 0 && threadIdx.x == 0) { const unsigned m_ = __hip_atomic_load((unsigned*)args.ws + 8192, __ATOMIC_RELAXED, __HIP_MEMORY_SCOPE_AGENT);
        probe_val = (float)(PROBE_MODE == 1 ? m_ : 0xFFFFFFFFu - m_) * (1.0f / PROBE_DIV); } }
    if (PROBE_PT && blockIdx.x == 0) { __syncthreads(); if (threadIdx.x == 0) args.out[0] = probe_val; }
#undef IN
#undef SEAM
}

extern "C" void kernel_launch(void* const* d_in, const int* in_sizes, int n_in, void* d_out, int out_size, void* d_ws, size_t ws_size, hipStream_t stream) {
    static int grid = 0;
    if (grid == 0) {
        if (n_in != 22 || out_size != TL * DM || ws_size < WS_END) { fprintf(stderr, "kernel_launch: unexpected shapes: n_in %d out %d ws %zu (need %zu)\n", n_in, out_size, ws_size, (size_t)WS_END); grid = -1; return; }
        int dev = 0, cus = 0, per_cu = 0;
        hipGetDevice(&dev); hipDeviceGetAttribute(&cus, hipDeviceAttributeMultiprocessorCount, dev);
        hipFuncSetAttribute((const void*)mk_fwd, hipFuncAttributeMaxDynamicSharedMemorySize, LDS_BYTES);
        hipOccupancyMaxActiveBlocksPerMultiprocessor(&per_cu, (const void*)mk_fwd, NTHREADS, LDS_BYTES);
        (void)hipGetLastError();
        if (per_cu < 1) { fprintf(stderr, "kernel_launch: occupancy query says %d blocks per CU\n", per_cu); }
        grid = cus;
    }
    if (grid < 0) return;
    if (hipMemsetAsync(d_ws, 0, 65536, stream) != hipSuccess) { fprintf(stderr, "kernel_launch: memset of the barrier words failed\n"); return; }
    Args a{};
    for (int i = 0; i < 22; ++i) a.in[i] = (const float*)d_in[i];
    a.out = (float*)d_out; a.ws = (unsigned char*)d_ws;
    if (MK_N_LAUNCHES == 1) {
        a.ph_lo = 0; a.ph_hi = PEER_XCD ? 10 : 6; void* kargs[] = {&a};
        hipError_t e = hipLaunchCooperativeKernel((const void*)mk_fwd, dim3(grid), dim3(NTHREADS), kargs, LDS_BYTES, stream);
        if (e != hipSuccess) fprintf(stderr, "cooperative launch failed: %s (grid %d)\n", hipGetErrorString(e), grid);
    } else {
        for (int p = 0; p < (PEER_XCD ? 10 : 6); ++p) { a.ph_lo = p; a.ph_hi = p + 1; hipLaunchKernelGGL(mk_fwd, dim3(grid), dim3(NTHREADS), LDS_BYTES, stream, a); }
    }
}
```
